# Optimizing an MI355X kernel written in HIP

```python
import jax, jax.numpy as jnp
from jax import lax
import numpy as np

D_MODEL = 2048
BATCH = 2
SEQ = 4096
DEPTH = 2

HEAD_DIM = 128
GROUP_HEADS = 4
GROUP_WIDTH = GROUP_HEADS * HEAD_DIM
N_GROUPS = 5
MIX_WIDTH = N_GROUPS * GROUP_WIDTH
IN_SLICES = 4 + 3 + 4 + 4 + 2
IN_COLS = IN_SLICES * GROUP_WIDTH
ROPE_THETA = 10000.0
NORM_EPS = 1e-6
NEG_INF = -1e30

DILATED_PATTERNS = ((128, 1), (512, 4), (2048, 16))
SGU_CHUNK = 128
MOBA_BLOCK = 256
MOBA_TOPK = 3
MOBA_QCHUNK = 64
CONV_WIDTH = 3
N_MEM = 256
MEM_HEADS = 4

kernel_name = 'hymba_style_hybrid_dilated_sgu_moba_conv'


def rms_norm(x, g):
    xf = x.astype(jnp.float32)
    y = xf * lax.rsqrt(jnp.mean(xf * xf, axis=-1, keepdims=True) + NORM_EPS)
    return (y * g.astype(jnp.float32)).astype(x.dtype)


def layer_norm(x, g, b):
    xf = x.astype(jnp.float32)
    mu = jnp.mean(xf, axis=-1, keepdims=True)
    var = jnp.mean(jnp.square(xf - mu), axis=-1, keepdims=True)
    y = (xf - mu) * lax.rsqrt(var + NORM_EPS) * g.astype(jnp.float32) + b.astype(jnp.float32)
    return y.astype(x.dtype)


def rotary(x, pos):
    half = HEAD_DIM // 2
    inv_freq = ROPE_THETA ** (-jnp.arange(half, dtype=jnp.float32) / half)
    ang = pos.astype(jnp.float32)[:, None] * inv_freq[None, :]
    cos = jnp.cos(ang)[None, :, None, :]
    sin = jnp.sin(ang)[None, :, None, :]
    xf = x.astype(jnp.float32)
    x1, x2 = xf[..., :half], xf[..., half:]
    return jnp.concatenate([x1 * cos - x2 * sin, x2 * cos + x1 * sin], axis=-1).astype(x.dtype)


def pad_seq(x, mult, axis):
    p = (-x.shape[axis]) % mult
    if p == 0:
        return x
    widths = [(0, 0)] * x.ndim
    widths[axis] = (0, p)
    return jnp.pad(x, widths)


def dilated_window_attention(q, k, v, window, dilation):
    b, s, h, hd = q.shape
    band = window // dilation
    qp, kp, vp = (pad_seq(t, dilation * band, 1) for t in (q, k, v))
    sp = qp.shape[1]
    length = sp // dilation
    nb = length // band

    def to_strided(t):
        t = t.reshape(b, length, dilation, h, hd).transpose(0, 2, 3, 1, 4)
        return t.reshape(b, dilation, h, nb, band, hd)

    def with_prev(t):
        prev = jnp.pad(t, [(0, 0)] * 3 + [(1, 0), (0, 0), (0, 0)])[:, :, :, :-1]
        return jnp.concatenate([prev, t], axis=-2)

    qs = to_strided(qp)
    kb = with_prev(to_strided(kp))
    vb = with_prev(to_strided(vp))
    scores = jnp.einsum('brhnqd,brhnkd->brhnqk', qs, kb).astype(jnp.float32) * (hd ** -0.5)
    qi = jnp.arange(band)[:, None]
    kj = jnp.arange(2 * band)[None, :]
    dist = qi + band - kj
    blk = jnp.arange(nb)[:, None, None]
    valid = (dist >= 0) & (dist <= band) & (blk * band + kj - band >= 0)
    scores = jnp.where(valid, scores, NEG_INF)
    lse = jax.nn.logsumexp(scores, axis=-1)
    p = jnp.exp(scores - lse[..., None])
    o = jnp.einsum('brhnqk,brhnkd->brhnqd', p, vb.astype(jnp.float32))
    o = o.reshape(b, dilation, h, length, hd).transpose(0, 3, 1, 2, 4).reshape(b, sp, h, hd)[:, :s]
    lse = lse.reshape(b, dilation, h, length).transpose(0, 3, 1, 2).reshape(b, sp, h)[:, :s]
    return o, lse


def dilated_mixture(q, k, v):
    results = [dilated_window_attention(q, k, v, w, d) for w, d in DILATED_PATTERNS]
    outs = jnp.stack([r[0] for r in results], axis=0)
    lses = jnp.stack([r[1] for r in results], axis=0)
    wts = jax.nn.softmax(lses, axis=0)
    return jnp.einsum('pbsh,pbshd->bshd', wts, outs)


def chunked_spatial_gating(u, v, w_s, b_s, ln_g, ln_b):
    b, s, _ = v.shape
    vn = pad_seq(layer_norm(v, ln_g, ln_b), SGU_CHUNK, 1)
    sp = vn.shape[1]
    vc = vn.reshape(b, sp // SGU_CHUNK, SGU_CHUNK, GROUP_HEADS, HEAD_DIM)
    causal = jnp.tril(jnp.ones((SGU_CHUNK, SGU_CHUNK), dtype=w_s.dtype))
    mixed = jnp.einsum('gij,bnjgc->bnigc', w_s * causal, vc) + b_s.T[None, None, :, :, None]
    return u * mixed.reshape(b, sp, GROUP_WIDTH)[:, :s]


def moba_attention(q, k, v):
    b, s, h, hd = q.shape
    qp, kp, vp = (pad_seq(t, MOBA_BLOCK, 1).transpose(0, 2, 1, 3) for t in (q, k, v))
    sp = qp.shape[2]
    nb = sp // MOBA_BLOCK
    topk = min(MOBA_TOPK, nb)
    kblocks = kp.reshape(b, h, nb, MOBA_BLOCK, hd)
    vblocks = vp.reshape(b, h, nb, MOBA_BLOCK, hd)
    kmean = jnp.mean(kblocks.astype(jnp.float32), axis=3)
    gate = jnp.einsum('bhsd,bhnd->bhsn', qp.astype(jnp.float32), kmean)
    qblk = jnp.arange(sp) // MOBA_BLOCK
    past = jnp.arange(nb)[None, :] < qblk[:, None]
    gate = jnp.where(past, gate, NEG_INF)
    _, idx = lax.top_k(gate, topk)
    sel_valid = jnp.arange(topk)[None, :] < qblk[:, None]

    nc = sp // MOBA_QCHUNK
    q_ch = qp.reshape(b, h, nc, MOBA_QCHUNK, hd).transpose(2, 0, 1, 3, 4)
    idx_ch = idx.reshape(b, h, nc, MOBA_QCHUNK, topk).transpose(2, 0, 1, 3, 4)
    valid_ch = sel_valid.reshape(nc, MOBA_QCHUNK, topk)
    starts = jnp.arange(nc, dtype=jnp.int32) * MOBA_QCHUNK
    gather = jax.vmap(jax.vmap(lambda t, i: t[i]))
    scale = hd ** -0.5
    n_sel = topk * MOBA_BLOCK

    def one_chunk(args):
        qc, ic, vc, start = args
        kg = gather(kblocks, ic).reshape(b, h, MOBA_QCHUNK, n_sel, hd)
        vg = gather(vblocks, ic).reshape(b, h, MOBA_QCHUNK, n_sel, hd)
        own = (start // MOBA_BLOCK) * MOBA_BLOCK
        ko = lax.dynamic_slice_in_dim(kp, own, MOBA_BLOCK, axis=2)
        vo = lax.dynamic_slice_in_dim(vp, own, MOBA_BLOCK, axis=2)
        s_sel = jnp.einsum('bhqd,bhqkd->bhqk', qc, kg).astype(jnp.float32) * scale
        s_sel = jnp.where(jnp.repeat(vc, MOBA_BLOCK, axis=-1), s_sel, NEG_INF)
        s_own = jnp.einsum('bhqd,bhkd->bhqk', qc, ko).astype(jnp.float32) * scale
        qpos = start + jnp.arange(MOBA_QCHUNK)
        kpos = own + jnp.arange(MOBA_BLOCK)
        s_own = jnp.where(kpos[None, :] <= qpos[:, None], s_own, NEG_INF)
        p = jax.nn.softmax(jnp.concatenate([s_sel, s_own], axis=-1), axis=-1)
        return (jnp.einsum('bhqk,bhqkd->bhqd', p[..., :n_sel], vg.astype(jnp.float32))
                + jnp.einsum('bhqk,bhkd->bhqd', p[..., n_sel:], vo.astype(jnp.float32)))

    o = lax.map(one_chunk, (q_ch, idx_ch, valid_ch, starts))
    return o.transpose(1, 0, 3, 2, 4).reshape(b, sp, h, hd)[:, :s]


def short_conv_mixer(gate_b, gate_c, hval, conv_w):
    z = gate_c * hval
    y = lax.conv_general_dilated(z, conv_w[:, None, :].astype(z.dtype), window_strides=(1,),
                                 padding=[(CONV_WIDTH - 1, 0)],
                                 dimension_numbers=('NWC', 'WIO', 'NWC'),
                                 feature_group_count=GROUP_WIDTH)
    return gate_b * y


def memory_cross_attention(q, mem_n, w_mem_kv):
    b, m, _ = mem_n.shape
    kv = (mem_n @ w_mem_kv).reshape(b, m, 2, MEM_HEADS, HEAD_DIM)
    s = jnp.einsum('bshd,bmhd->bhsm', q, kv[:, :, 0]).astype(jnp.float32) * (HEAD_DIM ** -0.5)
    p = jax.nn.softmax(s, axis=-1)
    return jnp.einsum('bhsm,bmhd->bshd', p, kv[:, :, 1].astype(jnp.float32))


def hybrid_layer(x, mem, pos, norm_g, w_in, sgu_w, sgu_b, sgu_ln_g, sgu_ln_b, conv_w,
                 mem_norm_g, w_mem_kv, out_norm_g, w_out):
    b, s, _ = x.shape
    h = rms_norm(x, norm_g)
    proj = h @ w_in
    (a_q, a_k, a_v, a_g, b_u, b_v, b_g, c_q, c_k, c_v, c_g,
     d_b, d_c, d_h, d_g, x_q, x_g) = jnp.split(proj, IN_SLICES, axis=-1)
    heads = lambda t: t.reshape(b, s, GROUP_HEADS, HEAD_DIM)
    flat = lambda t: t.reshape(b, s, GROUP_WIDTH)

    o_a = flat(dilated_mixture(rotary(heads(a_q), pos), rotary(heads(a_k), pos), heads(a_v)))
    o_b = chunked_spatial_gating(jax.nn.gelu(b_u), jax.nn.gelu(b_v), sgu_w, sgu_b, sgu_ln_g, sgu_ln_b)
    o_c = flat(moba_attention(rotary(heads(c_q), pos), rotary(heads(c_k), pos), heads(c_v)))
    o_d = short_conv_mixer(d_b, d_c, d_h, conv_w)
    o_x = flat(memory_cross_attention(heads(x_q), rms_norm(mem, mem_norm_g), w_mem_kv))

    branches = [(o_a, a_g), (o_b, b_g), (o_c, c_g), (o_d, d_g), (o_x, x_g)]
    y = jnp.concatenate([(o * jax.nn.silu(g)).astype(x.dtype) for o, g in branches], axis=-1)
    y = rms_norm(y.reshape(b, s, N_GROUPS, GROUP_WIDTH),
                 out_norm_g.reshape(N_GROUPS, GROUP_WIDTH)).reshape(b, s, MIX_WIDTH)
    return x + y @ w_out


def setup_inputs(seed: int = 0) -> dict:
    key = jax.random.key(seed)
    ks = jax.random.split(key, 16)
    f32 = jnp.float32
    nrm = lambda k, shape, scale: jax.random.normal(k, shape, f32) * scale
    return {
        'x': nrm(ks[0], (BATCH, SEQ, D_MODEL), 1.0),
        'mem': nrm(ks[1], (BATCH, N_MEM, D_MODEL), 1.0),
        'norm_g': 1.0 + nrm(ks[2], (DEPTH, D_MODEL), 0.01),
        'w_in': nrm(ks[3], (DEPTH, D_MODEL, IN_COLS), D_MODEL ** -0.5),
        'sgu_w': nrm(ks[4], (DEPTH, GROUP_HEADS, SGU_CHUNK, SGU_CHUNK), SGU_CHUNK ** -0.5),
        'sgu_b': 1.0 + nrm(ks[5], (DEPTH, GROUP_HEADS, SGU_CHUNK), 0.01),
        'sgu_ln_g': 1.0 + nrm(ks[6], (DEPTH, GROUP_WIDTH), 0.01),
        'sgu_ln_b': nrm(ks[7], (DEPTH, GROUP_WIDTH), 0.01),
        'conv_w': nrm(ks[8], (DEPTH, CONV_WIDTH, GROUP_WIDTH), CONV_WIDTH ** -0.5),
        'mem_norm_g': 1.0 + nrm(ks[9], (DEPTH, D_MODEL), 0.01),
        'w_mem_kv': nrm(ks[10], (DEPTH, D_MODEL, 2 * GROUP_WIDTH), D_MODEL ** -0.5),
        'out_norm_g': 1.0 + nrm(ks[11], (DEPTH, MIX_WIDTH), 0.01),
        'w_out': nrm(ks[12], (DEPTH, MIX_WIDTH, D_MODEL), MIX_WIDTH ** -0.5),
        'final_norm_g': 1.0 + nrm(ks[13], (D_MODEL,), 0.01),
    }


def reference(x, mem, norm_g, w_in, sgu_w, sgu_b, sgu_ln_g, sgu_ln_b, conv_w,
              mem_norm_g, w_mem_kv, out_norm_g, w_out, final_norm_g):
    pos = jnp.arange(x.shape[1], dtype=jnp.int32)
    for i in range(DEPTH):
        x = hybrid_layer(x, mem, pos, norm_g[i], w_in[i], sgu_w[i], sgu_b[i], sgu_ln_g[i],
                         sgu_ln_b[i], conv_w[i], mem_norm_g[i], w_mem_kv[i], out_norm_g[i], w_out[i])
    return rms_norm(x, final_norm_g)
```

```cpp
#include <hip/hip_runtime.h>
#include <hip/hip_cooperative_groups.h>
#include <cstdio>
#include <cstdint>
namespace cg = cooperative_groups;

#ifndef REP_MASK
#define REP_MASK 0
#endif
#ifndef SYNC_REP
#define SYNC_REP 1
#endif
#define REPS(k) (1 + ((REP_MASK >> (k)) & 1))
#ifndef PH_MASK
#define PH_MASK 0x7f
#endif
#define PH_EN(k) ((PH_MASK >> (k)) & 1)
#ifndef XB_USE
#define XB_USE 1
#endif
#ifndef COOP
#define COOP 0
#endif
#ifndef MK_FUSED
#define MK_FUSED 1
#endif

#define LAS __attribute__((address_space(3)))
typedef _Float16 hf;
typedef _Float16 h8 __attribute__((ext_vector_type(8)));
typedef _Float16 h4 __attribute__((ext_vector_type(4)));
typedef short s16x4 __attribute__((ext_vector_type(4)));
typedef float f32x4 __attribute__((ext_vector_type(4)));
typedef float f32x2 __attribute__((ext_vector_type(2)));
typedef unsigned u32x4 __attribute__((ext_vector_type(4)));

constexpr int SEQ = 4096, NTOK = 8192, DM = 2048, NCOL = 8704, GW = 512, MIXW = 2560, NMEM = 256;
constexpr float NORM_EPS = 1e-6f;
constexpr float QSCALE = 0.08838834764831845f * 1.4426950408889634f;
enum { SL_AQ = 0, SL_AK, SL_AV, SL_AG, SL_BU, SL_BV, SL_BG, SL_CQ, SL_CK, SL_CV, SL_CG, SL_DB, SL_DC, SL_DH, SL_DG, SL_XQ, SL_XG };

constexpr size_t MiB = 1u << 20;
constexpr size_t WS_CTL = 0;
constexpr size_t WS_ROPE = 1 * MiB;
constexpr size_t WS_SGUW = 3 * MiB;
constexpr size_t WS_KPART = 4 * MiB;
constexpr size_t WS_VSTAT = 5 * MiB;
constexpr size_t WS_LSE = 6 * MiB;
constexpr size_t WS_ROWSS = 7 * MiB + 512 * 1024;
constexpr size_t WS_KVMEM = 8 * MiB;
constexpr size_t WS_MEMN = 10 * MiB;
constexpr size_t WS_WMEMT = 16 * MiB;
constexpr size_t WS_WOUTT = 24 * MiB;
constexpr size_t WS_WINT = 48 * MiB;
constexpr size_t WS_XN = 116 * MiB;
constexpr size_t WS_PROJ = 148 * MiB;
constexpr size_t WS_OA = 284 * MiB;
constexpr size_t WS_OB = 308 * MiB;
constexpr size_t WS_OCP = 316 * MiB;
constexpr size_t WS_OX = 348 * MiB;
constexpr size_t WS_Y = 356 * MiB;
constexpr size_t WS_X1 = 396 * MiB;
constexpr size_t WS_HM = 460 * MiB;
constexpr size_t WS_LIST = 520 * MiB;
constexpr size_t WS_END = 524 * MiB;
constexpr int CW_BAR = 4096;
constexpr int CW_CNT = 8192;

constexpr int PROJ_N1 = 8192;
constexpr int LDS_BYTES = 147456;
constexpr int NWAVES = 8;

__device__ __forceinline__ float shx_l(float v, int lane, int mask) { return __builtin_bit_cast(float, __builtin_amdgcn_ds_bpermute((lane ^ mask) << 2, __builtin_bit_cast(int, v))); }
__device__ __forceinline__ float wave_sum(float v, int lane) {
#pragma unroll
    for (int o = 1; o < 64; o <<= 1) v += shx_l(v, lane, o);
    return v;
}
__device__ __forceinline__ h8 pack8(f32x4 a, f32x4 b) {
    h4 x = __builtin_convertvector(a, h4), y = __builtin_convertvector(b, h4);
    return __builtin_shufflevector(x, y, 0, 1, 2, 3, 4, 5, 6, 7);
}
__device__ __forceinline__ float silu_f(float x) { return x * __builtin_amdgcn_rcpf(1.0f + __builtin_amdgcn_exp2f(-1.4426950408889634f * x)); }
__device__ __forceinline__ float gelu_f(float x) {
    const float z2 = 1.5957691216057308f * (x + 0.044715f * x * x * x);
    return x * __builtin_amdgcn_rcpf(1.0f + __builtin_amdgcn_exp2f(-1.4426950408889634f * z2));
}

namespace pg8 {
constexpr int BM = 256, BK = 64, HALF = 128, HTB = HALF * BK * 2, STAGE_BYTES = 8 * HTB, NXCD = 8, WGM = 8;
__host__ __device__ __forceinline__ int lds_byte(int r, int c) { const int st = (r >> 4) * 2 + (c >> 5), rr = r & 15, cc = c & 31, ob = rr * 64 + cc * 2; return st * 1024 + (ob ^ (((ob >> 9) & 1) << 5)); }
__host__ __device__ __forceinline__ void stage_rc(int b, int& R, int& C) { const int st = b / 1024, sb = b % 1024, swz = sb ^ (((sb >> 9) & 1) << 5); R = (st >> 1) * 16 + swz / 64; C = (st & 1) * 32 + (swz % 64) / 2; }
__host__ __device__ __forceinline__ int perm32(int rho) { const int n = rho >> 4, i = rho & 15; return 8 * (i >> 2) + 4 * n + (i & 3); }
struct Unit { int pm, pn; };
struct Gemm { const hf* A; const hf* Bt; int M, N, K; };
struct StaticOrder {
    int nM, nN, nwg, G, c;
    __host__ __device__ void init(int M, int N, int G_, int c_) { nM = M / BM; nN = N / BM; nwg = nM * nN; G = G_; c = c_; }
    __host__ __device__ bool next(int i, Unit& u) const {
        const long L = (long)i * G + c; if (L >= nwg) return false;
        int wgid = (int)L; { const int q = nwg / NXCD, r = nwg % NXCD, xcd = wgid % NXCD, off = wgid / NXCD; wgid = (xcd < r ? xcd * (q + 1) : r * (q + 1) + (xcd - r) * q) + off; }
        const int nig = WGM * nN, gid = wgid / nig, fm = gid * WGM, gsz = (nM - fm) < WGM ? (nM - fm) : WGM;
        u.pm = fm + ((wgid % nig) % gsz); u.pn = (wgid % nig) / gsz; return true;
    }
    __device__ __forceinline__ void a_ready(const Unit&) const {}
    __device__ __forceinline__ void done(const Unit&) const {}
};

struct OneUnit {
    int pm, pn;
    __device__ __forceinline__ bool next(int i, Unit& u) const { if (i != 0) return false; u.pm = pm; u.pn = pn; return true; }
    __device__ __forceinline__ void a_ready(const Unit&) const {}
    __device__ __forceinline__ void done(const Unit&) const {}
};
template <class Epi, class Sched, bool ALIGN_EPI, bool SP2>
__device__ __forceinline__ void gemm_phase(LAS unsigned char* lds, const Gemm g, const Sched& S, const Epi& E) {
    static_assert(SP2, "only the SP2 loop is kept");
    int tid = threadIdx.x; asm volatile("" : "+v"(tid));
    const int wid = __builtin_amdgcn_readfirstlane(tid >> 6), lane = tid & 63, wr = wid >> 2, wc = wid & 3, fr = lane & 15, fq = lane >> 4;
    const int K = g.K, nt = K / BK;
    unsigned voffA[2], voffB[2];
#pragma unroll
    for (int i = 0; i < 2; ++i) { int R, C; stage_rc(tid * 16 + i * 8192, R, C); const int Rb = Epi::PERM ? ((R & ~31) + perm32(R & 31)) : R;
        voffA[i] = (unsigned)(R * K + C) * 2u; voffB[i] = (unsigned)(Rb * K + C) * 2u; }
    const size_t kstep = (size_t)(BK * 2);
    const size_t hstep = (size_t)HALF * K * 2;
    const size_t tstep = 2 * hstep;
    const unsigned ldsw = (unsigned)wid * 1024u;
    const int aoff = lds_byte(wr * 64 + fr, fq * 8), boff = lds_byte(wc * 32 + fr, fq * 8);
#define PG8_SA(b, h) (((b) * 2 + (h)) * HTB)
#define PG8_SB(b, h) ((4 + (b) * 2 + (h)) * HTB)
#define PG8_STAGE(bufoff, gbase, voff) do { _Pragma("unroll") for (int _i = 0; _i < 2; ++_i) \
        __builtin_amdgcn_global_load_lds((const unsigned*)((const char*)(gbase) + (voff)[_i]), (LAS unsigned*)(lds + (bufoff) + ldsw + _i * 8192), 16, 0, 0); } while (0)
#define PG8_LDA(dst, b, h) do { _Pragma("unroll") for (int m = 0; m < 4; ++m) _Pragma("unroll") for (int k = 0; k < 2; ++k) dst[m][k] = *(const LAS h8*)(lds + PG8_SA(b, h) + aoff + m * 2048 + k * 1024); } while (0)
#define PG8_LDB(dst, b, h) do { _Pragma("unroll") for (int n = 0; n < 2; ++n) _Pragma("unroll") for (int k = 0; k < 2; ++k) dst[n][k] = *(const LAS h8*)(lds + PG8_SB(b, h) + boff + n * 2048 + k * 1024); } while (0)
#define PG8_MMA(ai, bj, At, Bt) do { __builtin_amdgcn_s_setprio(1); _Pragma("unroll") for (int m = 0; m < 4; ++m) _Pragma("unroll") for (int n = 0; n < 2; ++n) _Pragma("unroll") for (int k = 0; k < 2; ++k) \
        acc[ai][bj][m][n] = __builtin_amdgcn_mfma_f32_16x16x32_f16(Bt[n][k], At[m][k], acc[ai][bj][m][n], 0, 0, 0); __builtin_amdgcn_s_setprio(0); } while (0)
#define PG8_WAIT_V(n) asm volatile("s_waitcnt vmcnt(" #n ")" ::: "memory")
#define PG8_WAIT_L(n) asm volatile("s_waitcnt lgkmcnt(" #n ")" ::: "memory")
#define PG8_BAR __builtin_amdgcn_s_barrier()
#define PG8_SCHED __builtin_amdgcn_sched_barrier(0)
    Unit cur, nxt; int ui = 0;
    if (!S.next(0, cur)) return;
    f32x4 acc[2][2][4][2];
    E.init(acc, cur, wr, wc, fr, fq);
    h8 At[4][2], B0[2][2], B1[2][2];
    const char* cA = (const char*)g.A + (size_t)cur.pm * tstep; const char* cB = (const char*)g.Bt + (size_t)cur.pn * tstep;
    S.a_ready(cur);
    {
        PG8_STAGE(PG8_SB(0, 0), cB, voffB); PG8_STAGE(PG8_SB(0, 1), cB + hstep, voffB); PG8_STAGE(PG8_SA(0, 0), cA, voffA); PG8_STAGE(PG8_SA(0, 1), cA + hstep, voffA);
        if (wr == 1) PG8_BAR;
        PG8_WAIT_V(2); PG8_BAR;
        PG8_STAGE(PG8_SB(1, 0), cB + kstep, voffB); PG8_STAGE(PG8_SA(1, 0), cA + kstep, voffA); PG8_STAGE(PG8_SB(1, 1), cB + hstep + kstep, voffB);
        PG8_WAIT_V(6); PG8_BAR;
    }
    for (;;) {
        const bool has_next = S.next(ui + 1, nxt);
        const char* nA = has_next ? (const char*)g.A + (size_t)nxt.pm * tstep : cA; const char* nB = has_next ? (const char*)g.Bt + (size_t)nxt.pn * tstep : cB;
        for (int t = 0; t < nt; t += 2) {
            const bool last = (t == nt - 2);
            const char* a1 = cA + (size_t)(t + 1) * kstep;
            const char* a2 = last ? nA : cA + (size_t)(t + 2) * kstep; const char* b2 = last ? nB : cB + (size_t)(t + 2) * kstep;
            const char* a3 = a2 + kstep; const char* b3 = b2 + kstep;
            if (last && has_next) S.a_ready(nxt);
            PG8_LDB(B0, 0, 0); PG8_LDB(B1, 0, 1); PG8_SCHED; PG8_LDA(At, 0, 0); PG8_STAGE(PG8_SA(1, 1), a1 + hstep, voffA);
            PG8_WAIT_V(8); PG8_WAIT_L(0); PG8_BAR; PG8_MMA(0, 0, At, B0); PG8_MMA(0, 1, At, B1); PG8_BAR; PG8_SCHED;
            PG8_LDA(At, 0, 1); PG8_STAGE(PG8_SB(0, 0), b2, voffB); PG8_STAGE(PG8_SB(0, 1), b2 + hstep, voffB); PG8_STAGE(PG8_SA(0, 0), a2, voffA);
            PG8_WAIT_V(8); PG8_WAIT_L(0); PG8_BAR; PG8_MMA(1, 0, At, B0); PG8_MMA(1, 1, At, B1); PG8_BAR; PG8_SCHED;
            PG8_LDB(B0, 1, 0); PG8_LDB(B1, 1, 1); PG8_SCHED; PG8_LDA(At, 1, 0); PG8_STAGE(PG8_SA(0, 1), a2 + hstep, voffA);
            PG8_WAIT_V(8); PG8_WAIT_L(0); PG8_BAR; PG8_MMA(0, 0, At, B0); PG8_MMA(0, 1, At, B1); PG8_BAR; PG8_SCHED;
            PG8_LDA(At, 1, 1); PG8_STAGE(PG8_SB(1, 0), b3, voffB); PG8_STAGE(PG8_SB(1, 1), b3 + hstep, voffB); PG8_STAGE(PG8_SA(1, 0), a3, voffA);
            PG8_WAIT_V(8); PG8_WAIT_L(0); PG8_BAR; PG8_MMA(1, 0, At, B0); PG8_MMA(1, 1, At, B1); PG8_BAR; PG8_SCHED;
        }
        if constexpr (ALIGN_EPI) { if (wr == 0) PG8_BAR; }
        if constexpr (!Epi::AFTER_DRAIN) { E(acc, cur, wr, wc, fr, fq); S.done(cur); }
        if (!has_next) break;
        E.init(acc, nxt, wr, wc, fr, fq);
        cur = nxt; cA = nA; cB = nB; ++ui;
        if constexpr (ALIGN_EPI) { if (wr == 1) PG8_BAR; }
    }
    PG8_WAIT_V(0);
    if constexpr (!ALIGN_EPI) { if (wr == 0) PG8_BAR; }
    PG8_BAR;
    if constexpr (Epi::AFTER_DRAIN) { E.fused(acc, cur, wr, wc, fr, fq, lds); S.done(cur); }
#undef PG8_SA
#undef PG8_SB
#undef PG8_STAGE
#undef PG8_LDA
#undef PG8_LDB
#undef PG8_MMA
#undef PG8_WAIT_V
#undef PG8_WAIT_L
#undef PG8_BAR
#undef PG8_SCHED
}

struct EpiProj {
    static constexpr bool PERM = true, AFTER_DRAIN = false;
    hf* O; const float* cosT; const float* sinT; float* kpart; f32x2* vstat; const float* rowss; hf* HM;
    __device__ __forceinline__ void init(f32x4 (&acc)[2][2][4][2], const Unit&, int, int, int, int) const {
#pragma unroll
        for (int a = 0; a < 2; ++a)
#pragma unroll
            for (int b = 0; b < 2; ++b)
#pragma unroll
                for (int m = 0; m < 4; ++m)
#pragma unroll
                    for (int n = 0; n < 2; ++n) acc[a][b][m][n] = (f32x4){0.f, 0.f, 0.f, 0.f};
    }
    template <int TYPE>
    __device__ __forceinline__ void run(const f32x4 (&acc)[2][2][4][2], const Unit& u, int wr, int wc, int fr, int fq, int hmi, int colbase) const {
        asm volatile("" : "+v"(fr), "+v"(fq));
        const int row0 = u.pm * BM + wr * 64 + fr, col0 = colbase + wc * 32 + 8 * fq;
        const int jj = 4 * wc + fq;
        if (TYPE >= 8) {
#pragma unroll
            for (int ai = 0; ai < 2; ++ai)
#pragma unroll
                for (int m = 0; m < 4; ++m) {
                    const int row = row0 + ai * HALF + m * 16;
                    const f32x4 pa = *(const f32x4*)(rowss + (size_t)row * 8), pb = *(const f32x4*)(rowss + (size_t)row * 8 + 4);
                    const float rsc = __builtin_amdgcn_rsqf(((pa[0] + pa[1]) + (pa[2] + pa[3]) + (pb[0] + pb[1]) + (pb[2] + pb[3])) * (1.0f / DM) + NORM_EPS);
#pragma unroll
                    for (int bj = 0; bj < 2; ++bj) {
                        const f32x4 v0 = acc[ai][bj][m][0] * rsc, v1 = acc[ai][bj][m][1] * rsc; f32x4 pr;
#pragma unroll
                        for (int i = 0; i < 4; ++i) pr[i] = (TYPE == 8 ? gelu_f(v0[i]) : v0[i]) * (TYPE == 10 ? v1[i] : silu_f(v1[i]));
                        *(h4*)(O + (size_t)row * NCOL + colbase + bj * 64 + wc * 16 + 4 * fq) = __builtin_convertvector(pr, h4);
                    }
                    asm volatile("" ::: "memory");
                }
            return;
        }
        f32x4 cs[2][2];
        if (TYPE == 3) {
#pragma unroll
            for (int bj = 0; bj < 2; ++bj)
#pragma unroll
                for (int n = 0; n < 2; ++n) cs[bj][n] = (f32x4){0.f, 0.f, 0.f, 0.f};
        }
        float rscv[8];
        {
            f32x4 pa[8], pb[8];
#pragma unroll
            for (int i = 0; i < 8; ++i) { const int row = row0 + (i >> 2) * HALF + (i & 3) * 16; pa[i] = *(const f32x4*)(rowss + (size_t)row * 8); pb[i] = *(const f32x4*)(rowss + (size_t)row * 8 + 4); }
#pragma unroll
            for (int i = 0; i < 8; ++i) rscv[i] = __builtin_amdgcn_rsqf(((pa[i][0] + pa[i][1]) + (pa[i][2] + pa[i][3]) + (pb[i][0] + pb[i][1]) + (pb[i][2] + pb[i][3])) * (1.0f / DM) + NORM_EPS);
        }
        f32x4 cv_n = (f32x4){1.f, 1.f, 1.f, 1.f}, sv_n = (f32x4){0.f, 0.f, 0.f, 0.f};
        if (TYPE >= 1 && TYPE <= 3) { const int t = row0 & (SEQ - 1); cv_n = *(const f32x4*)(cosT + t * 64 + 4 * jj); sv_n = *(const f32x4*)(sinT + t * 64 + 4 * jj); }
#pragma unroll
        for (int ai = 0; ai < 2; ++ai)
#pragma unroll
            for (int m = 0; m < 4; ++m) {
                const int row = row0 + ai * HALF + m * 16;
                hf* rowp = O + (size_t)row * NCOL + col0;
                const f32x4 cv = cv_n, sv = sv_n;
                if (TYPE >= 1 && TYPE <= 3 && (ai * 4 + m) < 7) {
                    const int in_ = ai * 4 + m + 1, t = (row0 + (in_ >> 2) * HALF + (in_ & 3) * 16) & (SEQ - 1);
                    cv_n = *(const f32x4*)(cosT + t * 64 + 4 * jj); sv_n = *(const f32x4*)(sinT + t * 64 + 4 * jj); }
                float s1 = 0.f, s2 = 0.f;
                const float rsc = rscv[ai * 4 + m];
#pragma unroll
                for (int bj = 0; bj < 2; ++bj) {
                    f32x4 v0 = acc[ai][bj][m][0] * rsc, v1 = acc[ai][bj][m][1] * rsc;
                    if (TYPE >= 1 && TYPE <= 3) {
                        const f32x4 r0 = v0 * cv - v1 * sv, r1 = v1 * cv + v0 * sv; v0 = r0; v1 = r1;
                        if (TYPE == 1) { v0 = v0 * QSCALE; v1 = v1 * QSCALE; }
                        if (TYPE == 3) { cs[bj][0] += v0; cs[bj][1] += v1; asm volatile("" : "+v"(cs[bj][0]), "+v"(cs[bj][1])); }
                    } else if (TYPE == 4 || TYPE == 5) {
#pragma unroll
                        for (int i = 0; i < 4; ++i) { v0[i] = gelu_f(v0[i]); v1[i] = gelu_f(v1[i]); }
                    } else if (TYPE == 6) {
#pragma unroll
                        for (int i = 0; i < 4; ++i) { v0[i] = silu_f(v0[i]); v1[i] = silu_f(v1[i]); }
                    } else if (TYPE == 7) { v0 = v0 * QSCALE; v1 = v1 * QSCALE; }
                    const h8 hv = pack8(v0, v1);
                    if (TYPE == 5) {
#pragma unroll
                        for (int i = 0; i < 8; ++i) { const float x = (float)hv[i]; s1 += x; s2 += x * x; }
                    }
                    if ((TYPE <= 3 || TYPE == 7) && hmi >= 0) {
                        const int hh = (u.pn & 1) * 2 + bj;
                        *(h8*)(HM + (size_t)hmi * NTOK * GW + ((size_t)((row >> 12) * 4 + hh) * SEQ + (row & (SEQ - 1))) * 128 + wc * 32 + 8 * fq) = hv;
                    } else *(h8*)(rowp + bj * HALF) = hv;
                }
                if (TYPE == 5) {
                    { const int ln_ = fq * 16 + fr; s1 += shx_l(s1, ln_, 16); s1 += shx_l(s1, ln_, 32); s2 += shx_l(s2, ln_, 16); s2 += shx_l(s2, ln_, 32); }
                    if (fq == 0) vstat[(size_t)row * 8 + (u.pn & 1) * 4 + wc] = (f32x2){s1, s2};
                }
                asm volatile("" ::: "memory");
            }
        if (TYPE == 3) {
#pragma unroll
            for (int bj = 0; bj < 2; ++bj)
#pragma unroll
                for (int n = 0; n < 2; ++n) {
                    f32x4 c = cs[bj][n];
#pragma unroll
                    for (int o = 1; o < 16; o <<= 1) { const int ln_ = fq * 16 + fr; c[0] += shx_l(c[0], ln_, o); c[1] += shx_l(c[1], ln_, o); c[2] += shx_l(c[2], ln_, o); c[3] += shx_l(c[3], ln_, o); }
                    if (fr == 0) *(f32x4*)(kpart + (size_t)(u.pm * 2 + wr) * GW + (u.pn & 1) * BM + bj * HALF + wc * 32 + 8 * fq + 4 * n) = c;
                }
        }
    }
    __device__ __forceinline__ void operator()(const f32x4 (&acc)[2][2][4][2], const Unit& u, int wr, int wc, int fr, int fq) const {
        const int pn = u.pn, slice = pn >> 1, cb = pn * BM;
        if (pn >= 8 && pn < 12) run<8>(acc, u, wr, wc, fr, fq, -1, SL_BU * GW + (pn - 8) * 128);
        else if (pn == 12 || pn == 13) run<5>(acc, u, wr, wc, fr, fq, -1, SL_BV * GW + (pn - 12) * BM);
        else if (pn >= 22 && pn < 26) run<9>(acc, u, wr, wc, fr, fq, -1, SL_DB * GW + (pn - 22) * 128);
        else if (pn >= 26 && pn < 30) run<10>(acc, u, wr, wc, fr, fq, -1, SL_DC * GW + (pn - 26) * 128);
        else if (slice == SL_AQ || slice == SL_CQ) run<1>(acc, u, wr, wc, fr, fq, slice == SL_AQ ? 0 : 3, cb);
        else if (slice == SL_AK) run<2>(acc, u, wr, wc, fr, fq, 1, cb);
        else if (slice == SL_CK) run<3>(acc, u, wr, wc, fr, fq, 4, cb);
        else if (slice == SL_AG || slice == SL_CG || slice == SL_XG) run<6>(acc, u, wr, wc, fr, fq, -1, cb);
        else if (slice == SL_XQ) run<7>(acc, u, wr, wc, fr, fq, 6, cb);
        else run<0>(acc, u, wr, wc, fr, fq, slice == SL_AV ? 2 : (slice == SL_CV ? 5 : -1), cb);
    }
};
struct EpiRes {
    static constexpr bool PERM = false, AFTER_DRAIN = true;
    const float* res32; const hf* res16; hf* out16; float* rowss; float* out32; const float* gfin; unsigned* pcnt;
    __device__ __forceinline__ void init(f32x4 (&acc)[2][2][4][2], const Unit& u, int wr, int wc, int fr, int fq) const {
        asm volatile("" : "+v"(fr), "+v"(fq));
        const int row0 = u.pm * BM + wr * 64 + fr, col0 = u.pn * BM + wc * 32 + 4 * fq;
#pragma unroll
        for (int ai = 0; ai < 2; ++ai)
#pragma unroll
            for (int m = 0; m < 4; ++m) { const size_t off = (size_t)(row0 + ai * HALF + m * 16) * DM + col0;
#pragma unroll
                for (int bj = 0; bj < 2; ++bj)
#pragma unroll
                    for (int n = 0; n < 2; ++n) {
                        if (res32 != nullptr) acc[ai][bj][m][n] = __builtin_nontemporal_load((const f32x4*)(res32 + off + bj * HALF + n * 16));
                        else acc[ai][bj][m][n] = __builtin_convertvector(__builtin_nontemporal_load((const h4*)(res16 + off + bj * HALF + n * 16)), f32x4); } }
    }
    __device__ __forceinline__ void fused(const f32x4 (&acc)[2][2][4][2], const Unit& u, int wr, int wc, int fr, int fq, LAS unsigned char* lds) const {
        asm volatile("" : "+v"(fr), "+v"(fq));
        const int row0 = u.pm * BM + wr * 64 + fr, col0 = u.pn * BM + wc * 32 + 4 * fq;
        LAS float* red = (LAS float*)lds;
#pragma unroll
        for (int ai = 0; ai < 2; ++ai)
#pragma unroll
            for (int m = 0; m < 4; ++m) { const size_t off = (size_t)(row0 + ai * HALF + m * 16) * DM + col0; float ss = 0.f;
#pragma unroll
                for (int bj = 0; bj < 2; ++bj)
#pragma unroll
                    for (int n = 0; n < 2; ++n) { const f32x4 o = acc[ai][bj][m][n];
                        if (out32 == nullptr) *(h4*)(out16 + off + bj * HALF + n * 16) = __builtin_convertvector(o, h4);
                        ss += (o[0] * o[0] + o[1] * o[1]) + (o[2] * o[2] + o[3] * o[3]); }
                { const int ln_ = fq * 16 + fr; ss += shx_l(ss, ln_, 16); ss += shx_l(ss, ln_, 32); } if (fq == 0) red[(wr * 64 + ai * HALF + m * 16 + fr) * 4 + wc] = ss;
                asm volatile("" ::: "memory"); }
        __syncthreads();
        int t = threadIdx.x; asm volatile("" : "+v"(t));
        if (t < 256) { const f32x4 p = *(const LAS f32x4*)(red + t * 4); __hip_atomic_store(&rowss[(size_t)(u.pm * BM + t) * 8 + u.pn], (p[0] + p[1]) + (p[2] + p[3]), __ATOMIC_RELAXED, __HIP_MEMORY_SCOPE_AGENT); }
        if (out32 != nullptr) {
            asm volatile("s_waitcnt vmcnt(0)" ::: "memory");
            __syncthreads();
            if (t == 0) {
                __hip_atomic_fetch_add(pcnt + u.pm, 1u, __ATOMIC_RELAXED, __HIP_MEMORY_SCOPE_AGENT);
                unsigned sp = 0u;
                while (__hip_atomic_load(pcnt + u.pm, __ATOMIC_RELAXED, __HIP_MEMORY_SCOPE_AGENT) < 8u) { __builtin_amdgcn_s_sleep(1); if (++sp > (1u << 22)) break; }
                __builtin_amdgcn_fence(__ATOMIC_ACQUIRE, "agent"); asm volatile("s_waitcnt vmcnt(0)" ::: "memory");
            }
            __syncthreads();
#pragma unroll
            for (int ai = 0; ai < 2; ++ai)
#pragma unroll
                for (int m = 0; m < 4; ++m) { const int row = row0 + ai * HALF + m * 16; const size_t off = (size_t)row * DM + col0;
                    const f32x4 pa = *(const f32x4*)(rowss + (size_t)row * 8), pb = *(const f32x4*)(rowss + (size_t)row * 8 + 4);
                    const float r = __builtin_amdgcn_rsqf(((pa[0] + pa[1]) + (pa[2] + pa[3]) + (pb[0] + pb[1]) + (pb[2] + pb[3])) * (1.0f / DM) + NORM_EPS);
#pragma unroll
                    for (int bj = 0; bj < 2; ++bj)
#pragma unroll
                        for (int n = 0; n < 2; ++n) { const f32x4 gg = *(const f32x4*)(gfin + col0 + bj * HALF + n * 16);
                            __builtin_nontemporal_store(acc[ai][bj][m][n] * r * gg, (f32x4*)(out32 + off + bj * HALF + n * 16)); }
                    asm volatile("" ::: "memory"); }
        }
    }
};
}

namespace att {
constexpr int NWV = 8, QBLK = 32, KVBLK = 64, QB = NWV * QBLK, D = 128;
constexpr int SHM_V = KVBLK * D * 2, SHM_K = KVBLK * D * 2;
constexpr int LDS_WS = 2 * SHM_V + 2 * SHM_K;
constexpr int LDS_KSUM = LDS_WS + NWV * 96 * 4;
constexpr int LDS_BYTES_ATT = LDS_KSUM + 16 * 128 * 4;
constexpr float THR2 = 11.5f;
typedef float f32x16 __attribute__((ext_vector_type(16)));
typedef short s16x8 __attribute__((ext_vector_type(8)));
typedef _Float16 h2 __attribute__((ext_vector_type(2)));
#define KSWZ(row, colB) ((row) * 256 + ((colB) ^ (((row) & 7) << 4)))
#define SBAR() __builtin_amdgcn_sched_barrier(0)
__device__ __forceinline__ int v_st(int k, int c) { const int kk = (k & ~0xC) | ((k & 4) << 1) | ((k & 8) >> 1); return ((kk >> 3) * 4 + (c >> 5)) * 512 + ((kk & 7) * 32 + (c & 31)) * 2; }
__device__ __forceinline__ int v_rd_base(int lane) { return ((lane & 3) << 3) | (((lane >> 2) & 3) << 6) | (((lane >> 4) & 1) << 5) | (((lane >> 5) & 1) << 8); }
constexpr int v_rd_off(int d0, int ks, int half) { return d0 * 512 + ks * 4096 + half * 2048; }
__device__ __forceinline__ int crow(int r, int hi) { return (r & 3) + 8 * (r >> 2) + 4 * hi; }
__device__ __forceinline__ unsigned cvtpk(float lo, float hi) { const f32x2 v = {lo, hi}; const h2 b = __builtin_convertvector(v, h2); return __builtin_bit_cast(unsigned, b); }
__device__ __forceinline__ void mask_tile(f32x16& p0, f32x16& p1, int dq, unsigned W) {
    const float NEG = -__builtin_inff();
#pragma unroll
    for (int r = 0; r < 16; ++r) {
        const int c = (r & 3) + 8 * (r >> 2);
        if ((unsigned)(dq - c) >= W) p0[r] = NEG;
        if ((unsigned)(dq - c - 32) >= W) p1[r] = NEG;
    }
}
__device__ __forceinline__ void partialSM(f32x16& p0, f32x16& p1, float& m_reg, float& mn, float& alpha) {
    float pmax = p0[0];
#pragma unroll
    for (int r = 1; r < 16; ++r) pmax = fmaxf(pmax, p0[r]);
#pragma unroll
    for (int r = 0; r < 16; ++r) pmax = fmaxf(pmax, p1[r]);
    { auto rr = __builtin_amdgcn_permlane32_swap(__float_as_uint(pmax), __float_as_uint(pmax), false, false);
      pmax = fmaxf(__uint_as_float(rr[0]), __uint_as_float(rr[1])); }
    mn = ((pmax - m_reg) <= THR2) ? m_reg : fmaxf(m_reg, pmax); alpha = __builtin_amdgcn_exp2f(m_reg - mn); m_reg = mn;
#pragma unroll
    for (int r = 0; r < 16; ++r) p0[r] = p0[r] - mn;
#pragma unroll
    for (int r = 0; r < 16; ++r) p1[r] = p1[r] - mn;
#pragma unroll
    for (int r = 0; r < 16; ++r) p0[r] = __builtin_amdgcn_exp2f(p0[r]);
}
__device__ __forceinline__ void finishSM(f32x16& p0, f32x16& p1, float alpha, float& l_reg, h8& pa0, h8& pa1, h8& pa2, h8& pa3) {
#pragma unroll
    for (int r = 0; r < 16; ++r) p1[r] = __builtin_amdgcn_exp2f(p1[r]);
    float ps = 0;
#pragma unroll
    for (int r = 0; r < 16; ++r) ps += p0[r];
#pragma unroll
    for (int r = 0; r < 16; ++r) ps += p1[r];
    { auto rr = __builtin_amdgcn_permlane32_swap(__float_as_uint(ps), __float_as_uint(ps), false, false);
      ps = __uint_as_float(rr[0]) + __uint_as_float(rr[1]); }
    l_reg = l_reg * alpha + ps;
#define PK4(P, B_, OUT) do { unsigned a0 = cvtpk(P[B_+0], P[B_+1]), a1 = cvtpk(P[B_+2], P[B_+3]);                          \
        unsigned b0 = cvtpk(P[B_+4], P[B_+5]), b1 = cvtpk(P[B_+6], P[B_+7]);                                             \
        auto r0 = __builtin_amdgcn_permlane32_swap(a0, b0, false, false); auto r1 = __builtin_amdgcn_permlane32_swap(a1, b1, false, false); \
        u32x4 w = {r0[0], r1[0], r0[1], r1[1]}; OUT = __builtin_bit_cast(h8, w); } while (0)
    PK4(p0, 0, pa0); PK4(p0, 8, pa1); PK4(p1, 0, pa2); PK4(p1, 8, pa3);
#undef PK4
}
template <int KB>
__device__ __forceinline__ void qkt(f32x16& p0, f32x16& p1, const LAS char* K_lds, int r32, int hi, const h8* qr, bool act) {
    if (!act) { const float NEG = -__builtin_inff();
#pragma unroll
        for (int r = 0; r < 16; ++r) { p0[r] = NEG; p1[r] = NEG; } return; }
    p0 = f32x16{}; p1 = f32x16{};
    const LAS char* kb[4];
#pragma unroll
    for (int dd = 0; dd < 4; ++dd) kb[dd] = K_lds + KB * SHM_K + KSWZ(r32, (dd * 16 + hi * 8) * 2);
#pragma unroll
    for (int d0 = 0; d0 < 8; ++d0) { const LAS char* a = kb[d0 & 3] + (d0 >> 2) * 128;
        const h8 b0 = *reinterpret_cast<const LAS h8*>(a);
        const h8 b1 = *reinterpret_cast<const LAS h8*>(a + 32 * 256);
        p0 = __builtin_amdgcn_mfma_f32_32x32x16_f16(b0, qr[d0], p0, 0, 0, 0);
        p1 = __builtin_amdgcn_mfma_f32_32x32x16_f16(b1, qr[d0], p1, 0, 0, 0); }
}
template <int VB>
__device__ __forceinline__ void pv_tile(f32x16* o, int vb0, h8 pa0, h8 pa1, h8 pa2, h8 pa3, bool act) {
    if (!act) return;
#define TRRD(dst, off) asm volatile("ds_read_b64_tr_b16 %0, %1 offset:%2" : "=&v"(dst) : "v"(vb0), "i"(off) : "memory")
#define MKH8(l, h) __builtin_bit_cast(h8, (s16x8){l[0], l[1], l[2], l[3], h[0], h[1], h[2], h[3]})
#define PV_D0(d0) do { s16x4 l0, l1, l2, l3, h0, h1, h2, h3; constexpr int b_ = VB * SHM_V + v_rd_off(d0, 0, 0); \
        TRRD(l0, b_); TRRD(h0, b_ + 2048); TRRD(l1, b_ + 4096); TRRD(h1, b_ + 6144); TRRD(l2, b_ + 8192); TRRD(h2, b_ + 10240); TRRD(l3, b_ + 12288); TRRD(h3, b_ + 14336); \
        asm volatile("s_waitcnt lgkmcnt(0)" ::: "memory"); SBAR();   \
        o[d0] = __builtin_amdgcn_mfma_f32_32x32x16_f16(pa0, MKH8(l0, h0), o[d0], 0, 0, 0);   \
        o[d0] = __builtin_amdgcn_mfma_f32_32x32x16_f16(pa1, MKH8(l1, h1), o[d0], 0, 0, 0);   \
        o[d0] = __builtin_amdgcn_mfma_f32_32x32x16_f16(pa2, MKH8(l2, h2), o[d0], 0, 0, 0);   \
        o[d0] = __builtin_amdgcn_mfma_f32_32x32x16_f16(pa3, MKH8(l3, h3), o[d0], 0, 0, 0); } while (0)
    PV_D0(0); PV_D0(1); PV_D0(2); PV_D0(3);
#undef PV_D0
#undef MKH8
#undef TRRD
}
struct BlkRef { const hf* Q; const hf* K; const hf* V; hf* O; float* LSE; const unsigned* list; int qs, ks, os, ls; int P0, W, j_lo, j_hi, cnt; };
struct NxtRef { const hf* Q; const hf* K; const hf* V; const unsigned* list; int qs, ks, j_lo, cnt; };
struct Seam { h8 qr[8]; h8 st_v0, st_v1, st_k0, st_k1; unsigned ent; };
__device__ __forceinline__ long q_row_of(const unsigned* list, int cnt, int idx, unsigned& ent) {
    ent = 0xFFFFFFFFu; if (list == nullptr) return idx;
    if (idx < cnt) ent = list[idx];
    return ent == 0xFFFFFFFFu ? 0 : (long)(ent & 0xFFFFu);
}
#define ROWP(p, st, k0, rr) ((p) + (long)((k0) + (rr)) * (st) + sc)
#define VMW() asm volatile("s_waitcnt vmcnt(0)" ::: "memory")
#define VMWN(n) asm volatile("s_waitcnt vmcnt(%0)" :: "i"(n) : "memory")
#define SLOAD_H(Kp, Vp, st, k0) do { S.st_v0 = *(const h8*)ROWP(Vp, st, k0, sr); S.st_v1 = *(const h8*)ROWP(Vp, st, k0, 32 + sr);              \
                         S.st_k0 = *(const h8*)ROWP(Kp, st, k0, sr); S.st_k1 = *(const h8*)ROWP(Kp, st, k0, 32 + sr); } while (0)
#define SWRITE_HK(bf) do { *(LAS h8*)(K_lds + (bf) * SHM_K + kws) = S.st_k0; *(LAS h8*)(K_lds + (bf) * SHM_K + kws + 32 * 256) = S.st_k1; } while (0)
#define SWRITE_HV(bf) do { *(LAS h8*)(V_lds + (bf) * SHM_V + vst0) = S.st_v0; *(LAS h8*)(V_lds + (bf) * SHM_V + vst1) = S.st_v1; } while (0)
#define SWRITE_H(bf) do { SWRITE_HV(bf); SWRITE_HK(bf); } while (0)
__device__ __forceinline__ void blk_prime(const BlkRef& cur, LAS char* lds, Seam& S) {
    int tid = threadIdx.x; asm volatile("" : "+v"(tid));
    const int wid = __builtin_amdgcn_readfirstlane(tid >> 6), lane = tid & 63, r32 = lane & 31, hi = lane >> 5;
    const int sr = tid >> 4, sc = (tid & 15) * 8, kws = KSWZ(sr, sc * 2); LAS char* K_lds = lds + 2 * SHM_V;
    const int kb0 = cur.j_lo * KVBLK;
    { const long qrow = q_row_of(cur.list, cur.cnt, wid * QBLK + r32, S.ent);
#pragma unroll
      for (int d0 = 0; d0 < 8; ++d0) S.qr[d0] = *(const h8*)(cur.Q + qrow * cur.qs + d0 * 16 + hi * 8); }
    SLOAD_H(cur.K, cur.V, cur.ks, kb0); VMW(); SWRITE_HK(0);
    __syncthreads();
}
__device__ __forceinline__ void blk_run(const BlkRef& cur, const NxtRef& nxt, LAS char* lds, Seam& S, unsigned tk, volatile LAS int* qw, int qbase) {
    int tid = threadIdx.x; asm volatile("" : "+v"(tid));
    const int wid = __builtin_amdgcn_readfirstlane(tid >> 6), lane = tid & 63, r32 = lane & 31, hi = lane >> 5;
    const int j_lo = cur.j_lo, NT = cur.j_hi - cur.j_lo, W = cur.W;
    const int kbn = nxt.j_lo * KVBLK;
    const int qlo = cur.P0 + wid * QBLK, qm = qlo + r32 - 4 * hi;
    LAS char* V_lds = lds; LAS char* K_lds = lds + 2 * SHM_V;
    LAS float* ws = (LAS float*)(lds + LDS_WS) + wid * 96; LAS float* li_l = ws; LAS float* al_l = ws + 32;
    float m_reg = -1e30f, l_reg = 0; f32x16 o[4] = {}; int epi_r32;
    const int sr = tid >> 4, sc = (tid & 15) * 8, vst0 = v_st(sr, sc), vst1 = v_st(32 + sr, sc), kws = KSWZ(sr, sc * 2);
    const int vb0 = (int)(unsigned)(uintptr_t)V_lds + v_rd_base(lane);
    const hf* Kh = cur.K; const hf* Vh = cur.V; const int kst = cur.ks;
    const unsigned ent_cur = S.ent;
    LAS unsigned* rt_l = (LAS unsigned*)(ws + 64);
    if (cur.list != nullptr && hi == 0) rt_l[r32] = ent_cur;
#define RESC(a) do { if (__any((a) < 1.f)) { if (hi == 0) al_l[r32] = (a); asm volatile("s_waitcnt lgkmcnt(0)" ::: "memory");              \
                     for (int d_ = 0; d_ < 4; ++d_) for (int r = 0; r < 16; ++r) o[d_][r] *= al_l[crow(r, hi)]; } } while (0)
#define KBASE(t) ((j_lo + (t)) * KVBLK)
#define ACT(t) (KBASE(t) <= qlo + QBLK - 1 && KBASE(t) + KVBLK - 1 >= qlo - W + 1)
#define MASKT(P0_, P1_, t) do { const int kb_ = KBASE(t); if (ACT(t) && (kb_ + KVBLK - 1 > qlo || kb_ <= qlo + QBLK - 1 - W)) mask_tile(P0_, P1_, qm - kb_, (unsigned)W); } while (0)
    constexpr int NQL = 8;
#define SEAM_K0() do { VMWN(NQL); SWRITE_HK(0); SBAR(); } while (0)
    f32x16 pA0, pA1, pB0, pB1; float mnA, mnB, alA, alB; h8 pa0, pa1, pa2, pa3;
    SWRITE_HV(0); SBAR();
    if (NT > 1) { SLOAD_H(Kh, Vh, kst, KBASE(1)); }
    SBAR(); qkt<0>(pA0, pA1, K_lds, r32, hi, S.qr, ACT(0));
    if (ACT(0)) { MASKT(pA0, pA1, 0); partialSM(pA0, pA1, m_reg, mnA, alA); } else { mnA = m_reg; alA = 1.f; }
    if (NT > 1) { VMW(); SWRITE_H(1); SBAR(); }
    if (NT > 2) { SLOAD_H(Kh, Vh, kst, KBASE(2)); SBAR(); }
    __syncthreads();
#define HALF_STEP(PX0, PX1, mnX, alX, PY0, PY1, alY, t, KB, VB, SB) do {                                                      \
        SBAR(); qkt<KB>(PX0, PX1, K_lds, r32, hi, S.qr, ACT(t));                                             \
        if (ACT((t) - 1)) finishSM(PY0, PY1, alY, l_reg, pa0, pa1, pa2, pa3); SBAR();                                         \
        pv_tile<VB>(o, vb0, pa0, pa1, pa2, pa3, ACT((t) - 1));                                                                \
        if (ACT(t)) { MASKT(PX0, PX1, (t)); partialSM(PX0, PX1, m_reg, mnX, alX); } else { mnX = m_reg; alX = 1.f; }          \
        __syncthreads();                                                                                                      \
        if ((t) + 1 < NT) { VMW(); SWRITE_H(SB); SBAR(); }                                                                  \
        if ((t) + 2 < NT) { SLOAD_H(Kh, Vh, kst, KBASE((t) + 2)); SBAR(); }                                               \
        RESC(alX); __syncthreads(); } while (0)
    for (int t = 1; t + 1 < NT; t += 2) {
        HALF_STEP(pB0, pB1, mnB, alB, pA0, pA1, alA, t, 1, 0, 0);
        HALF_STEP(pA0, pA1, mnA, alA, pB0, pB1, alB, t + 1, 0, 1, 1);
    }
    const bool even = (NT & 1) == 0;
    if (even) { SBAR(); qkt<1>(pB0, pB1, K_lds, r32, hi, S.qr, ACT(NT - 1)); SBAR(); }
    { SLOAD_H(nxt.K, nxt.V, nxt.ks, kbn); SBAR();
      const long qrow = q_row_of(nxt.list, nxt.cnt, wid * QBLK + r32, S.ent);
#pragma unroll
      for (int d0 = 0; d0 < 8; ++d0) S.qr[d0] = *(const h8*)(nxt.Q + qrow * nxt.qs + d0 * 16 + hi * 8); }
    SBAR();
    if (ACT(even ? NT - 2 : NT - 1)) finishSM(pA0, pA1, alA, l_reg, pa0, pa1, pa2, pa3); SBAR();
    pv_tile<0>(o, vb0, pa0, pa1, pa2, pa3, ACT(even ? NT - 2 : NT - 1));
    if (even) { if (ACT(NT - 1)) { MASKT(pB0, pB1, NT - 1); partialSM(pB0, pB1, m_reg, mnB, alB); } else { mnB = m_reg; alB = 1.f; } __syncthreads(); RESC(alB);
        if (ACT(NT - 1)) finishSM(pB0, pB1, alB, l_reg, pa0, pa1, pa2, pa3); SBAR(); pv_tile<1>(o, vb0, pa0, pa1, pa2, pa3, ACT(NT - 1)); }
    SBAR(); SEAM_K0();
    if (hi == 0) li_l[r32] = l_reg; asm volatile("s_waitcnt lgkmcnt(0)" ::: "memory");
    { int lane_e = lane; asm volatile("" : "+v"(lane_e)); epi_r32 = lane_e & 31; }
    float rli[16];
#pragma unroll
    for (int r = 0; r < 16; ++r) { const float lv = li_l[crow(r, hi)]; rli[r] = lv > 0.f ? __builtin_amdgcn_rcpf(lv) : 0.f; }
    __syncthreads();
    {
        LAS char* ost = V_lds + wid * 4096;
        const bool odd = (epi_r32 & 1) != 0;
        const bool gat = cur.list != nullptr;
        hf* Ow = cur.O + (long)(wid * QBLK) * cur.os;
#pragma unroll
        for (int ps = 0; ps < 2; ++ps) {
#pragma unroll
            for (int r = 0; r < 16; ++r) {
                const float va = o[2 * ps][r] * rli[r], vb = o[2 * ps + 1][r] * rli[r];
                const float got = shx_l(odd ? va : vb, hi * 32 + epi_r32, 1);
                const unsigned w = odd ? cvtpk(got, vb) : cvtpk(va, got);
                *(LAS unsigned*)(ost + crow(r, hi) * 128 + (odd ? 64 : 0) + (epi_r32 & ~1) * 2) = w;
            }
            asm volatile("s_waitcnt lgkmcnt(0)" ::: "memory");
#pragma unroll
            for (int it = 0; it < 4; ++it) {
                const int idx = it * 64 + (hi * 32 + epi_r32), row = idx >> 3, ch = idx & 7;
                const u32x4 v = *(const LAS u32x4*)(ost + row * 128 + ch * 16);
                if (!gat) *(u32x4*)(Ow + (long)row * cur.os + ps * 64 + ch * 8) = v;
                else { const unsigned e = rt_l[row]; if (e != 0xFFFFFFFFu) *(u32x4*)(cur.O + ((long)(e >> 16) * NTOK + (long)(e & 0xFFFFu)) * GW + ps * 64 + ch * 8) = v; }
            }
            asm volatile("s_waitcnt lgkmcnt(0)" ::: "memory");
        }
        if (!gat) { if (cur.LSE != nullptr && hi == 0) cur.LSE[(long)(wid * QBLK + epi_r32) * cur.ls] = l_reg > 0.f ? m_reg + __builtin_amdgcn_logf(l_reg) : -1e30f; }
        else if (hi == 0 && ent_cur != 0xFFFFFFFFu) cur.LSE[((long)(ent_cur >> 16) * NTOK + (long)(ent_cur & 0xFFFFu)) * 4] = l_reg > 0.f ? m_reg + __builtin_amdgcn_logf(l_reg) : -1e30f;
    }
    if (tid == 0) qw[0] = qbase + (int)tk;
    __syncthreads();
#undef RESC
#undef KBASE
#undef ACT
#undef MASKT
#undef SEAM_K0
#undef HALF_STEP
}
#undef ROWP
#undef VMW
#undef VMWN
#undef SLOAD_H
#undef SWRITE_HK
#undef SWRITE_HV
#undef SWRITE_H
#undef KSWZ
#undef SBAR
}

constexpr int VROW = 288;
constexpr int WAVE_LDS = 10240;
constexpr int NG = 1;
constexpr int QW = 16 * NG;
constexpr int NPH = SEQ / QW;

__device__ __forceinline__ void load_q(h8 (&qf)[NG][4], const hf* qb, long qstride, int fr, int quad) {
#pragma unroll
    for (int g = 0; g < NG; ++g) { const hf* p = qb + (long)(16 * g + fr) * qstride + 8 * quad;
#pragma unroll
        for (int c = 0; c < 4; ++c) qf[g][c] = *(const h8*)(p + 32 * c); }
}
__device__ __forceinline__ void v_stage_load(h8 (&vs)[8], const hf* Vt, long stride, int rlo, int rhi, int fr, int quad) {
#pragma unroll
    for (int it = 0; it < 8; ++it) { int r = 4 * it + quad; r = r < rlo ? rlo : r; r = r > rhi ? rhi : r; vs[it] = *(const h8*)(Vt + (long)r * stride + 8 * fr); }
}
__device__ __forceinline__ void v_stage_store(const h8 (&vs)[8], LAS unsigned char* vl, int fr, int quad) {
#pragma unroll
    for (int it = 0; it < 8; ++it) *(LAS h8*)(vl + (4 * it + quad) * VROW + fr * 16) = vs[it];
}
__device__ __forceinline__ void pv_mma(f32x4 (&o)[NG][8], const h8 (&pf)[NG], LAS unsigned char* vl, int fr, int quad) {
    LAS unsigned char* base = vl + (4 * quad + (fr >> 2)) * VROW + 8 * (fr & 3);
#pragma unroll
    for (int dt = 0; dt < 8; ++dt) {
        const s16x4 a = __builtin_amdgcn_ds_read_tr16_b64_v4i16((LAS s16x4*)(base + 32 * dt));
        const s16x4 b = __builtin_amdgcn_ds_read_tr16_b64_v4i16((LAS s16x4*)(base + 16 * VROW + 32 * dt));
        const h4 x = __builtin_bit_cast(h4, a), y = __builtin_bit_cast(h4, b);
        const h8 vf = __builtin_shufflevector(x, y, 0, 1, 2, 3, 4, 5, 6, 7);
#pragma unroll
        for (int g = 0; g < NG; ++g) o[g][dt] = __builtin_amdgcn_mfma_f32_16x16x32_f16(vf, pf[g], o[g][dt], 0, 0, 0);
    }
}
struct AttnAcc { f32x4 o[NG][8]; float m[NG], l[NG]; };
__device__ __forceinline__ void attn_init(AttnAcc& a) {
#pragma unroll
    for (int g = 0; g < NG; ++g) { a.m[g] = -1e30f; a.l[g] = 0.f;
#pragma unroll
        for (int dt = 0; dt < 8; ++dt) a.o[g][dt] = (f32x4){0.f, 0.f, 0.f, 0.f}; }
}
template <class Mask>
__device__ __forceinline__ void attn_step(AttnAcc& a, const h8 (&qf)[NG][4], const hf* Kt, const hf* Vt, long stride, int rlo, int rhi, LAS unsigned char* vl, int fr, int quad, Mask mask) {
    __builtin_amdgcn_sched_barrier(0);
    f32x4 s[NG][2];
    {
        h8 kf[2][4];
#pragma unroll
        for (int kb = 0; kb < 2; ++kb) { int r = 16 * kb + fr; r = r < rlo ? rlo : r; r = r > rhi ? rhi : r; const hf* p = Kt + (long)r * stride + 8 * quad;
#pragma unroll
            for (int c = 0; c < 4; ++c) kf[kb][c] = *(const h8*)(p + 32 * c); }
#pragma unroll
        for (int g = 0; g < NG; ++g)
#pragma unroll
            for (int kb = 0; kb < 2; ++kb) { s[g][kb] = (f32x4){0.f, 0.f, 0.f, 0.f};
#pragma unroll
                for (int c = 0; c < 4; ++c) s[g][kb] = __builtin_amdgcn_mfma_f32_16x16x32_f16(kf[kb][c], qf[g][c], s[g][kb], 0, 0, 0); }
    }
    h8 vs[8];
    v_stage_load(vs, Vt, stride, rlo, rhi, fr, quad);
    h8 pf[NG];
#pragma unroll
    for (int g = 0; g < NG; ++g) {
        float mx = -3e38f;
#pragma unroll
        for (int kb = 0; kb < 2; ++kb)
#pragma unroll
            for (int r = 0; r < 4; ++r) { const float v = mask(g, kb, r) ? s[g][kb][r] : -3e38f; s[g][kb][r] = v; mx = fmaxf(mx, v); }
        { const int ln_ = quad * 16 + fr; mx = fmaxf(mx, shx_l(mx, ln_, 16)); mx = fmaxf(mx, shx_l(mx, ln_, 32)); }
        const float mn = fmaxf(a.m[g], mx), alpha = __builtin_amdgcn_exp2f(a.m[g] - mn);
        a.m[g] = mn; a.l[g] *= alpha;
#pragma unroll
        for (int dt = 0; dt < 8; ++dt) a.o[g][dt] = a.o[g][dt] * alpha;
        f32x4 p0, p1; float ps = 0.f;
#pragma unroll
        for (int r = 0; r < 4; ++r) { p0[r] = __builtin_amdgcn_exp2f(s[g][0][r] - mn); p1[r] = __builtin_amdgcn_exp2f(s[g][1][r] - mn); ps += p0[r] + p1[r]; }
        a.l[g] += ps;
        pf[g] = pack8(p0, p1);
    }
    v_stage_store(vs, vl, fr, quad);
    pv_mma(a.o, pf, vl, fr, quad);
    __builtin_amdgcn_sched_barrier(0);
}
__device__ __forceinline__ void attn_finish(AttnAcc& a, hf* ob, long ostride, float* lsep, long lstride, int fr, int quad) {
#pragma unroll
    for (int g = 0; g < NG; ++g) {
        float lt = a.l[g]; { const int ln_ = quad * 16 + fr; lt += shx_l(lt, ln_, 16); lt += shx_l(lt, ln_, 32); }
        const float inv = lt > 0.f ? 1.0f / lt : 0.f;
        hf* p = ob + (long)(16 * g + fr) * ostride + 4 * quad;
#pragma unroll
        for (int dt = 0; dt < 8; ++dt) { const f32x4 v = a.o[g][dt] * inv; *(h4*)(p + 16 * dt) = __builtin_convertvector(v, h4); }
        if (lsep != nullptr && quad == 0) lsep[(long)(16 * g + fr) * lstride] = lt > 0.f ? a.m[g] + __builtin_log2f(lt) : -1e30f;
    }
}

struct MixP {
    const hf* proj; const hf* kvmem; hf* oa; float* lsea; hf* ob; hf* ocp; float* lsec; hf* ox;
    const float* kpart; const f32x2* vstat; const hf* sguw; const float* sgurs; const float* sgub; const float* lng; const float* lnb;
};
constexpr int N_A = 3 * 8 * NPH, N_X = 8 * NPH, N_C = 40 * 8 * (256 / QW), N_B = 2 * 32 * 4 * (128 / QW);

__device__ __forceinline__ void item_A(const MixP& P, int idx, LAS unsigned char* vl, int fr, int quad) {
    asm volatile("" : "+v"(fr), "+v"(quad));
    const int p = idx / (8 * NPH), r10 = idx % (8 * NPH), b = r10 / (4 * NPH), h = (r10 / NPH) & 3, slot = r10 % NPH;
    const int dsh = 2 * p, d = 1 << dsh, cpr = NPH >> dsh, Lsub = SEQ >> dsh;
    const int res = slot / cpr, ch = slot % cpr, l0 = QW * ch;
    const long rowbase = (long)b * SEQ + res, stride = (long)d * NCOL;
    h8 qf[NG][4];
    load_q(qf, P.proj + (rowbase + (long)l0 * d) * NCOL + SL_AQ * GW + h * 128, stride, fr, quad);
    const hf* Kb = P.proj + rowbase * NCOL + SL_AK * GW + h * 128;
    const hf* Vb = P.proj + rowbase * NCOL + SL_AV * GW + h * 128;
    AttnAcc a; attn_init(a);
    constexpr int NST = (128 + QW + 31) / 32;
    for (int s = NST - 1; s >= 0; --s) {
        const int lk0 = l0 - 128 + 32 * s;
        if (lk0 + 31 < 0) break;
        const int rlo = lk0 < 0 ? -lk0 : 0, rhi = (Lsub - 1 - lk0) < 31 ? (Lsub - 1 - lk0) : 31;
        attn_step(a, qf, Kb + (long)lk0 * stride, Vb + (long)lk0 * stride, stride, rlo, rhi, vl, fr, quad,
                  [&](int g, int kb, int r) { const int lq = l0 + 16 * g + fr, lk = lk0 + 16 * kb + 4 * quad + r; return lk >= 0 && lk <= lq && lq - lk <= 128; });
    }
    const long orow = (long)p * NTOK + rowbase + (long)l0 * d;
    attn_finish(a, P.oa + orow * GW + h * 128, (long)d * GW, P.lsea + orow * 4 + h, (long)d * 4, fr, quad);
}
__device__ __forceinline__ void item_X(const MixP& P, int idx, LAS unsigned char* vl, int fr, int quad) {
    asm volatile("" : "+v"(fr), "+v"(quad));
    const int b = idx / (4 * NPH), h = (idx / NPH) & 3, ch = idx % NPH;
    const long row0 = (long)b * SEQ + QW * ch;
    h8 qf[NG][4];
    load_q(qf, P.proj + row0 * NCOL + SL_XQ * GW + h * 128, NCOL, fr, quad);
    const hf* Kb = P.kvmem + (long)b * NMEM * 1024 + h * 128;
    AttnAcc a; attn_init(a);
    for (int s = 0; s < 8; ++s)
        attn_step(a, qf, Kb + (long)(32 * s) * 1024, Kb + (long)(32 * s) * 1024 + GW, 1024, 0, 31, vl, fr, quad, [&](int, int, int) { return true; });
    attn_finish(a, P.ox + row0 * GW + h * 128, GW, nullptr, 0, fr, quad);
}
__device__ const unsigned char CTAB[40] = {60,61,62,63,56,57,58,52,53,54,48,49,50,44,45,46,40,41,36,37,32,33,28,29,24,20,16,12,59,42,25,8,55,38,21,4,51,34,17,0};
__device__ __forceinline__ void item_C(const MixP& P, int idx, LAS unsigned char* vl, int fr, int quad) {
    asm volatile("" : "+v"(fr), "+v"(quad));
    constexpr int NSUB = 256 / QW;
    const int e = idx / (8 * NSUB), rest = idx % (8 * NSUB), bh = rest / NSUB, sub = rest % NSUB, b = bh >> 2, h = bh & 3;
    const int code = CTAB[e], qblk = code >> 2, part = code & 3;
    const long row0 = (long)b * SEQ + qblk * 256 + sub * QW;
    h8 qf[NG][4];
    load_q(qf, P.proj + row0 * NCOL + SL_CQ * GW + h * 128, NCOL, fr, quad);
    unsigned sel[NG];
    {
        float v1[NG], v2[NG], v3[NG]; int i1[NG], i2[NG], i3[NG];
#pragma unroll
        for (int g = 0; g < NG; ++g) { v1[g] = v2[g] = v3[g] = -3e38f; i1[g] = i2[g] = i3[g] = -1; }
        for (int n = 0; n < qblk; ++n) {
            const float* k0 = P.kpart + (size_t)((b * 16 + n) * 2) * GW + h * 128 + 8 * quad;
            float dv[NG];
#pragma unroll
            for (int g = 0; g < NG; ++g) dv[g] = 0.f;
#pragma unroll
            for (int c = 0; c < 4; ++c) {
                const f32x4 ka = *(const f32x4*)(k0 + 32 * c) + *(const f32x4*)(k0 + GW + 32 * c);
                const f32x4 kb = *(const f32x4*)(k0 + 32 * c + 4) + *(const f32x4*)(k0 + GW + 32 * c + 4);
#pragma unroll
                for (int g = 0; g < NG; ++g)
#pragma unroll
                    for (int i = 0; i < 4; ++i) dv[g] += (float)qf[g][c][i] * ka[i] + (float)qf[g][c][4 + i] * kb[i];
            }
#pragma unroll
            for (int g = 0; g < NG; ++g) {
                float v = dv[g]; { const int ln_ = quad * 16 + fr; v += shx_l(v, ln_, 16); v += shx_l(v, ln_, 32); }
                if (v > v1[g]) { v3[g] = v2[g]; i3[g] = i2[g]; v2[g] = v1[g]; i2[g] = i1[g]; v1[g] = v; i1[g] = n; }
                else if (v > v2[g]) { v3[g] = v2[g]; i3[g] = i2[g]; v2[g] = v; i2[g] = n; }
                else if (v > v3[g]) { v3[g] = v; i3[g] = n; }
            }
        }
#pragma unroll
        for (int g = 0; g < NG; ++g) sel[g] = (i1[g] >= 0 ? 1u << i1[g] : 0u) | (i2[g] >= 0 ? 1u << i2[g] : 0u) | (i3[g] >= 0 ? 1u << i3[g] : 0u);
    }
    unsigned selany = 0u;
#pragma unroll
    for (int g = 0; g < NG; ++g) selany |= sel[g];
    AttnAcc a; attn_init(a);
    const int nlo = 4 * part, nhi = (4 * part + 3 < qblk) ? 4 * part + 3 : qblk;
    for (int n = nlo; n <= nhi; ++n) {
        const hf* Kb = P.proj + ((long)b * SEQ + n * 256) * NCOL + SL_CK * GW + h * 128;
        if (n == qblk) {
            const int tlmax = (QW * sub + QW - 1) >> 5;
            for (int tl = 0; tl <= tlmax; ++tl)
                attn_step(a, qf, Kb + (long)(32 * tl) * NCOL, Kb + (long)(32 * tl) * NCOL + GW, NCOL, 0, 31, vl, fr, quad,
                          [&](int g, int kb, int r) { return 32 * tl + 16 * kb + 4 * quad + r <= QW * sub + 16 * g + fr; });
        } else {
            const bool any = __any((int)((selany >> n) & 1u));
            if (any) {
                for (int tl = 0; tl < 8; ++tl)
                    attn_step(a, qf, Kb + (long)(32 * tl) * NCOL, Kb + (long)(32 * tl) * NCOL + GW, NCOL, 0, 31, vl, fr, quad,
                              [&](int g, int, int) { return ((sel[g] >> n) & 1u) != 0u; });
            }
        }
    }
    const long orow = (long)part * NTOK + row0;
    attn_finish(a, P.ocp + orow * GW + h * 128, GW, P.lsec + orow * 4 + h, 4, fr, quad);
}
__device__ __forceinline__ void item_B(const MixP& P, int idx, LAS unsigned char* vl, int lane, int fr, int quad) {
    asm volatile("" : "+v"(lane)); fr = lane & 15; quad = lane >> 4;
    constexpr int NIG = 128 / QW;
    const int ig = NIG - 1 - (idx >> 8), rest = idx & 255, b = rest >> 7, chunk = (rest >> 2) & 31, g = rest & 3;
    const int smax = (QW * ig + QW - 1) >> 5;
    const long tok0 = (long)b * SEQ + chunk * 128;
    LAS f32x2* stl = (LAS f32x2*)(vl + 32 * VROW);
#pragma unroll
    for (int k = 0; k < 2; ++k) { const int tt = lane + 64 * k;
        if (tt < 32 * (smax + 1)) { const f32x2* sp = P.vstat + (size_t)(tok0 + tt) * 8; float s1 = 0.f, s2 = 0.f;
#pragma unroll
            for (int q = 0; q < 8; ++q) { const f32x2 v = sp[q]; s1 += v.x; s2 += v.y; }
            const float mu = s1 * (1.0f / 512.0f), var = fmaxf(s2 * (1.0f / 512.0f) - mu * mu, 0.f);
            stl[tt] = (f32x2){mu, __builtin_amdgcn_rsqf(var + NORM_EPS)}; } }
    AttnAcc a; attn_init(a);
    float aacc[NG];
#pragma unroll
    for (int g2 = 0; g2 < NG; ++g2) aacc[g2] = 0.f;
    const hf* Vb = P.proj + tok0 * NCOL + SL_BV * GW + g * 128;
    h8 vsa[4][8];
#pragma unroll
    for (int s = 0; s < 4; ++s) if (s <= smax) v_stage_load(vsa[s], Vb + (long)(32 * s) * NCOL, NCOL, 0, 31, fr, quad);
#pragma unroll
    for (int s = 0; s < 4; ++s) { if (s <= smax) {
        const int j0 = 32 * s;
        h8 (&vs)[8] = vsa[s];
        h8 pf[NG];
#pragma unroll
        for (int g2 = 0; g2 < NG; ++g2) {
            const int i = QW * ig + 16 * g2 + fr;
            f32x4 pv[2];
#pragma unroll
            for (int kb = 0; kb < 2; ++kb) { const int j = j0 + 16 * kb + 4 * quad;
                const h4 w = *(const h4*)(P.sguw + ((size_t)(g * 128 + i)) * 128 + j);
#pragma unroll
                for (int r = 0; r < 4; ++r) { const f32x2 st = stl[j + r]; pv[kb][r] = (float)w[r] * st.y; } }
            pf[g2] = pack8(pv[0], pv[1]);
#pragma unroll
            for (int kb = 0; kb < 2; ++kb)
#pragma unroll
                for (int r = 0; r < 4; ++r) aacc[g2] += (float)pf[g2][4 * kb + r] * stl[j0 + 16 * kb + 4 * quad + r].x;
        }
        v_stage_store(vs, vl, fr, quad);
        pv_mma(a.o, pf, vl, fr, quad);
    } }
#pragma unroll
    for (int g2 = 0; g2 < NG; ++g2) {
        float as = aacc[g2]; as += shx_l(as, lane, 16); as += shx_l(as, lane, 32);
        const int i = QW * ig + 16 * g2 + fr;
        const float rs = P.sgurs[g * 128 + i], bs = P.sgub[g * 128 + i];
        const hf* up = P.proj + (tok0 + i) * NCOL + SL_BU * GW + g * 128 + 4 * quad;
        hf* op = P.ob + (tok0 + i) * GW + g * 128 + 4 * quad;
#pragma unroll
        for (int dt = 0; dt < 8; ++dt) {
            const f32x4 gm = *(const f32x4*)(P.lng + g * 128 + 16 * dt + 4 * quad), bt = *(const f32x4*)(P.lnb + g * 128 + 16 * dt + 4 * quad);
            const h4 u = *(const h4*)(up + 16 * dt);
            f32x4 o;
#pragma unroll
            for (int r = 0; r < 4; ++r) o[r] = (float)u[r] * (gm[r] * (a.o[g2][dt][r] - as) + bt[r] * rs + bs);
            *(h4*)(op + 16 * dt) = __builtin_convertvector(o, h4);
        }
    }
}

struct Args { const float* in[14]; float* out; unsigned char* ws; int ph_lo, ph_hi; };

__device__ __forceinline__ int win_phys_row(int n) {
    const int slice = n >> 9, ch = n & 511;
    if (slice == SL_AQ || slice == SL_AK || slice == SL_CQ || slice == SL_CK) { const int d = n & 127, dd = d & 63; return (n & ~127) + 8 * (dd >> 2) + (d >= 64 ? 4 : 0) + (dd & 3); }
    if (slice == SL_BU) return 4 * 512 + (ch >> 2) * 8 + (ch & 3);
    if (slice == SL_BG) return 4 * 512 + (ch >> 2) * 8 + 4 + (ch & 3);
    if (slice == SL_BV) return 6 * 512 + ch;
    if (slice == SL_DB) return 11 * 512 + (ch >> 2) * 8 + (ch & 3);
    if (slice == SL_DG) return 11 * 512 + (ch >> 2) * 8 + 4 + (ch & 3);
    if (slice == SL_DC) return 13 * 512 + (ch >> 2) * 8 + (ch & 3);
    if (slice == SL_DH) return 13 * 512 + (ch >> 2) * 8 + 4 + (ch & 3);
    return n;
}
__device__ __forceinline__ void tr_item(const float* W, int K, int N, hf* WT, LAS float* scr, int item, int lane, bool perm, const float* kscale = nullptr) {
    const int nblk = N / 32, kb = item / nblk, nb = item % nblk, k0 = 64 * kb, n0 = 32 * nb;
#pragma unroll 8
    for (int i = 0; i < 32; ++i) { const int kk = 2 * i + (lane >> 5); scr[kk * 33 + (lane & 31)] = W[(size_t)(k0 + kk) * N + n0 + (lane & 31)]; }
    asm volatile("s_waitcnt lgkmcnt(0)" ::: "memory");
    const int c = lane & 7;
    f32x4 ga = (f32x4){1.f, 1.f, 1.f, 1.f}, gb = ga;
    if (kscale) { ga = *(const f32x4*)(kscale + k0 + 8 * c); gb = *(const f32x4*)(kscale + k0 + 8 * c + 4); }
#pragma unroll
    for (int j = 0; j < 4; ++j) { const int n = (lane >> 3) + 8 * j; const LAS float* s = scr + (8 * c) * 33 + n;
        const f32x4 a = (f32x4){s[0], s[33], s[66], s[99]} * ga, b = (f32x4){s[132], s[165], s[198], s[231]} * gb;
        const int nr = perm ? win_phys_row(n0 + n) : (n0 + n);
        *(h8*)(WT + (size_t)nr * K + k0 + 8 * c) = pack8(a, b); }
    asm volatile("s_waitcnt lgkmcnt(0)" ::: "memory");
}
__device__ __forceinline__ void rms_row(const float* xrow, const float* g, hf* oh, float* of, int lane) {
    f32x4 v[8]; float ss = 0.f;
#pragma unroll
    for (int j = 0; j < 8; ++j) { v[j] = *(const f32x4*)(xrow + 4 * (lane + 64 * j)); ss += v[j][0] * v[j][0] + v[j][1] * v[j][1] + v[j][2] * v[j][2] + v[j][3] * v[j][3]; }
    const float r = __builtin_amdgcn_rsqf(wave_sum(ss, lane) * (1.0f / DM) + NORM_EPS);
#pragma unroll
    for (int j = 0; j < 8; ++j) { const f32x4 gg = *(const f32x4*)(g + 4 * (lane + 64 * j)); const f32x4 o = v[j] * r * gg;
        if (oh) *(h4*)(oh + 4 * (lane + 64 * j)) = __builtin_convertvector(o, h4); else *(f32x4*)(of + 4 * (lane + 64 * j)) = o; }
}

#define CAS __attribute__((address_space(4)))
#define KA_BEGIN() const CAS Args* ka = (const CAS Args*)__builtin_amdgcn_kernarg_segment_ptr(); asm volatile("" : "+s"(ka)); \
    int tid_ = threadIdx.x; asm volatile("" : "+v"(tid_)); const int lane = tid_ & 63; \
    const int wave = __builtin_amdgcn_readfirstlane(tid_ >> 6), fr = lane & 15, quad = lane >> 4; \
    const int G = gridDim.x, gw = blockIdx.x * NWAVES + wave, NGW = G * NWAVES; unsigned char* ws = ka->ws; \
    (void)fr; (void)quad; (void)gw; (void)NGW; (void)ws

struct ConvDesc { const float* W; hf* WT; const float* kscale; int K, N, k0, n0; bool perm; };
__device__ __forceinline__ ConvDesc conv_decode(int it, const float* w_in, const float* w_out, const float* w_mem_kv, hf* winT, hf* woutT, hf* wmemT, const float* norm_g) {
    constexpr int I_IN = (DM / 64) * (NCOL / 32), I_OUT = (MIXW / 64) * (DM / 32), I_MEM = (DM / 64) * (1024 / 32), I_ALL = I_IN + I_OUT + I_MEM;
    const int l = it >= I_ALL ? 1 : 0; int r = it - l * I_ALL; ConvDesc d;
    if (r < I_IN) { d.W = w_in + (size_t)l * DM * NCOL; d.WT = winT + (size_t)l * NCOL * DM; d.K = DM; d.N = NCOL; d.perm = true; d.kscale = norm_g + l * DM; }
    else if (r < I_IN + I_OUT) { r -= I_IN; d.W = w_out + (size_t)l * MIXW * DM; d.WT = woutT + (size_t)l * DM * MIXW; d.K = MIXW; d.N = DM; d.perm = false; d.kscale = nullptr; }
    else { r -= I_IN + I_OUT; d.W = w_mem_kv + (size_t)l * DM * 1024; d.WT = wmemT + (size_t)l * 1024 * DM; d.K = DM; d.N = 1024; d.perm = false; d.kscale = nullptr; }
    const int nblk = d.N / 32; d.k0 = 64 * (r / nblk); d.n0 = 32 * (r % nblk);
    return d;
}
__device__ __forceinline__ void conv_load(f32x4 (&v)[8], const ConvDesc& d, int lane) {
    const float* p = d.W + (size_t)(d.k0 + (lane >> 3)) * d.N + d.n0 + 4 * (lane & 7);
#pragma unroll
    for (int i = 0; i < 8; ++i) v[i] = *(const f32x4*)(p + (size_t)(8 * i) * d.N);
}
__device__ __forceinline__ int win_phys_row(int n);
__device__ __forceinline__ void conv_store(const f32x4 (&v)[8], const ConvDesc& d, LAS float* scr, int lane) {
    { LAS float* s = scr + (lane >> 3) * 33 + 4 * (lane & 7);
#pragma unroll
      for (int i = 0; i < 8; ++i) { s[(8 * i) * 33 + 0] = v[i][0]; s[(8 * i) * 33 + 1] = v[i][1]; s[(8 * i) * 33 + 2] = v[i][2]; s[(8 * i) * 33 + 3] = v[i][3]; } }
    asm volatile("s_waitcnt lgkmcnt(0)" ::: "memory");
    const int c = lane & 7;
    f32x4 ga = (f32x4){1.f, 1.f, 1.f, 1.f}, gb = ga;
    if (d.kscale) { ga = *(const f32x4*)(d.kscale + d.k0 + 8 * c); gb = *(const f32x4*)(d.kscale + d.k0 + 8 * c + 4); }
#pragma unroll
    for (int j = 0; j < 4; ++j) { const int n = (lane >> 3) + 8 * j; const LAS float* s = scr + (8 * c) * 33 + n;
        const f32x4 a = (f32x4){s[0], s[33], s[66], s[99]} * ga, b = (f32x4){s[132], s[165], s[198], s[231]} * gb;
        const int nr = d.perm ? win_phys_row(d.n0 + n) : (d.n0 + n);
        *(h8*)(d.WT + (size_t)nr * d.K + d.k0 + 8 * c) = pack8(a, b); }
    asm volatile("s_waitcnt lgkmcnt(0)" ::: "memory");
}
constexpr int CT_IN = (DM / 128) * (NCOL / 128), CT_OUT = (MIXW / 128) * (DM / 128), CT_MEM = (DM / 128) * (1024 / 128), CT_ALL = CT_IN + CT_OUT + CT_MEM;
__device__ __forceinline__ ConvDesc ctile_decode(int it, const float* w_in, const float* w_out, const float* w_mem_kv, hf* winT, hf* woutT, hf* wmemT, const float* norm_g) {
    const int l = it >= CT_ALL ? 1 : 0; int r = it - l * CT_ALL; ConvDesc d;
    if (r < CT_IN) { d.W = w_in + (size_t)l * DM * NCOL; d.WT = winT + (size_t)l * NCOL * DM; d.K = DM; d.N = NCOL; d.perm = true; d.kscale = norm_g + l * DM; }
    else if (r < CT_IN + CT_OUT) { r -= CT_IN; d.W = w_out + (size_t)l * MIXW * DM; d.WT = woutT + (size_t)l * DM * MIXW; d.K = MIXW; d.N = DM; d.perm = false; d.kscale = nullptr; }
    else { r -= CT_IN + CT_OUT; d.W = w_mem_kv + (size_t)l * DM * 1024; d.WT = wmemT + (size_t)l * 1024 * DM; d.K = DM; d.N = 1024; d.perm = false; d.kscale = nullptr; }
    const int nblk = d.N / 128; d.k0 = 128 * (r / nblk); d.n0 = 128 * (r % nblk);
    return d;
}
__device__ __forceinline__ void ctile_load(f32x4 (&v)[8], const ConvDesc& d, int tid) {
    const float* p = d.W + (size_t)(d.k0 + (tid >> 5)) * d.N + d.n0 + 4 * (tid & 31);
#pragma unroll
    for (int i = 0; i < 8; ++i) v[i] = __builtin_nontemporal_load((const f32x4*)(p + (size_t)(16 * i) * d.N));
}
__device__ __forceinline__ void ctile_store(const f32x4 (&v)[8], const ConvDesc& d, LAS float* t129, int tid) {
    { LAS float* s = t129 + (tid >> 5) * 129 + 4 * (tid & 31);
#pragma unroll
      for (int i = 0; i < 8; ++i) { s[(16 * i) * 129 + 0] = v[i][0]; s[(16 * i) * 129 + 1] = v[i][1]; s[(16 * i) * 129 + 2] = v[i][2]; s[(16 * i) * 129 + 3] = v[i][3]; } }
    __syncthreads();
    const int c = tid & 15;
    f32x4 ga = (f32x4){1.f, 1.f, 1.f, 1.f}, gb = ga;
    if (d.kscale) { ga = *(const f32x4*)(d.kscale + d.k0 + 8 * c); gb = *(const f32x4*)(d.kscale + d.k0 + 8 * c + 4); }
#pragma unroll
    for (int j = 0; j < 4; ++j) { const int n = (tid >> 4) + 32 * j; const LAS float* s = t129 + (8 * c) * 129 + n;
        const f32x4 a = (f32x4){s[0], s[129], s[258], s[387]} * ga, b = (f32x4){s[516], s[645], s[774], s[903]} * gb;
        const int nr = d.perm ? win_phys_row(d.n0 + n) : (d.n0 + n);
        *(h8*)(d.WT + (size_t)nr * d.K + d.k0 + 8 * c) = pack8(a, b); }
    __syncthreads();
}
constexpr int CONV_I_IN = (DM / 64) * (NCOL / 32), CONV_I_OUT = (MIXW / 64) * (DM / 32), CONV_I_MEM = (DM / 64) * (1024 / 32);
constexpr int CONV_ITEMS = CONV_I_IN + CONV_I_OUT + CONV_I_MEM;
__device__ __forceinline__ void conv_item(const float* w_in, const float* w_out, const float* w_mem_kv, hf* winT, hf* woutT, hf* wmemT, int l, int it, LAS float* scr, int lane, const float* norm_g) {
    int r = it;
    if (r < CONV_I_IN) { tr_item(w_in + (size_t)l * DM * NCOL, DM, NCOL, winT + (size_t)l * NCOL * DM, scr, r, lane, true, norm_g + l * DM); return; } r -= CONV_I_IN;
    if (r < CONV_I_OUT) { tr_item(w_out + (size_t)l * MIXW * DM, MIXW, DM, woutT + (size_t)l * DM * MIXW, scr, r, lane, false); return; } r -= CONV_I_OUT;
    tr_item(w_mem_kv + (size_t)l * DM * 1024, DM, 1024, wmemT + (size_t)l * 1024 * DM, scr, r, lane, false);
}
__device__ __forceinline__ void xg_row(const float* xrow, const float* g, hf* oh, float* ssp, int lane) {
    f32x4 v[8]; float ss = 0.f;
#pragma unroll
    for (int j = 0; j < 8; ++j) { v[j] = __builtin_nontemporal_load((const f32x4*)(xrow + 4 * (lane + 64 * j))); ss += v[j][0] * v[j][0] + v[j][1] * v[j][1] + v[j][2] * v[j][2] + v[j][3] * v[j][3]; }
    ss = wave_sum(ss, lane);
#pragma unroll
    for (int j = 0; j < 8; ++j) { (void)g; *(h4*)(oh + 4 * (lane + 64 * j)) = __builtin_convertvector(v[j], h4); }
    if (lane < 8) ssp[lane] = lane == 0 ? ss : 0.f;
}
__device__ const double ROPE_REV[64] = {0.15915494309189535,0.13782250260398285,0.11934937021124886,0.10335229661843406,0.08949940160889101,0.07750328875537406,0.06711508300522726,0.058119267441876246,0.050329212104487035,0.04358330210530733,0.03774158471741977,0.032682865872357,0.0283021958306234,0.024508691862069852,0.02122365276477766,0.018378926105679667,0.015915494309189534,0.013782250260398284,0.011934937021124886,0.010335229661843406,0.008949940160889102,0.0077503288755374055,0.006711508300522725,0.005811926744187624,0.005032921210448704,0.004358330210530733,0.003774158471741977,0.0032682865872356993,0.00283021958306234,0.002450869186206985,0.0021223652764777662,0.0018378926105679667,0.0015915494309189536,0.0013782250260398288,0.0011934937021124885,0.0010335229661843405,0.0008949940160889102,0.0007750328875537405,0.0006711508300522726,0.0005811926744187624,0.0005032921210448703,0.0004358330210530733,0.00037741584717419774,0.0003268286587235699,0.00028302195830623395,0.00024508691862069854,0.0002122365276477766,0.00018378926105679666,0.00015915494309189535,0.00013782250260398286,0.00011934937021124886,0.00010335229661843406,8.949940160889102e-05,7.750328875537406e-05,6.711508300522725e-05,5.811926744187624e-05,5.0329212104487035e-05,4.358330210530732e-05,3.774158471741978e-05,3.2682865872357e-05,2.8302195830623396e-05,2.4508691862069852e-05,2.122365276477766e-05,1.8378926105679668e-05};
__device__ __forceinline__ void phase_prologue(LAS unsigned char* lds) {
    KA_BEGIN();
    const float* x = ka->in[0]; const float* mem = ka->in[1]; const float* norm_g = ka->in[2]; const float* w_in = ka->in[3];
    const float* sgu_w = ka->in[4]; const float* mem_norm_g = ka->in[9]; const float* w_mem_kv = ka->in[10]; const float* w_out = ka->in[12];
    float* cosT = (float*)(ws + WS_ROPE); float* sinT = cosT + SEQ * 64;
    hf* sguw = (hf*)(ws + WS_SGUW); float* sgurs = (float*)(ws + WS_SGUW + 512 * 1024);
    hf* memn = (hf*)(ws + WS_MEMN); hf* wmemT = (hf*)(ws + WS_WMEMT); hf* woutT = (hf*)(ws + WS_WOUTT); hf* winT = (hf*)(ws + WS_WINT); hf* xn = (hf*)(ws + WS_XN);
    LAS float* scr = (LAS float*)(lds + wave * 16384);
    {
        int tid_c = wave * 64 + lane;
        LAS float* t129 = (LAS float*)lds;
        f32x4 va[8], vb[8];
        int it = blockIdx.x;
        ConvDesc da = ctile_decode(it < 2 * CT_ALL ? it : 0, w_in, w_out, w_mem_kv, winT, woutT, wmemT, norm_g), db = da;
        if (it < 2 * CT_ALL) ctile_load(va, da, tid_c);
        while (it < 2 * CT_ALL) {
            const int it1 = it + G;
            if (it1 < 2 * CT_ALL) { db = ctile_decode(it1, w_in, w_out, w_mem_kv, winT, woutT, wmemT, norm_g); ctile_load(vb, db, tid_c); }
            ctile_store(va, da, t129, tid_c);
            const int it2 = it1 + G;
            if (it2 < 2 * CT_ALL) { da = ctile_decode(it2, w_in, w_out, w_mem_kv, winT, woutT, wmemT, norm_g); ctile_load(va, da, tid_c); }
            if (it1 < 2 * CT_ALL) ctile_store(vb, db, t129, tid_c);
            it = it2;
        }
    }
    for (int e = blockIdx.x * 512 + wave * 64 + lane; e < SEQ * 64; e += G * 512) {
        const int t = e >> 6, i = e & 63;
        const double rev = (double)t * ROPE_REV[i];
        const float f = (float)(rev - floor(rev));
        cosT[e] = __builtin_amdgcn_cosf(f); sinT[e] = __builtin_amdgcn_sinf(f);
    }
    for (int rw = gw; rw < 2 * 4 * 128; rw += NGW) {
        const int i = rw & 127; const float* wr_ = sgu_w + (size_t)rw * 128; float s = 0.f;
#pragma unroll
        for (int k = 0; k < 2; ++k) { const int j = lane + 64 * k; const float w = (j <= i) ? wr_[j] : 0.f; s += w; sguw[(size_t)rw * 128 + j] = (hf)w; }
        s = wave_sum(s, lane); if (lane == 0) sgurs[rw] = s;
    }
    for (int m = gw; m < NTOK; m += NGW) xg_row(x + (size_t)m * DM, norm_g, xn + (size_t)m * DM, (float*)(ws + WS_ROWSS) + (size_t)m * 8, lane);
    for (int m = gw; m < 2 * 512; m += NGW) { const int l = m >> 9, r = m & 511; rms_row(mem + (size_t)r * DM, mem_norm_g + l * DM, memn + (size_t)m * DM, nullptr, lane); }
}

__device__ __forceinline__ void phase_proj(LAS unsigned char* lds, int L) {
    {
        KA_BEGIN();
        pg8::Gemm g{(const hf*)(ws + WS_XN), (const hf*)(ws + WS_WINT) + (size_t)L * NCOL * DM, NTOK, PROJ_N1, DM}; pg8::StaticOrder S; S.init(NTOK, PROJ_N1, G, (int)blockIdx.x);
        float* cosT = (float*)(ws + WS_ROPE);
        pg8::EpiProj E{(hf*)(ws + WS_PROJ), cosT, cosT + SEQ * 64, (float*)(ws + WS_KPART), (f32x2*)(ws + WS_VSTAT), (const float*)(ws + WS_ROWSS), (hf*)(ws + WS_HM)};
        pg8::gemm_phase<pg8::EpiProj, pg8::StaticOrder, true, true>(lds, g, S, E);
    }
}

__device__ __forceinline__ void memkv_tile(int tl, LAS unsigned char* lds) {
    KA_BEGIN();
    const hf* memn = (const hf*)(ws + WS_MEMN); const hf* wmemT = (const hf*)(ws + WS_WMEMT); hf* kvmem = (hf*)(ws + WS_KVMEM);
    const int l = tl >> 7, r = tl & 127, mt = r >> 4, nt = r & 15, m0 = mt * 64, n0 = nt * 64;
    const hf* ap = memn + ((size_t)l * 512 + m0 + fr) * DM + wave * 256 + 8 * quad;
    const hf* bp = wmemT + ((size_t)l * 1024 + n0 + fr) * DM + wave * 256 + 8 * quad;
    f32x4 c[4][4];
#pragma unroll
    for (int ni = 0; ni < 4; ++ni)
#pragma unroll
        for (int mi = 0; mi < 4; ++mi) c[ni][mi] = (f32x4){0.f, 0.f, 0.f, 0.f};
#pragma unroll 2
    for (int kk = 0; kk < 8; ++kk) {
        h8 av[4], bv[4];
#pragma unroll
        for (int i = 0; i < 4; ++i) { av[i] = *(const h8*)(ap + (size_t)(16 * i) * DM + 32 * kk); bv[i] = *(const h8*)(bp + (size_t)(16 * i) * DM + 32 * kk); }
#pragma unroll
        for (int ni = 0; ni < 4; ++ni)
#pragma unroll
            for (int mi = 0; mi < 4; ++mi) c[ni][mi] = __builtin_amdgcn_mfma_f32_16x16x32_f16(bv[ni], av[mi], c[ni][mi], 0, 0, 0);
    }
    LAS float* red = (LAS float*)lds + wave * 4096;
#pragma unroll
    for (int ni = 0; ni < 4; ++ni)
#pragma unroll
        for (int mi = 0; mi < 4; ++mi) *(LAS f32x4*)(red + (16 * mi + fr) * 64 + 16 * ni + 4 * quad) = c[ni][mi];
    __syncthreads();
    { const int t = wave * 64 + lane, m = t >> 3, n8 = (t & 7) * 8;
      f32x4 s0 = (f32x4){0.f, 0.f, 0.f, 0.f}, s1 = s0;
#pragma unroll
      for (int w = 0; w < 8; ++w) { const LAS float* p = (const LAS float*)lds + w * 4096 + m * 64 + n8; s0 += *(const LAS f32x4*)p; s1 += *(const LAS f32x4*)(p + 4); }
      const h8 hv = pack8(s0, s1); const unsigned long long* q2 = (const unsigned long long*)&hv; unsigned long long* dst = (unsigned long long*)(kvmem + ((size_t)l * 512 + m0 + m) * 1024 + n0 + n8);
      __hip_atomic_store(dst, q2[0], __ATOMIC_RELAXED, __HIP_MEMORY_SCOPE_AGENT); __hip_atomic_store(dst + 1, q2[1], __ATOMIC_RELAXED, __HIP_MEMORY_SCOPE_AGENT); }
    asm volatile("s_waitcnt vmcnt(0)" ::: "memory");
    __syncthreads();
    if (threadIdx.x == 0) __hip_atomic_fetch_add((unsigned*)(ws + WS_CTL) + CW_BAR + 48, 1u, __ATOMIC_RELAXED, __HIP_MEMORY_SCOPE_AGENT);
}

__device__ __forceinline__ void moba_gate_item(int g, unsigned char* ws, int L, LAS unsigned char* lds) {
    int tid = threadIdx.x; asm volatile("" : "+v"(tid));
    const int wid = __builtin_amdgcn_readfirstlane(tid >> 6), lane = tid & 63, r32 = lane & 31, hi = lane >> 5;
    const int bh = g & 7, qblk = g >> 3, b = bh >> 2, h = bh & 3;
    const int pos = qblk * 256 + wid * 32 + r32;
    float* lsec = (float*)(ws + WS_LSE + MiB) + ((size_t)b * SEQ) * 4 + h;
    {
        if (tid < 256) for (int s = (qblk < 3 ? qblk : 3); s < 3; ++s) __hip_atomic_store(&lsec[((size_t)s * NTOK + qblk * 256 + tid) * 4], -1e30f, __ATOMIC_RELAXED, __HIP_MEMORY_SCOPE_AGENT);
    }
    if (qblk > 0) {
        const hf* Q = (const hf*)(ws + WS_HM) + 3 * (size_t)NTOK * GW + ((size_t)(b * 4 + h) * SEQ + pos) * 128;
        h8 qr[8];
#pragma unroll
        for (int d0 = 0; d0 < 8; ++d0) qr[d0] = *(const h8*)(Q + d0 * 16 + hi * 8);
        const float* ksum = (const float*)(ws + WS_KPART) + (size_t)(b * 16 * 2) * GW + h * 128;
        LAS float* ksl = (LAS float*)(lds + att::LDS_KSUM);
        { const int n = tid >> 5, d4 = (tid & 31) * 4;
          if (n < qblk) { const float* kp = ksum + (size_t)(n * 2) * GW + d4; *(LAS f32x4*)(ksl + n * 128 + d4) = *(const f32x4*)kp + *(const f32x4*)(kp + GW); } }
        __syncthreads();
        float v1 = -3e38f, v2 = -3e38f, v3 = -3e38f; int i1 = -1, i2 = -1, i3 = -1;
        for (int n = 0; n < qblk; ++n) {
            const LAS float* kr = ksl + n * 128 + hi * 8; float dv = 0.f;
#pragma unroll
            for (int d0 = 0; d0 < 8; ++d0) { const f32x4 ka = *(const LAS f32x4*)(kr + d0 * 16), kb = *(const LAS f32x4*)(kr + d0 * 16 + 4);
#pragma unroll
                for (int i = 0; i < 4; ++i) dv += (float)qr[d0][i] * ka[i] + (float)qr[d0][4 + i] * kb[i]; }
            dv += shx_l(dv, lane, 32);
            if (dv > v1) { v3 = v2; i3 = i2; v2 = v1; i2 = i1; v1 = dv; i1 = n; }
            else if (dv > v2) { v3 = v2; i3 = i2; v2 = dv; i2 = n; }
            else if (dv > v3) { v3 = dv; i3 = n; }
        }
        const unsigned sel = (i1 >= 0 ? 1u << i1 : 0u) | (i2 >= 0 ? 1u << i2 : 0u) | (i3 >= 0 ? 1u << i3 : 0u);
        unsigned* cnt = (unsigned*)(ws + WS_CTL) + CW_CNT + L * 128 + bh * 16;
        unsigned* list = (unsigned*)(ws + WS_LIST) + (size_t)bh * 16 * SEQ;
        for (int n = 0; n < qblk; ++n) {
            const bool pred = (hi == 0) && (((sel >> n) & 1u) != 0u);
            const unsigned long long m = __ballot(pred);
            if (m != 0ull) {
                const int leader = __ffsll((unsigned long long)m) - 1;
                unsigned base = 0u;
                if (lane == leader) base = __hip_atomic_fetch_add(cnt + n, (unsigned)__popcll(m), __ATOMIC_RELAXED, __HIP_MEMORY_SCOPE_AGENT);
                base = (unsigned)__builtin_amdgcn_readlane((int)base, leader);
                if (pred) { const unsigned off = (unsigned)__popcll(m & ((1ull << lane) - 1ull)); const unsigned slot = (unsigned)__popc(sel & ((1u << n) - 1u));
                    __hip_atomic_store(&list[(size_t)n * SEQ + base + off], (unsigned)pos | (slot << 16), __ATOMIC_RELAXED, __HIP_MEMORY_SCOPE_AGENT); }
            }
        }
    }
    asm volatile("s_waitcnt vmcnt(0)" ::: "memory");
    __syncthreads();
    if (tid == 0) __hip_atomic_fetch_add((unsigned*)(ws + WS_CTL) + CW_BAR + 32 + 64 * L, 1u, __ATOMIC_RELAXED, __HIP_MEMORY_SCOPE_AGENT);
}

constexpr int NI_G = 64, NI_K = 256, NI_M = 128, NI_C = 128, NI_A = 3 * 8 * 16, NI_X = 8 * 16, NI_B = N_B / 8;
constexpr int LDS_Q_OFF = 131072 + 64;
constexpr int LDS_GTAB = att::LDS_KSUM;
__device__ __forceinline__ att::BlkRef mix_decode(int Li, unsigned char* ws, int L) {
    const hf* hm = (const hf*)(ws + WS_HM); constexpr long HMS = (long)NTOK * GW;
    att::BlkRef r;
    r.list = nullptr; r.cnt = 0;
    if (Li < NI_C) {
        const int bh = Li & 7, qblk = 15 - (Li >> 3), b = bh >> 2, h = bh & 3;
        const long row0 = (long)b * SEQ + qblk * 256, hrow = (long)(b * 4 + h) * SEQ;
        r.Q = hm + 3 * HMS + (hrow + qblk * 256) * 128; r.qs = 128;
        r.K = hm + 4 * HMS + hrow * 128; r.V = hm + 5 * HMS + hrow * 128; r.ks = 128;
        r.O = (hf*)(ws + WS_OCP) + ((long)3 * NTOK + row0) * GW + h * 128; r.os = GW;
        r.LSE = (float*)(ws + WS_LSE + MiB) + ((long)3 * NTOK + row0) * 4 + h; r.ls = 4;
        r.P0 = qblk * 256; r.W = 1 << 30; r.j_lo = qblk * 4; r.j_hi = qblk * 4 + 4;
    } else if (Li < NI_C + NI_A) {
        const int i = Li - NI_C, p = i >> 7, rr = i & 127, b = rr >> 6, h = (rr >> 4) & 3, slot = rr & 15;
        const int dsh = 2 * p, d = 1 << dsh, bpr = 16 >> dsh, res = slot / bpr, blk = slot % bpr, l0 = 256 * blk, Lsub = SEQ >> dsh;
        const long rowb = (long)b * SEQ + res, q0 = rowb + (long)l0 * d, hrow = (long)(b * 4 + h) * SEQ + res;
        r.Q = hm + 0 * HMS + (hrow + (long)l0 * d) * 128; r.qs = d * 128;
        r.K = hm + 1 * HMS + hrow * 128; r.V = hm + 2 * HMS + hrow * 128; r.ks = d * 128;
        r.O = (hf*)(ws + WS_OA) + ((long)p * NTOK + q0) * GW + h * 128; r.os = d * GW;
        r.LSE = (float*)(ws + WS_LSE) + ((long)p * NTOK + q0) * 4 + h; r.ls = d * 4;
        r.P0 = l0; r.W = 129; r.j_lo = (l0 >= 128) ? (l0 - 128) / 64 : 0; r.j_hi = (l0 + 255) / 64 + 1; if (r.j_hi > Lsub / 64) r.j_hi = Lsub / 64;
    } else {
        const int i = Li - NI_C - NI_A, b = i >> 6, h = (i >> 4) & 3, blk = i & 15;
        const long row0 = (long)b * SEQ + 256 * blk;
        const hf* kv = (const hf*)(ws + WS_KVMEM) + (size_t)L * 512 * 1024 + (long)b * NMEM * 1024 + h * 128;
        r.Q = hm + 6 * HMS + ((long)(b * 4 + h) * SEQ + 256 * blk) * 128; r.qs = 128;
        r.K = kv; r.V = kv + GW; r.ks = 1024;
        r.O = (hf*)(ws + WS_OX) + row0 * GW + h * 128; r.os = GW; r.LSE = nullptr; r.ls = 0;
        r.P0 = 1 << 20; r.W = 1 << 30; r.j_lo = 0; r.j_hi = 4;
    }
    return r;
}
__device__ __forceinline__ att::BlkRef gather_decode(int gi, unsigned char* ws, int L, const LAS int* tab) {
    int k = 0;
#pragma unroll 1
    for (int s = 64; s > 0; s >>= 1) if (tab[k + s] <= gi) k += s;
    const int chunk = gi - tab[k], bh = k >> 4, n = k & 15, b = bh >> 2, h = bh & 3;
    const hf* hm = (const hf*)(ws + WS_HM); constexpr long HMS = (long)NTOK * GW;
    const long hrow = (long)(b * 4 + h) * SEQ;
    const unsigned total = __hip_atomic_load((unsigned*)(ws + WS_CTL) + CW_CNT + L * 128 + k, __ATOMIC_RELAXED, __HIP_MEMORY_SCOPE_AGENT);
    att::BlkRef r;
    r.list = (const unsigned*)(ws + WS_LIST) + (size_t)k * SEQ + chunk * 256; r.cnt = (int)total - chunk * 256; if (r.cnt > 256) r.cnt = 256;
    r.Q = hm + 3 * HMS + hrow * 128; r.qs = 128;
    r.K = hm + 4 * HMS + hrow * 128; r.V = hm + 5 * HMS + hrow * 128; r.ks = 128;
    r.O = (hf*)(ws + WS_OCP) + ((long)b * SEQ) * GW + h * 128; r.os = GW;
    r.LSE = (float*)(ws + WS_LSE + MiB) + ((long)b * SEQ) * 4 + h; r.ls = 4;
    r.P0 = 1 << 20; r.W = 1 << 30; r.j_lo = n * 4; r.j_hi = n * 4 + 4;
    return r;
}
__device__ __forceinline__ att::NxtRef nxt_of(const att::BlkRef& n2) { att::NxtRef nx; nx.Q = n2.Q; nx.K = n2.K; nx.V = n2.V; nx.list = n2.list; nx.qs = n2.qs; nx.ks = n2.ks; nx.j_lo = n2.j_lo; nx.cnt = n2.cnt; return nx; }
__device__ __forceinline__ int wg_dequeue(unsigned* ctr, LAS unsigned char* lds, int base) {
    volatile LAS int* qw = (volatile LAS int*)(lds + LDS_Q_OFF);
    if (threadIdx.x == 0) qw[0] = base + (int)__hip_atomic_fetch_add(ctr, 1u, __ATOMIC_RELAXED, __HIP_MEMORY_SCOPE_AGENT);
    __syncthreads();
    const int v = qw[0];
    __syncthreads();
    return __builtin_amdgcn_readfirstlane(v);
}
__device__ __forceinline__ void phase_mix(LAS unsigned char* lds, int L) {
    const CAS Args* ka0 = (const CAS Args*)__builtin_amdgcn_kernarg_segment_ptr(); asm volatile("" : "+s"(ka0));
    const int Gq = gridDim.x;
    unsigned* qctr = (unsigned*)(ka0->ws + WS_CTL) + CW_BAR + 64 * L;
    unsigned* gdone = (unsigned*)(ka0->ws + WS_CTL) + CW_BAR + 32 + 64 * L;
    unsigned* kdone = (unsigned*)(ka0->ws + WS_CTL) + CW_BAR + 48;
    const int Q_M0 = NI_G, Q_C0 = Q_M0 + NI_M, Q_K0 = Q_C0 + NI_C, Q_A0 = Q_K0 + (L == 0 ? NI_K : 0), Q_DYN = Q_A0 + NI_A;
    const int QBASE = 2 * Gq - NI_G;
    LAS int* tab = (LAS int*)(lds + LDS_GTAB);
    bool tabok = false; int GT = 0;
    int L0 = blockIdx.x, L1 = ((int)blockIdx.x >= NI_G) ? (int)blockIdx.x + Gq - NI_G : -1;
    unsigned char* ws = ka0->ws;
#define IS_ATT(i) (((i) >= Q_C0 && (i) < Q_K0) || ((i) >= Q_A0 && (i) < Q_DYN) || (tabok && (i) >= Q_DYN && (i) < Q_DYN + GT + NI_X))
#define ATT_DECODE(i) ((i) < Q_K0 ? mix_decode((i) - Q_C0, ws, L) : ((i) < Q_DYN ? mix_decode(NI_C + (i) - Q_A0, ws, L) : \
                       ((i) < Q_DYN + GT ? gather_decode((i) - Q_DYN, ws, L, tab) : mix_decode(NI_C + NI_A + (i) - Q_DYN - GT, ws, L))))
    for (;;) {
        if (L0 >= Q_DYN && !tabok) {
            __syncthreads();
            if (threadIdx.x == 0) { unsigned sp = 0u;
                while (__hip_atomic_load(gdone, __ATOMIC_RELAXED, __HIP_MEMORY_SCOPE_AGENT) < (unsigned)NI_M || __hip_atomic_load(kdone, __ATOMIC_RELAXED, __HIP_MEMORY_SCOPE_AGENT) < (unsigned)NI_K) { __builtin_amdgcn_s_sleep(2); if (++sp > (1u << 22)) break; }
                __builtin_amdgcn_fence(__ATOMIC_ACQUIRE, "agent"); asm volatile("s_waitcnt vmcnt(0)" ::: "memory"); }
            __syncthreads();
            {
                int tid_s = threadIdx.x; asm volatile("" : "+v"(tid_s));
                LAS int* cl = tab + 160;
                if (tid_s < 128) cl[tid_s] = ((int)__hip_atomic_load((unsigned*)(ws + WS_CTL) + CW_CNT + L * 128 + tid_s, __ATOMIC_RELAXED, __HIP_MEMORY_SCOPE_AGENT) + 255) >> 8;
                __syncthreads();
                if (tid_s <= 128) { int s = 0; for (int k = 0; k < tid_s; ++k) s += cl[k]; tab[tid_s] = s; }
            }
            __syncthreads();
            GT = tab[128]; tabok = true;
        }
        if (tabok && L0 >= Q_DYN + GT + NI_X + NI_B) break;
        if (L0 < Q_M0) {
            {
                KA_BEGIN();
                pg8::Gemm g{(const hf*)(ws + WS_XN), (const hf*)(ws + WS_WINT) + (size_t)L * NCOL * DM, NTOK, NCOL, DM};
                pg8::OneUnit S{L0 & 31, (PROJ_N1 / 256) + (L0 >> 5)};
                float* cosT = (float*)(ws + WS_ROPE);
                pg8::EpiProj E{(hf*)(ws + WS_PROJ), cosT, cosT + SEQ * 64, (float*)(ws + WS_KPART), (f32x2*)(ws + WS_VSTAT), (const float*)(ws + WS_ROWSS), (hf*)(ws + WS_HM)};
                pg8::gemm_phase<pg8::EpiProj, pg8::OneUnit, true, true>(lds, g, S, E);
            }
            L0 = wg_dequeue(qctr, lds, QBASE); L1 = wg_dequeue(qctr, lds, QBASE);
        } else if (L0 < Q_C0) {
            moba_gate_item(L0 - Q_M0, ws, L, lds);
            L0 = L1; L1 = wg_dequeue(qctr, lds, QBASE);
        } else if (L0 >= Q_K0 && L0 < Q_A0) {
            memkv_tile(L0 - Q_K0, lds);
            L0 = L1; L1 = wg_dequeue(qctr, lds, QBASE);
        } else if (tabok && L0 >= Q_DYN + GT + NI_X) {
            KA_BEGIN();
            MixP P{(const hf*)(ws + WS_PROJ), (const hf*)(ws + WS_KVMEM) + (size_t)L * 512 * 1024, (hf*)(ws + WS_OA), (float*)(ws + WS_LSE), (hf*)(ws + WS_OB), (hf*)(ws + WS_OCP),
                   (float*)(ws + WS_LSE + MiB), (hf*)(ws + WS_OX), (const float*)(ws + WS_KPART), (const f32x2*)(ws + WS_VSTAT), (const hf*)(ws + WS_SGUW) + (size_t)L * 4 * 128 * 128,
                   (const float*)(ws + WS_SGUW + 512 * 1024) + L * 512, ka->in[5] + L * 512, ka->in[6] + L * GW, ka->in[7] + L * GW};
            const int it = (L0 - (Q_DYN + GT + NI_X)) * 8 + wave;
            const int itx = ((it & 7) << 8) | (it >> 3);
            item_B(P, itx, lds + wave * WAVE_LDS, lane, fr, quad);
            L0 = L1; L1 = wg_dequeue(qctr, lds, QBASE);
        } else {
            att::Seam S;
            { const att::BlkRef c0 = ATT_DECODE(L0); att::blk_prime(c0, (LAS char*)lds, S); }
            for (;;) {
                const bool more = IS_ATT(L1);
                unsigned tk = 0u;
                if (threadIdx.x == 0) tk = __hip_atomic_fetch_add(qctr, 1u, __ATOMIC_RELAXED, __HIP_MEMORY_SCOPE_AGENT);
                const att::BlkRef cur = ATT_DECODE(L0);
                const int Ln = more ? L1 : L0;
                const att::NxtRef nx = nxt_of(ATT_DECODE(Ln));
                volatile LAS int* qw = (volatile LAS int*)(lds + LDS_Q_OFF);
                att::blk_run(cur, nx, (LAS char*)lds, S, tk, qw, QBASE);
                const int L2 = __builtin_amdgcn_readfirstlane(qw[0]);
                L0 = L1; L1 = L2;
                if (!more) break;
            }
            asm volatile("s_waitcnt vmcnt(0)" ::: "memory");
            __syncthreads();
        }
    }
#undef IS_ATT
#undef ATT_DECODE
}

__device__ __forceinline__ void phase_finalize(int L) {
    KA_BEGIN();
    const hf* proj = (const hf*)(ws + WS_PROJ); const hf* oa = (const hf*)(ws + WS_OA); const hf* ob = (const hf*)(ws + WS_OB); const hf* ocp = (const hf*)(ws + WS_OCP); const hf* ox = (const hf*)(ws + WS_OX);
    const float* lsea = (const float*)(ws + WS_LSE); const float* lsec = (const float*)(ws + WS_LSE + MiB); hf* yb = (hf*)(ws + WS_Y);
    const float* cw = ka->in[8] + (size_t)L * 3 * GW; const float* ong = ka->in[11] + (size_t)L * MIXW;
    for (int t = gw; t < NTOK; t += NGW) {
        const int pos = t & (SEQ - 1), hd = lane >> 4, c8 = 8 * lane;
        const hf* prow = proj + (size_t)t * NCOL;
        float u[5][8];
        {
            float ls[3], mx = -3e38f;
#pragma unroll
            for (int p = 0; p < 3; ++p) { ls[p] = lsea[((size_t)p * NTOK + t) * 4 + hd]; mx = fmaxf(mx, ls[p]); }
            float wsum = 0.f, acc[8] = {0, 0, 0, 0, 0, 0, 0, 0};
#pragma unroll
            for (int p = 0; p < 3; ++p) { const float w = __builtin_amdgcn_exp2f(ls[p] - mx); wsum += w; const h8 o = __builtin_nontemporal_load((const h8*)(oa + ((size_t)p * NTOK + t) * GW + c8));
#pragma unroll
                for (int i = 0; i < 8; ++i) acc[i] += w * (float)o[i]; }
            const float inv = 1.0f / wsum; const h8 gt = __builtin_nontemporal_load((const h8*)(prow + SL_AG * GW + c8));
#pragma unroll
            for (int i = 0; i < 8; ++i) u[0][i] = acc[i] * inv * (float)gt[i];
        }
        {
            const h8 o = __builtin_nontemporal_load((const h8*)(ob + (size_t)t * GW + c8));
#pragma unroll
            for (int i = 0; i < 8; ++i) u[1][i] = (float)o[i];
        }
        {
            float ls[4], mx = -3e38f;
#pragma unroll
            for (int p = 0; p < 4; ++p) { ls[p] = lsec[((size_t)p * NTOK + t) * 4 + hd]; mx = fmaxf(mx, ls[p]); }
            float wsum = 0.f, acc[8] = {0, 0, 0, 0, 0, 0, 0, 0};
#pragma unroll
            for (int p = 0; p < 4; ++p) if (ls[p] > -1e29f) { const float w = __builtin_amdgcn_exp2f(ls[p] - mx); wsum += w; const h8 o = __builtin_nontemporal_load((const h8*)(ocp + ((size_t)p * NTOK + t) * GW + c8));
#pragma unroll
                for (int i = 0; i < 8; ++i) acc[i] += w * (float)o[i]; }
            const float inv = 1.0f / wsum; const h8 gt = __builtin_nontemporal_load((const h8*)(prow + SL_CG * GW + c8));
#pragma unroll
            for (int i = 0; i < 8; ++i) u[2][i] = acc[i] * inv * (float)gt[i];
        }
        {
            float y[8] = {0, 0, 0, 0, 0, 0, 0, 0};
#pragma unroll
            for (int k = 0; k < 3; ++k) { const int back = 2 - k;
                if (pos - back >= 0) { const hf* pr = prow - (size_t)back * NCOL; const h8 z = *(const h8*)(pr + SL_DC * GW + c8);
                    const f32x4 w0 = *(const f32x4*)(cw + k * GW + c8), w1 = *(const f32x4*)(cw + k * GW + c8 + 4);
#pragma unroll
                    for (int i = 0; i < 4; ++i) { y[i] += w0[i] * (float)z[i]; y[4 + i] += w1[i] * (float)z[4 + i]; } } }
            const h8 dbg = __builtin_nontemporal_load((const h8*)(prow + SL_DB * GW + c8));
#pragma unroll
            for (int i = 0; i < 8; ++i) u[3][i] = (float)dbg[i] * y[i];
        }
        {
            const h8 o = __builtin_nontemporal_load((const h8*)(ox + (size_t)t * GW + c8)), gt = __builtin_nontemporal_load((const h8*)(prow + SL_XG * GW + c8));
#pragma unroll
            for (int i = 0; i < 8; ++i) u[4][i] = (float)o[i] * (float)gt[i];
        }
#pragma unroll
        for (int gq = 0; gq < 5; ++gq) {
            float ss = 0.f;
#pragma unroll
            for (int i = 0; i < 8; ++i) ss += u[gq][i] * u[gq][i];
            const float r = __builtin_amdgcn_rsqf(wave_sum(ss, lane) * (1.0f / GW) + NORM_EPS);
            const f32x4 g0 = *(const f32x4*)(ong + gq * GW + c8), g1 = *(const f32x4*)(ong + gq * GW + c8 + 4);
            f32x4 o0, o1;
#pragma unroll
            for (int i = 0; i < 4; ++i) { o0[i] = u[gq][i] * r * g0[i]; o1[i] = u[gq][4 + i] * r * g1[i]; }
            *(h8*)(yb + (size_t)t * MIXW + gq * GW + c8) = pack8(o0, o1);
        }
    }
}

__device__ __forceinline__ void phase_out(LAS unsigned char* lds, int L) {
    KA_BEGIN();
    float* x1 = (float*)(ws + WS_X1);
    pg8::Gemm g{(const hf*)(ws + WS_Y), (const hf*)(ws + WS_WOUTT) + (size_t)L * DM * MIXW, NTOK, DM, MIXW}; pg8::StaticOrder S; S.init(NTOK, DM, G, (int)blockIdx.x);
    pg8::EpiRes E{L == 0 ? ka->in[0] : (const float*)nullptr, (const hf*)(ws + WS_XN), L == 0 ? (hf*)(ws + WS_XN) : (hf*)x1, (float*)(ws + WS_ROWSS),
                  L == 0 ? (float*)nullptr : ka->out, ka->in[13], (unsigned*)(ws + WS_CTL) + CW_CNT + 256};
    pg8::gemm_phase<pg8::EpiRes, pg8::StaticOrder, true, true>(lds, g, S, E);
}
__device__ __forceinline__ void phase_norm_mid() {
    KA_BEGIN();
    const float* x1 = (const float*)(ws + WS_X1); hf* xn = (hf*)(ws + WS_XN); const float* g1 = ka->in[2] + DM;
    for (int m = gw; m < NTOK; m += NGW) rms_row(x1 + (size_t)m * DM, g1, xn + (size_t)m * DM, nullptr, lane);
}
__device__ __forceinline__ void phase_norm_final() {
    KA_BEGIN();
    float* out = ka->out; const float* gf = ka->in[13]; const hf* x2 = (const hf*)(ws + WS_X1); const float* rowss = (const float*)(ws + WS_ROWSS);
    for (int m = gw; m < NTOK; m += NGW) {
        const f32x4 pa = *(const f32x4*)(rowss + (size_t)m * 8), pb = *(const f32x4*)(rowss + (size_t)m * 8 + 4);
        const float r = __builtin_amdgcn_rsqf(((pa[0] + pa[1]) + (pa[2] + pa[3]) + (pb[0] + pb[1]) + (pb[2] + pb[3])) * (1.0f / DM) + NORM_EPS);
#pragma unroll
        for (int j = 0; j < 4; ++j) { const int c = 8 * (lane + 64 * j); const h8 v = *(const h8*)(x2 + (size_t)m * DM + c);
            const f32x4 g0 = *(const f32x4*)(gf + c), g1 = *(const f32x4*)(gf + c + 4); f32x4 o0, o1;
#pragma unroll
            for (int i = 0; i < 4; ++i) { o0[i] = (float)v[i] * r * g0[i]; o1[i] = (float)v[4 + i] * r * g1[i]; }
            *(f32x4*)(out + (size_t)m * DM + c) = o0; *(f32x4*)(out + (size_t)m * DM + c + 4) = o1; }
    }
}


#define XB_TMO      128
#define XB_XCNT(j)  (256  + 64 * (j))
#define XB_XSUB(j)  (1280 + 64 * (j))
#define XB_XGEN(j)  (2304 + 64 * (j))
#define XB_TOP      3328
#define XB_TOPGEN   3392
#define XCD_BAR_WORDS 3456
#define XB_SPIN_CAP (1u << 18)
__device__ __forceinline__ unsigned xb_ld(unsigned* p)              { return __hip_atomic_load(p, __ATOMIC_RELAXED, __HIP_MEMORY_SCOPE_AGENT); }
__device__ __forceinline__ unsigned xb_add(unsigned* p, unsigned v) { return __hip_atomic_fetch_add(p, v, __ATOMIC_RELAXED, __HIP_MEMORY_SCOPE_AGENT); }
__device__ __forceinline__ unsigned xb_xcc_id() { return (unsigned)__builtin_amdgcn_s_getreg((3 << 11) | 20) & 0xFu; }
#define XB_SPIN(cond, bar) do { unsigned _sp = 0; while (cond) { __builtin_amdgcn_s_sleep(1); \
    if ((++_sp & 255u) == 0u) { if (xb_ld(&(bar)[XB_TMO])) break; if (_sp > XB_SPIN_CAP) { atomicAdd(&(bar)[XB_TMO], 1u); break; } } } } while (0)
struct XcdBarrier { unsigned* bar; unsigned x; volatile LAS unsigned* st; };
__device__ __forceinline__ XcdBarrier xcd_barrier_post(unsigned* bar, volatile LAS unsigned* st) {
    XcdBarrier b; b.bar = bar; b.x = xb_xcc_id(); b.st = st;
    if (threadIdx.x == 0) (void)xb_add(&bar[XB_XCNT(b.x)], 1u);
    return b;
}
__device__ __forceinline__ void xcd_barrier_complete(unsigned* bar, unsigned x, unsigned& nloc, unsigned& nx) {
    const unsigned G = gridDim.x * gridDim.y * gridDim.z;
    unsigned sum, cnt, mine, sp = 0u;
    for (;;) {
        sum = 0u; cnt = 0u; mine = 0u;
#pragma unroll
        for (unsigned j = 0; j < 16; ++j) { const unsigned c = xb_ld(&bar[XB_XCNT(j)]); sum += c; cnt += (c > 0u) ? 1u : 0u; mine = (j == x) ? c : mine; }
        if (sum == G) break;
        __builtin_amdgcn_s_sleep(1);
        if ((++sp & 255u) == 0u) { if (xb_ld(&bar[XB_TMO])) break; if (sp > XB_SPIN_CAP) { atomicAdd(&bar[XB_TMO], 1u); break; } }
    }
    nloc = mine > 0u ? mine : 1u; nx = cnt > 0u ? cnt : 1u;
}
__device__ __forceinline__ void xcd_barrier(const XcdBarrier& b) {
    asm volatile("s_waitcnt vmcnt(0)" ::: "memory");
    __syncthreads();
    if (threadIdx.x == 0) {
        unsigned* bar = b.bar;
        __builtin_amdgcn_s_waitcnt(0);
        unsigned nloc = b.st[0], nx = b.st[1];
        if (nloc == 0u) { xcd_barrier_complete(bar, b.x, nloc, nx); b.st[0] = nloc; b.st[1] = nx; }
        const unsigned old = xb_add(&bar[XB_XSUB(b.x)], 1u);
        const unsigned gen = old / nloc;
        if (old + 1u == (gen + 1u) * nloc) {
            __builtin_amdgcn_fence(__ATOMIC_RELEASE, "agent");
            asm volatile("s_waitcnt vmcnt(0)" ::: "memory");
            const unsigned og = xb_add(&bar[XB_TOP], 1u);
            const unsigned tg = og / nx;
            if (og + 1u == (tg + 1u) * nx) xb_add(&bar[XB_TOPGEN], 1u);
            else XB_SPIN(xb_ld(&bar[XB_TOPGEN]) == tg, bar);
            __builtin_amdgcn_fence(__ATOMIC_ACQUIRE, "agent");
            xb_add(&bar[XB_XGEN(b.x)], 1u);
            asm volatile("s_waitcnt vmcnt(0)" ::: "memory");
        } else {
            XB_SPIN(xb_ld(&bar[XB_XGEN(b.x)]) == gen, bar);
            __builtin_amdgcn_fence(__ATOMIC_ACQUIRE, "agent");
            asm volatile("s_waitcnt vmcnt(0)" ::: "memory");
        }
    }
    __syncthreads();
}
constexpr int LDS_BAR_OFF = 131072;

__global__ void __launch_bounds__(NWAVES * 64, 2) mk_fwd(Args args) {
    extern __shared__ __attribute__((aligned(16))) unsigned char lds_raw[];
    LAS unsigned char* lds = (LAS unsigned char*)lds_raw;
    const int ph_lo = args.ph_lo, ph_hi = args.ph_hi;
    if (threadIdx.x < 4) ((LAS unsigned*)(lds + LDS_BAR_OFF))[threadIdx.x] = 0u;
    if (COOP && blockIdx.x == 0) { unsigned* bw = (unsigned*)(args.ws + WS_CTL) + 4096; for (int i = threadIdx.x; i < XCD_BAR_WORDS; i += NWAVES * 64) __hip_atomic_store(bw + i, 0u, __ATOMIC_RELAXED, __HIP_MEMORY_SCOPE_AGENT); }
    __syncthreads();
    XcdBarrier xbar; xbar.bar = (unsigned*)(args.ws + WS_CTL) + 4096; xbar.x = 0; xbar.st = (volatile LAS unsigned*)(lds + LDS_BAR_OFF);
    if (!COOP) xbar = xcd_barrier_post(xbar.bar, xbar.st);
    for (int ph = ph_lo; ph < ph_hi; ++ph) {
        if (ph == 10 || ph == 5 || ph == 11) continue;
        int kind = 6;
        if (ph == 0) kind = 0; else if (ph < 11) kind = 1 + (ph - 1) % 5;
        const int nrep = 1 + ((REP_MASK >> kind) & 1);
        for (int rep = 0; rep < nrep; ++rep) {
        if (ph == 0) { if (PH_EN(0)) phase_prologue(lds); }
        else if (ph == 11) { if (PH_EN(6)) phase_norm_final(); }
        else {
            const int L = (ph - 1) / 5, sp = (ph - 1) % 5;
            if (sp == 0) { if (PH_EN(1)) phase_proj(lds, L); }
            else if (sp == 1) { if (PH_EN(2)) phase_mix(lds, L); }
            else if (sp == 2) { if (PH_EN(3)) phase_finalize(L); }
            else if (sp == 3) { if (PH_EN(4)) phase_out(lds, L); }
            else if (L == 0) { if (PH_EN(5)) phase_norm_mid(); }
        }
        __syncthreads();
        }
        if (ph + 1 < ph_hi) { for (int r = 0; r < SYNC_REP; ++r) { if (COOP && (ph == 0 || !XB_USE)) { __syncthreads(); cg::this_grid().sync(); if (ph == 0 && r == 0) xbar = xcd_barrier_post(xbar.bar, xbar.st); } else xcd_barrier(xbar); } }
    }
}

extern "C" void kernel_launch(void* const* d_in, const int* in_sizes, int n_in, void* d_out, int out_size, void* d_ws, size_t ws_size, hipStream_t stream) {
    static int grid = 0;
    if (grid == 0) {
        if (n_in != 14 || out_size != NTOK * DM || ws_size < WS_END) { fprintf(stderr, "kernel_launch: unexpected shapes (n_in %d, out %d, ws %zu)\n", n_in, out_size, ws_size); grid = -1; return; }
        int dev = 0, cus = 0, per_cu = 0;
        hipGetDevice(&dev); hipDeviceGetAttribute(&cus, hipDeviceAttributeMultiprocessorCount, dev);
        if (hipFuncSetAttribute((const void*)mk_fwd, hipFuncAttributeMaxDynamicSharedMemorySize, LDS_BYTES) != hipSuccess) { fprintf(stderr, "kernel_launch: hipFuncSetAttribute failed\n"); grid = -1; return; }
        if (hipOccupancyMaxActiveBlocksPerMultiprocessor(&per_cu, (const void*)mk_fwd, NWAVES * 64, LDS_BYTES) != hipSuccess || per_cu < 1) { fprintf(stderr, "kernel_launch: occupancy query says %d\n", per_cu); per_cu = 1; }
        (void)hipGetLastError();
        grid = cus;
    }
    if (grid < 0) return;
    Args a{};
    for (int i = 0; i < 14; ++i) a.in[i] = (const float*)d_in[i];
    a.out = (float*)d_out; a.ws = (unsigned char*)d_ws;
#if MK_FUSED
    a.ph_lo = 0; a.ph_hi = 10;
#if COOP
    void* kargs[] = {&a};
    hipError_t e = hipLaunchCooperativeKernel((const void*)mk_fwd, dim3(grid), dim3(NWAVES * 64), kargs, LDS_BYTES, stream);
    if (e != hipSuccess) fprintf(stderr, "cooperative launch failed: %s (grid %d)\n", hipGetErrorString(e), grid);
#else
    if (hipMemsetAsync((char*)d_ws + WS_CTL, 0, 65536, stream) != hipSuccess) { fprintf(stderr, "kernel_launch: memset of the control words failed\n"); return; }
    hipLaunchKernelGGL(mk_fwd, dim3(grid), dim3(NWAVES * 64), LDS_BYTES, stream, a);
#endif
#else
    for (int ph = 0; ph < 12; ++ph) {
        if (ph == 10) continue;
        a.ph_lo = ph; a.ph_hi = ph + 1;
        hipLaunchKernelGGL(mk_fwd, dim3(grid), dim3(NWAVES * 64), LDS_BYTES, stream, a);
    }
#endif
}
```

```cpp
#include <hip/hip_runtime.h>
#include <hip/hip_cooperative_groups.h>
#include <cstdio>
#include <cstdint>
namespace cg = cooperative_groups;

#ifndef REP_MASK
#define REP_MASK 0
#endif
#ifndef SYNC_REP
#define SYNC_REP 1
#endif
#define REPS(k) (1 + ((REP_MASK >> (k)) & 1))
#ifndef PH_MASK
#define PH_MASK 0x7f
#endif
#define PH_EN(k) ((PH_MASK >> (k)) & 1)
#ifndef XB_USE
#define XB_USE 1
#endif
#ifndef COOP
#define COOP 0
#endif
#ifndef MK_FUSED
#define MK_FUSED 1
#endif

#define LAS __attribute__((address_space(3)))
typedef _Float16 hf;
typedef _Float16 h8 __attribute__((ext_vector_type(8)));
typedef _Float16 h4 __attribute__((ext_vector_type(4)));
typedef short s16x4 __attribute__((ext_vector_type(4)));
typedef float f32x4 __attribute__((ext_vector_type(4)));
typedef float f32x2 __attribute__((ext_vector_type(2)));
typedef unsigned u32x4 __attribute__((ext_vector_type(4)));

constexpr int SEQ = 4096, NTOK = 8192, DM = 2048, NCOL = 8704, GW = 512, MIXW = 2560, NMEM = 256;
constexpr float NORM_EPS = 1e-6f;
constexpr float QSCALE = 0.08838834764831845f * 1.4426950408889634f;
enum { SL_AQ = 0, SL_AK, SL_AV, SL_AG, SL_BU, SL_BV, SL_BG, SL_CQ, SL_CK, SL_CV, SL_CG, SL_DB, SL_DC, SL_DH, SL_DG, SL_XQ, SL_XG };

constexpr size_t MiB = 1u << 20;
constexpr size_t WS_CTL = 0;
constexpr size_t WS_ROPE = 1 * MiB;
constexpr size_t WS_SGUW = 3 * MiB;
constexpr size_t WS_KPART = 4 * MiB;
constexpr size_t WS_VSTAT = 5 * MiB;
constexpr size_t WS_LSE = 6 * MiB;
constexpr size_t WS_ROWSS = 7 * MiB + 512 * 1024;
constexpr size_t WS_KVMEM = 8 * MiB;
constexpr size_t WS_MEMN = 10 * MiB;
constexpr size_t WS_WMEMT = 16 * MiB;
constexpr size_t WS_WOUTT = 24 * MiB;
constexpr size_t WS_WINT = 48 * MiB;
constexpr size_t WS_XN = 116 * MiB;
constexpr size_t WS_PROJ = 148 * MiB;
constexpr size_t WS_OA = 284 * MiB;
constexpr size_t WS_OB = 308 * MiB;
constexpr size_t WS_OCP = 316 * MiB;
constexpr size_t WS_OX = 348 * MiB;
constexpr size_t WS_Y = 356 * MiB;
constexpr size_t WS_X1 = 396 * MiB;
constexpr size_t WS_HM = 460 * MiB;
constexpr size_t WS_LIST = 520 * MiB;
constexpr size_t WS_END = 524 * MiB;
constexpr int CW_BAR = 4096;
constexpr int CW_CNT = 8192;

constexpr int PROJ_N1 = 8192;
constexpr int LDS_BYTES = 147456;
constexpr int NWAVES = 8;

__device__ __forceinline__ float shx_l(float v, int lane, int mask) { return __builtin_bit_cast(float, __builtin_amdgcn_ds_bpermute((lane ^ mask) << 2, __builtin_bit_cast(int, v))); }
__device__ __forceinline__ float wave_sum(float v, int lane) {
#pragma unroll
    for (int o = 1; o < 64; o <<= 1) v += shx_l(v, lane, o);
    return v;
}
__device__ __forceinline__ h8 pack8(f32x4 a, f32x4 b) {
    h4 x = __builtin_convertvector(a, h4), y = __builtin_convertvector(b, h4);
    return __builtin_shufflevector(x, y, 0, 1, 2, 3, 4, 5, 6, 7);
}
__device__ __forceinline__ float silu_f(float x) { return x * __builtin_amdgcn_rcpf(1.0f + __builtin_amdgcn_exp2f(-1.4426950408889634f * x)); }
__device__ __forceinline__ float gelu_f(float x) {
    const float z2 = 1.5957691216057308f * (x + 0.044715f * x * x * x);
    return x * __builtin_amdgcn_rcpf(1.0f + __builtin_amdgcn_exp2f(-1.4426950408889634f * z2));
}

namespace pg8 {
constexpr int BM = 256, BK = 64, HALF = 128, HTB = HALF * BK * 2, STAGE_BYTES = 8 * HTB, NXCD = 8, WGM = 8;
__host__ __device__ __forceinline__ int lds_byte(int r, int c) { const int st = (r >> 4) * 2 + (c >> 5), rr = r & 15, cc = c & 31, ob = rr * 64 + cc * 2; return st * 1024 + (ob ^ (((ob >> 9) & 1) << 5)); }
__host__ __device__ __forceinline__ void stage_rc(int b, int& R, int& C) { const int st = b / 1024, sb = b % 1024, swz = sb ^ (((sb >> 9) & 1) << 5); R = (st >> 1) * 16 + swz / 64; C = (st & 1) * 32 + (swz % 64) / 2; }
__host__ __device__ __forceinline__ int perm32(int rho) { const int n = rho >> 4, i = rho & 15; return 8 * (i >> 2) + 4 * n + (i & 3); }
struct Unit { int pm, pn; };
struct Gemm { const hf* A; const hf* Bt; int M, N, K; };
struct StaticOrder {
    int nM, nN, nwg, G, c;
    __host__ __device__ void init(int M, int N, int G_, int c_) { nM = M / BM; nN = N / BM; nwg = nM * nN; G = G_; c = c_; }
    __host__ __device__ bool next(int i, Unit& u) const {
        const long L = (long)i * G + c; if (L >= nwg) return false;
        int wgid = (int)L; { const int q = nwg / NXCD, r = nwg % NXCD, xcd = wgid % NXCD, off = wgid / NXCD; wgid = (xcd < r ? xcd * (q + 1) : r * (q + 1) + (xcd - r) * q) + off; }
        const int nig = WGM * nN, gid = wgid / nig, fm = gid * WGM, gsz = (nM - fm) < WGM ? (nM - fm) : WGM;
        u.pm = fm + ((wgid % nig) % gsz); u.pn = (wgid % nig) / gsz; return true;
    }
    __device__ __forceinline__ void a_ready(const Unit&) const {}
    __device__ __forceinline__ void done(const Unit&) const {}
};

struct OneUnit {
    int pm, pn;
    __device__ __forceinline__ bool next(int i, Unit& u) const { if (i != 0) return false; u.pm = pm; u.pn = pn; return true; }
    __device__ __forceinline__ void a_ready(const Unit&) const {}
    __device__ __forceinline__ void done(const Unit&) const {}
};
template <class Epi, class Sched, bool ALIGN_EPI, bool SP2>
__device__ __forceinline__ void gemm_phase(LAS unsigned char* lds, const Gemm g, const Sched& S, const Epi& E) {
    static_assert(SP2, "only the SP2 loop is kept");
    int tid = threadIdx.x; asm volatile("" : "+v"(tid));
    const int wid = __builtin_amdgcn_readfirstlane(tid >> 6), lane = tid & 63, wr = wid >> 2, wc = wid & 3, fr = lane & 15, fq = lane >> 4;
    const int K = g.K, nt = K / BK;
    unsigned voffA[2], voffB[2];
#pragma unroll
    for (int i = 0; i < 2; ++i) { int R, C; stage_rc(tid * 16 + i * 8192, R, C); const int Rb = Epi::PERM ? ((R & ~31) + perm32(R & 31)) : R;
        voffA[i] = (unsigned)(R * K + C) * 2u; voffB[i] = (unsigned)(Rb * K + C) * 2u; }
    const size_t kstep = (size_t)(BK * 2);
    const size_t hstep = (size_t)HALF * K * 2;
    const size_t tstep = 2 * hstep;
    const unsigned ldsw = (unsigned)wid * 1024u;
    const int aoff = lds_byte(wr * 64 + fr, fq * 8), boff = lds_byte(wc * 32 + fr, fq * 8);
#define PG8_SA(b, h) (((b) * 2 + (h)) * HTB)
#define PG8_SB(b, h) ((4 + (b) * 2 + (h)) * HTB)
#define PG8_STAGE(bufoff, gbase, voff) do { _Pragma("unroll") for (int _i = 0; _i < 2; ++_i) \
        __builtin_amdgcn_global_load_lds((const unsigned*)((const char*)(gbase) + (voff)[_i]), (LAS unsigned*)(lds + (bufoff) + ldsw + _i * 8192), 16, 0, 0); } while (0)
#define PG8_LDA(dst, b, h) do { _Pragma("unroll") for (int m = 0; m < 4; ++m) _Pragma("unroll") for (int k = 0; k < 2; ++k) dst[m][k] = *(const LAS h8*)(lds + PG8_SA(b, h) + aoff + m * 2048 + k * 1024); } while (0)
#define PG8_LDB(dst, b, h) do { _Pragma("unroll") for (int n = 0; n < 2; ++n) _Pragma("unroll") for (int k = 0; k < 2; ++k) dst[n][k] = *(const LAS h8*)(lds + PG8_SB(b, h) + boff + n * 2048 + k * 1024); } while (0)
#define PG8_MMA(ai, bj, At, Bt) do { __builtin_amdgcn_s_setprio(1); _Pragma("unroll") for (int m = 0; m < 4; ++m) _Pragma("unroll") for (int n = 0; n < 2; ++n) _Pragma("unroll") for (int k = 0; k < 2; ++k) \
        acc[ai][bj][m][n] = __builtin_amdgcn_mfma_f32_16x16x32_f16(Bt[n][k], At[m][k], acc[ai][bj][m][n], 0, 0, 0); __builtin_amdgcn_s_setprio(0); } while (0)
#define PG8_WAIT_V(n) asm volatile("s_waitcnt vmcnt(" #n ")" ::: "memory")
#define PG8_WAIT_L(n) asm volatile("s_waitcnt lgkmcnt(" #n ")" ::: "memory")
#define PG8_BAR __builtin_amdgcn_s_barrier()
#define PG8_SCHED __builtin_amdgcn_sched_barrier(0)
    Unit cur, nxt; int ui = 0;
    if (!S.next(0, cur)) return;
    f32x4 acc[2][2][4][2];
    E.init(acc, cur, wr, wc, fr, fq);
    h8 At[4][2], B0[2][2], B1[2][2];
    const char* cA = (const char*)g.A + (size_t)cur.pm * tstep; const char* cB = (const char*)g.Bt + (size_t)cur.pn * tstep;
    S.a_ready(cur);
    {
        PG8_STAGE(PG8_SB(0, 0), cB, voffB); PG8_STAGE(PG8_SB(0, 1), cB + hstep, voffB); PG8_STAGE(PG8_SA(0, 0), cA, voffA); PG8_STAGE(PG8_SA(0, 1), cA + hstep, voffA);
        if (wr == 1) PG8_BAR;
        PG8_WAIT_V(2); PG8_BAR;
        PG8_STAGE(PG8_SB(1, 0), cB + kstep, voffB); PG8_STAGE(PG8_SA(1, 0), cA + kstep, voffA); PG8_STAGE(PG8_SB(1, 1), cB + hstep + kstep, voffB);
        PG8_WAIT_V(6); PG8_BAR;
    }
    for (;;) {
        const bool has_next = S.next(ui + 1, nxt);
        const char* nA = has_next ? (const char*)g.A + (size_t)nxt.pm * tstep : cA; const char* nB = has_next ? (const char*)g.Bt + (size_t)nxt.pn * tstep : cB;
        for (int t = 0; t < nt; t += 2) {
            const bool last = (t == nt - 2);
            const char* a1 = cA + (size_t)(t + 1) * kstep;
            const char* a2 = last ? nA : cA + (size_t)(t + 2) * kstep; const char* b2 = last ? nB : cB + (size_t)(t + 2) * kstep;
            const char* a3 = a2 + kstep; const char* b3 = b2 + kstep;
            if (last && has_next) S.a_ready(nxt);
            PG8_LDB(B0, 0, 0); PG8_LDB(B1, 0, 1); PG8_SCHED; PG8_LDA(At, 0, 0); PG8_STAGE(PG8_SA(1, 1), a1 + hstep, voffA);
            PG8_WAIT_V(8); PG8_WAIT_L(0); PG8_BAR; PG8_MMA(0, 0, At, B0); PG8_MMA(0, 1, At, B1); PG8_BAR; PG8_SCHED;
            PG8_LDA(At, 0, 1); PG8_STAGE(PG8_SB(0, 0), b2, voffB); PG8_STAGE(PG8_SB(0, 1), b2 + hstep, voffB); PG8_STAGE(PG8_SA(0, 0), a2, voffA);
            PG8_WAIT_V(8); PG8_WAIT_L(0); PG8_BAR; PG8_MMA(1, 0, At, B0); PG8_MMA(1, 1, At, B1); PG8_BAR; PG8_SCHED;
            PG8_LDB(B0, 1, 0); PG8_LDB(B1, 1, 1); PG8_SCHED; PG8_LDA(At, 1, 0); PG8_STAGE(PG8_SA(0, 1), a2 + hstep, voffA);
            PG8_WAIT_V(8); PG8_WAIT_L(0); PG8_BAR; PG8_MMA(0, 0, At, B0); PG8_MMA(0, 1, At, B1); PG8_BAR; PG8_SCHED;
            PG8_LDA(At, 1, 1); PG8_STAGE(PG8_SB(1, 0), b3, voffB); PG8_STAGE(PG8_SB(1, 1), b3 + hstep, voffB); PG8_STAGE(PG8_SA(1, 0), a3, voffA);
            PG8_WAIT_V(8); PG8_WAIT_L(0); PG8_BAR; PG8_MMA(1, 0, At, B0); PG8_MMA(1, 1, At, B1); PG8_BAR; PG8_SCHED;
        }
        if constexpr (ALIGN_EPI) { if (wr == 0) PG8_BAR; }
        if constexpr (!Epi::AFTER_DRAIN) { E(acc, cur, wr, wc, fr, fq); S.done(cur); }
        if (!has_next) break;
        E.init(acc, nxt, wr, wc, fr, fq);
        cur = nxt; cA = nA; cB = nB; ++ui;
        if constexpr (ALIGN_EPI) { if (wr == 1) PG8_BAR; }
    }
    PG8_WAIT_V(0);
    if constexpr (!ALIGN_EPI) { if (wr == 0) PG8_BAR; }
    PG8_BAR;
    if constexpr (Epi::AFTER_DRAIN) { E.fused(acc, cur, wr, wc, fr, fq, lds); S.done(cur); }
#undef PG8_SA
#undef PG8_SB
#undef PG8_STAGE
#undef PG8_LDA
#undef PG8_LDB
#undef PG8_MMA
#undef PG8_WAIT_V
#undef PG8_WAIT_L
#undef PG8_BAR
#undef PG8_SCHED
}

struct EpiProj {
    static constexpr bool PERM = true, AFTER_DRAIN = false;
    hf* O; const float* cosT; const float* sinT; float* kpart; f32x2* vstat; const float* rowss; hf* HM;
    __device__ __forceinline__ void init(f32x4 (&acc)[2][2][4][2], const Unit&, int, int, int, int) const {
#pragma unroll
        for (int a = 0; a < 2; ++a)
#pragma unroll
            for (int b = 0; b < 2; ++b)
#pragma unroll
                for (int m = 0; m < 4; ++m)
#pragma unroll
                    for (int n = 0; n < 2; ++n) acc[a][b][m][n] = (f32x4){0.f, 0.f, 0.f, 0.f};
    }
    template <int TYPE>
    __device__ __forceinline__ void run(const f32x4 (&acc)[2][2][4][2], const Unit& u, int wr, int wc, int fr, int fq, int hmi, int colbase) const {
        asm volatile("" : "+v"(fr), "+v"(fq));
        const int row0 = u.pm * BM + wr * 64 + fr, col0 = colbase + wc * 32 + 8 * fq;
        const int jj = 4 * wc + fq;
        if (TYPE >= 8) {
#pragma unroll
            for (int ai = 0; ai < 2; ++ai)
#pragma unroll
                for (int m = 0; m < 4; ++m) {
                    const int row = row0 + ai * HALF + m * 16;
                    const f32x4 pa = *(const f32x4*)(rowss + (size_t)row * 8), pb = *(const f32x4*)(rowss + (size_t)row * 8 + 4);
                    const float rsc = __builtin_amdgcn_rsqf(((pa[0] + pa[1]) + (pa[2] + pa[3]) + (pb[0] + pb[1]) + (pb[2] + pb[3])) * (1.0f / DM) + NORM_EPS);
#pragma unroll
                    for (int bj = 0; bj < 2; ++bj) {
                        const f32x4 v0 = acc[ai][bj][m][0] * rsc, v1 = acc[ai][bj][m][1] * rsc; f32x4 pr;
#pragma unroll
                        for (int i = 0; i < 4; ++i) pr[i] = (TYPE == 8 ? gelu_f(v0[i]) : v0[i]) * (TYPE == 10 ? v1[i] : silu_f(v1[i]));
                        *(h4*)(O + (size_t)row * NCOL + colbase + bj * 64 + wc * 16 + 4 * fq) = __builtin_convertvector(pr, h4);
                    }
                    asm volatile("" ::: "memory");
                }
            return;
        }
        f32x4 cs[2][2];
        if (TYPE == 3) {
#pragma unroll
            for (int bj = 0; bj < 2; ++bj)
#pragma unroll
                for (int n = 0; n < 2; ++n) cs[bj][n] = (f32x4){0.f, 0.f, 0.f, 0.f};
        }
        float rscv[8];
        {
            f32x4 pa[8], pb[8];
#pragma unroll
            for (int i = 0; i < 8; ++i) { const int row = row0 + (i >> 2) * HALF + (i & 3) * 16; pa[i] = *(const f32x4*)(rowss + (size_t)row * 8); pb[i] = *(const f32x4*)(rowss + (size_t)row * 8 + 4); }
#pragma unroll
            for (int i = 0; i < 8; ++i) rscv[i] = __builtin_amdgcn_rsqf(((pa[i][0] + pa[i][1]) + (pa[i][2] + pa[i][3]) + (pb[i][0] + pb[i][1]) + (pb[i][2] + pb[i][3])) * (1.0f / DM) + NORM_EPS);
        }
        f32x4 cv_n = (f32x4){1.f, 1.f, 1.f, 1.f}, sv_n = (f32x4){0.f, 0.f, 0.f, 0.f};
        if (TYPE >= 1 && TYPE <= 3) { const int t = row0 & (SEQ - 1); cv_n = *(const f32x4*)(cosT + t * 64 + 4 * jj); sv_n = *(const f32x4*)(sinT + t * 64 + 4 * jj); }
#pragma unroll
        for (int ai = 0; ai < 2; ++ai)
#pragma unroll
            for (int m = 0; m < 4; ++m) {
                const int row = row0 + ai * HALF + m * 16;
                hf* rowp = O + (size_t)row * NCOL + col0;
                const f32x4 cv = cv_n, sv = sv_n;
                if (TYPE >= 1 && TYPE <= 3 && (ai * 4 + m) < 7) {
                    const int in_ = ai * 4 + m + 1, t = (row0 + (in_ >> 2) * HALF + (in_ & 3) * 16) & (SEQ - 1);
                    cv_n = *(const f32x4*)(cosT + t * 64 + 4 * jj); sv_n = *(const f32x4*)(sinT + t * 64 + 4 * jj); }
                float s1 = 0.f, s2 = 0.f;
                const float rsc = rscv[ai * 4 + m];
#pragma unroll
                for (int bj = 0; bj < 2; ++bj) {
                    f32x4 v0 = acc[ai][bj][m][0] * rsc, v1 = acc[ai][bj][m][1] * rsc;
                    if (TYPE >= 1 && TYPE <= 3) {
                        const f32x4 r0 = v0 * cv - v1 * sv, r1 = v1 * cv + v0 * sv; v0 = r0; v1 = r1;
                        if (TYPE == 1) { v0 = v0 * QSCALE; v1 = v1 * QSCALE; }
                        if (TYPE == 3) { cs[bj][0] += v0; cs[bj][1] += v1; asm volatile("" : "+v"(cs[bj][0]), "+v"(cs[bj][1])); }
                    } else if (TYPE == 4 || TYPE == 5) {
#pragma unroll
                        for (int i = 0; i < 4; ++i) { v0[i] = gelu_f(v0[i]); v1[i] = gelu_f(v1[i]); }
                    } else if (TYPE == 6) {
#pragma unroll
                        for (int i = 0; i < 4; ++i) { v0[i] = silu_f(v0[i]); v1[i] = silu_f(v1[i]); }
                    } else if (TYPE == 7) { v0 = v0 * QSCALE; v1 = v1 * QSCALE; }
                    const h8 hv = pack8(v0, v1);
                    if (TYPE == 5) {
#pragma unroll
                        for (int i = 0; i < 8; ++i) { const float x = (float)hv[i]; s1 += x; s2 += x * x; }
                    }
                    if ((TYPE <= 3 || TYPE == 7) && hmi >= 0) {
                        const int hh = (u.pn & 1) * 2 + bj;
                        *(h8*)(HM + (size_t)hmi * NTOK * GW + ((size_t)((row >> 12) * 4 + hh) * SEQ + (row & (SEQ - 1))) * 128 + wc * 32 + 8 * fq) = hv;
                    } else *(h8*)(rowp + bj * HALF) = hv;
                }
                if (TYPE == 5) {
                    { const int ln_ = fq * 16 + fr; s1 += shx_l(s1, ln_, 16); s1 += shx_l(s1, ln_, 32); s2 += shx_l(s2, ln_, 16); s2 += shx_l(s2, ln_, 32); }
                    if (fq == 0) vstat[(size_t)row * 8 + (u.pn & 1) * 4 + wc] = (f32x2){s1, s2};
                }
                asm volatile("" ::: "memory");
            }
        if (TYPE == 3) {
#pragma unroll
            for (int bj = 0; bj < 2; ++bj)
#pragma unroll
                for (int n = 0; n < 2; ++n) {
                    f32x4 c = cs[bj][n];
#pragma unroll
                    for (int o = 1; o < 16; o <<= 1) { const int ln_ = fq * 16 + fr; c[0] += shx_l(c[0], ln_, o); c[1] += shx_l(c[1], ln_, o); c[2] += shx_l(c[2], ln_, o); c[3] += shx_l(c[3], ln_, o); }
                    if (fr == 0) *(f32x4*)(kpart + (size_t)(u.pm * 2 + wr) * GW + (u.pn & 1) * BM + bj * HALF + wc * 32 + 8 * fq + 4 * n) = c;
                }
        }
    }
    __device__ __forceinline__ void operator()(const f32x4 (&acc)[2][2][4][2], const Unit& u, int wr, int wc, int fr, int fq) const {
        const int pn = u.pn, slice = pn >> 1, cb = pn * BM;
        if (pn >= 8 && pn < 12) run<8>(acc, u, wr, wc, fr, fq, -1, SL_BU * GW + (pn - 8) * 128);
        else if (pn == 12 || pn == 13) run<5>(acc, u, wr, wc, fr, fq, -1, SL_BV * GW + (pn - 12) * BM);
        else if (pn >= 22 && pn < 26) run<9>(acc, u, wr, wc, fr, fq, -1, SL_DB * GW + (pn - 22) * 128);
        else if (pn >= 26 && pn < 30) run<10>(acc, u, wr, wc, fr, fq, -1, SL_DC * GW + (pn - 26) * 128);
        else if (slice == SL_AQ || slice == SL_CQ) run<1>(acc, u, wr, wc, fr, fq, slice == SL_AQ ? 0 : 3, cb);
        else if (slice == SL_AK) run<2>(acc, u, wr, wc, fr, fq, 1, cb);
        else if (slice == SL_CK) run<3>(acc, u, wr, wc, fr, fq, 4, cb);
        else if (slice == SL_AG || slice == SL_CG || slice == SL_XG) run<6>(acc, u, wr, wc, fr, fq, -1, cb);
        else if (slice == SL_XQ) run<7>(acc, u, wr, wc, fr, fq, 6, cb);
        else run<0>(acc, u, wr, wc, fr, fq, slice == SL_AV ? 2 : (slice == SL_CV ? 5 : -1), cb);
    }
};
struct EpiRes {
    static constexpr bool PERM = false, AFTER_DRAIN = true;
    const float* res32; const hf* res16; hf* out16; float* rowss; float* out32; const float* gfin; unsigned* pcnt;
    __device__ __forceinline__ void init(f32x4 (&acc)[2][2][4][2], const Unit& u, int wr, int wc, int fr, int fq) const {
        asm volatile("" : "+v"(fr), "+v"(fq));
        const int row0 = u.pm * BM + wr * 64 + fr, col0 = u.pn * BM + wc * 32 + 4 * fq;
#pragma unroll
        for (int ai = 0; ai < 2; ++ai)
#pragma unroll
            for (int m = 0; m < 4; ++m) { const size_t off = (size_t)(row0 + ai * HALF + m * 16) * DM + col0;
#pragma unroll
                for (int bj = 0; bj < 2; ++bj)
#pragma unroll
                    for (int n = 0; n < 2; ++n) {
                        if (res32 != nullptr) acc[ai][bj][m][n] = __builtin_nontemporal_load((const f32x4*)(res32 + off + bj * HALF + n * 16));
                        else acc[ai][bj][m][n] = __builtin_convertvector(__builtin_nontemporal_load((const h4*)(res16 + off + bj * HALF + n * 16)), f32x4); } }
    }
    __device__ __forceinline__ void fused(const f32x4 (&acc)[2][2][4][2], const Unit& u, int wr, int wc, int fr, int fq, LAS unsigned char* lds) const {
        asm volatile("" : "+v"(fr), "+v"(fq));
        const int row0 = u.pm * BM + wr * 64 + fr, col0 = u.pn * BM + wc * 32 + 4 * fq;
        LAS float* red = (LAS float*)lds;
#pragma unroll
        for (int ai = 0; ai < 2; ++ai)
#pragma unroll
            for (int m = 0; m < 4; ++m) { const size_t off = (size_t)(row0 + ai * HALF + m * 16) * DM + col0; float ss = 0.f;
#pragma unroll
                for (int bj = 0; bj < 2; ++bj)
#pragma unroll
                    for (int n = 0; n < 2; ++n) { const f32x4 o = acc[ai][bj][m][n];
                        if (out32 == nullptr) *(h4*)(out16 + off + bj * HALF + n * 16) = __builtin_convertvector(o, h4);
                        ss += (o[0] * o[0] + o[1] * o[1]) + (o[2] * o[2] + o[3] * o[3]); }
                { const int ln_ = fq * 16 + fr; ss += shx_l(ss, ln_, 16); ss += shx_l(ss, ln_, 32); } if (fq == 0) red[(wr * 64 + ai * HALF + m * 16 + fr) * 4 + wc] = ss;
                asm volatile("" ::: "memory"); }
        __syncthreads();
        int t = threadIdx.x; asm volatile("" : "+v"(t));
        if (t < 256) { const f32x4 p = *(const LAS f32x4*)(red + t * 4); __hip_atomic_store(&rowss[(size_t)(u.pm * BM + t) * 8 + u.pn], (p[0] + p[1]) + (p[2] + p[3]), __ATOMIC_RELAXED, __HIP_MEMORY_SCOPE_AGENT); }
        if (out32 != nullptr) {
            asm volatile("s_waitcnt vmcnt(0)" ::: "memory");
            __syncthreads();
            if (t == 0) {
                __hip_atomic_fetch_add(pcnt + u.pm, 1u, __ATOMIC_RELAXED, __HIP_MEMORY_SCOPE_AGENT);
                unsigned sp = 0u;
                while (__hip_atomic_load(pcnt + u.pm, __ATOMIC_RELAXED, __HIP_MEMORY_SCOPE_AGENT) < 8u) { __builtin_amdgcn_s_sleep(1); if (++sp > (1u << 22)) break; }
                __builtin_amdgcn_fence(__ATOMIC_ACQUIRE, "agent"); asm volatile("s_waitcnt vmcnt(0)" ::: "memory");
            }
            __syncthreads();
#pragma unroll
            for (int ai = 0; ai < 2; ++ai)
#pragma unroll
                for (int m = 0; m < 4; ++m) { const int row = row0 + ai * HALF + m * 16; const size_t off = (size_t)row * DM + col0;
                    const f32x4 pa = *(const f32x4*)(rowss + (size_t)row * 8), pb = *(const f32x4*)(rowss + (size_t)row * 8 + 4);
                    const float r = __builtin_amdgcn_rsqf(((pa[0] + pa[1]) + (pa[2] + pa[3]) + (pb[0] + pb[1]) + (pb[2] + pb[3])) * (1.0f / DM) + NORM_EPS);
#pragma unroll
                    for (int bj = 0; bj < 2; ++bj)
#pragma unroll
                        for (int n = 0; n < 2; ++n) { const f32x4 gg = *(const f32x4*)(gfin + col0 + bj * HALF + n * 16);
                            __builtin_nontemporal_store(acc[ai][bj][m][n] * r * gg, (f32x4*)(out32 + off + bj * HALF + n * 16)); }
                    asm volatile("" ::: "memory"); }
        }
    }
};
}

namespace att {
constexpr int NWV = 8, QBLK = 32, KVBLK = 64, QB = NWV * QBLK, D = 128;
constexpr int SHM_V = KVBLK * D * 2, SHM_K = KVBLK * D * 2;
constexpr int LDS_WS = 2 * SHM_V + 2 * SHM_K;
constexpr int LDS_KSUM = LDS_WS + NWV * 96 * 4;
constexpr int LDS_BYTES_ATT = LDS_KSUM + 16 * 128 * 4;
constexpr float THR2 = 11.5f;
typedef float f32x16 __attribute__((ext_vector_type(16)));
typedef short s16x8 __attribute__((ext_vector_type(8)));
typedef _Float16 h2 __attribute__((ext_vector_type(2)));
#define KSWZ(row, colB) ((row) * 256 + ((colB) ^ (((row) & 7) << 4)))
#define SBAR() __builtin_amdgcn_sched_barrier(0)
__device__ __forceinline__ int v_st(int k, int c) { const int kk = (k & ~0xC) | ((k & 4) << 1) | ((k & 8) >> 1); return ((kk >> 3) * 4 + (c >> 5)) * 512 + ((kk & 7) * 32 + (c & 31)) * 2; }
__device__ __forceinline__ int v_rd_base(int lane) { return ((lane & 3) << 3) | (((lane >> 2) & 3) << 6) | (((lane >> 4) & 1) << 5) | (((lane >> 5) & 1) << 8); }
constexpr int v_rd_off(int d0, int ks, int half) { return d0 * 512 + ks * 4096 + half * 2048; }
__device__ __forceinline__ int crow(int r, int hi) { return (r & 3) + 8 * (r >> 2) + 4 * hi; }
__device__ __forceinline__ unsigned cvtpk(float lo, float hi) { const f32x2 v = {lo, hi}; const h2 b = __builtin_convertvector(v, h2); return __builtin_bit_cast(unsigned, b); }
__device__ __forceinline__ void mask_tile(f32x16& p0, f32x16& p1, int dq, unsigned W) {
    const float NEG = -__builtin_inff();
#pragma unroll
    for (int r = 0; r < 16; ++r) {
        const int c = (r & 3) + 8 * (r >> 2);
        if ((unsigned)(dq - c) >= W) p0[r] = NEG;
        if ((unsigned)(dq - c - 32) >= W) p1[r] = NEG;
    }
}
__device__ __forceinline__ void partialSM(f32x16& p0, f32x16& p1, float& m_reg, float& mn, float& alpha) {
    float pmax = p0[0];
#pragma unroll
    for (int r = 1; r < 16; ++r) pmax = fmaxf(pmax, p0[r]);
#pragma unroll
    for (int r = 0; r < 16; ++r) pmax = fmaxf(pmax, p1[r]);
    { auto rr = __builtin_amdgcn_permlane32_swap(__float_as_uint(pmax), __float_as_uint(pmax), false, false);
      pmax = fmaxf(__uint_as_float(rr[0]), __uint_as_float(rr[1])); }
    mn = ((pmax - m_reg) <= THR2) ? m_reg : fmaxf(m_reg, pmax); alpha = __builtin_amdgcn_exp2f(m_reg - mn); m_reg = mn;
#pragma unroll
    for (int r = 0; r < 16; ++r) p0[r] = p0[r] - mn;
#pragma unroll
    for (int r = 0; r < 16; ++r) p1[r] = p1[r] - mn;
#pragma unroll
    for (int r = 0; r < 16; ++r) p0[r] = __builtin_amdgcn_exp2f(p0[r]);
}
__device__ __forceinline__ void finishSM(f32x16& p0, f32x16& p1, float alpha, float& l_reg, h8& pa0, h8& pa1, h8& pa2, h8& pa3) {
#pragma unroll
    for (int r = 0; r < 16; ++r) p1[r] = __builtin_amdgcn_exp2f(p1[r]);
    float ps = 0;
#pragma unroll
    for (int r = 0; r < 16; ++r) ps += p0[r];
#pragma unroll
    for (int r = 0; r < 16; ++r) ps += p1[r];
    { auto rr = __builtin_amdgcn_permlane32_swap(__float_as_uint(ps), __float_as_uint(ps), false, false);
      ps = __uint_as_float(rr[0]) + __uint_as_float(rr[1]); }
    l_reg = l_reg * alpha + ps;
#define PK4(P, B_, OUT) do { unsigned a0 = cvtpk(P[B_+0], P[B_+1]), a1 = cvtpk(P[B_+2], P[B_+3]);                          \
        unsigned b0 = cvtpk(P[B_+4], P[B_+5]), b1 = cvtpk(P[B_+6], P[B_+7]);                                             \
        auto r0 = __builtin_amdgcn_permlane32_swap(a0, b0, false, false); auto r1 = __builtin_amdgcn_permlane32_swap(a1, b1, false, false); \
        u32x4 w = {r0[0], r1[0], r0[1], r1[1]}; OUT = __builtin_bit_cast(h8, w); } while (0)
    PK4(p0, 0, pa0); PK4(p0, 8, pa1); PK4(p1, 0, pa2); PK4(p1, 8, pa3);
#undef PK4
}
template <int KB>
__device__ __forceinline__ void qkt(f32x16& p0, f32x16& p1, const LAS char* K_lds, int r32, int hi, const h8* qr, bool act) {
    if (!act) { const float NEG = -__builtin_inff();
#pragma unroll
        for (int r = 0; r < 16; ++r) { p0[r] = NEG; p1[r] = NEG; } return; }
    p0 = f32x16{}; p1 = f32x16{};
    const LAS char* kb[4];
#pragma unroll
    for (int dd = 0; dd < 4; ++dd) kb[dd] = K_lds + KB * SHM_K + KSWZ(r32, (dd * 16 + hi * 8) * 2);
#pragma unroll
    for (int d0 = 0; d0 < 8; ++d0) { const LAS char* a = kb[d0 & 3] + (d0 >> 2) * 128;
        const h8 b0 = *reinterpret_cast<const LAS h8*>(a);
        const h8 b1 = *reinterpret_cast<const LAS h8*>(a + 32 * 256);
        p0 = __builtin_amdgcn_mfma_f32_32x32x16_f16(b0, qr[d0], p0, 0, 0, 0);
        p1 = __builtin_amdgcn_mfma_f32_32x32x16_f16(b1, qr[d0], p1, 0, 0, 0); }
}
template <int VB>
__device__ __forceinline__ void pv_tile(f32x16* o, int vb0, h8 pa0, h8 pa1, h8 pa2, h8 pa3, bool act) {
    if (!act) return;
#define TRRD(dst, off) asm volatile("ds_read_b64_tr_b16 %0, %1 offset:%2" : "=&v"(dst) : "v"(vb0), "i"(off) : "memory")
#define MKH8(l, h) __builtin_bit_cast(h8, (s16x8){l[0], l[1], l[2], l[3], h[0], h[1], h[2], h[3]})
#define PV_D0(d0) do { s16x4 l0, l1, l2, l3, h0, h1, h2, h3; constexpr int b_ = VB * SHM_V + v_rd_off(d0, 0, 0); \
        TRRD(l0, b_); TRRD(h0, b_ + 2048); TRRD(l1, b_ + 4096); TRRD(h1, b_ + 6144); TRRD(l2, b_ + 8192); TRRD(h2, b_ + 10240); TRRD(l3, b_ + 12288); TRRD(h3, b_ + 14336); \
        asm volatile("s_waitcnt lgkmcnt(0)" ::: "memory"); SBAR();   \
        o[d0] = __builtin_amdgcn_mfma_f32_32x32x16_f16(pa0, MKH8(l0, h0), o[d0], 0, 0, 0);   \
        o[d0] = __builtin_amdgcn_mfma_f32_32x32x16_f16(pa1, MKH8(l1, h1), o[d0], 0, 0, 0);   \
        o[d0] = __builtin_amdgcn_mfma_f32_32x32x16_f16(pa2, MKH8(l2, h2), o[d0], 0, 0, 0);   \
        o[d0] = __builtin_amdgcn_mfma_f32_32x32x16_f16(pa3, MKH8(l3, h3), o[d0], 0, 0, 0); } while (0)
    PV_D0(0); PV_D0(1); PV_D0(2); PV_D0(3);
#undef PV_D0
#undef MKH8
#undef TRRD
}
struct BlkRef { const hf* Q; const hf* K; const hf* V; hf* O; float* LSE; const unsigned* list; int qs, ks, os, ls; int P0, W, j_lo, j_hi, cnt; };
struct NxtRef { const hf* Q; const hf* K; const hf* V; const unsigned* list; int qs, ks, j_lo, cnt; };
struct Seam { h8 qr[8]; h8 st_v0, st_v1, st_k0, st_k1; unsigned ent; };
__device__ __forceinline__ long q_row_of(const unsigned* list, int cnt, int idx, unsigned& ent) {
    ent = 0xFFFFFFFFu; if (list == nullptr) return idx;
    if (idx < cnt) ent = list[idx];
    return ent == 0xFFFFFFFFu ? 0 : (long)(ent & 0xFFFFu);
}
#define ROWP(p, st, k0, rr) ((p) + (long)((k0) + (rr)) * (st) + sc)
#define VMW() asm volatile("s_waitcnt vmcnt(0)" ::: "memory")
#define VMWN(n) asm volatile("s_waitcnt vmcnt(%0)" :: "i"(n) : "memory")
#define SLOAD_H(Kp, Vp, st, k0) do { S.st_v0 = *(const h8*)ROWP(Vp, st, k0, sr); S.st_v1 = *(const h8*)ROWP(Vp, st, k0, 32 + sr);              \
                         S.st_k0 = *(const h8*)ROWP(Kp, st, k0, sr); S.st_k1 = *(const h8*)ROWP(Kp, st, k0, 32 + sr); } while (0)
#define SWRITE_HK(bf) do { *(LAS h8*)(K_lds + (bf) * SHM_K + kws) = S.st_k0; *(LAS h8*)(K_lds + (bf) * SHM_K + kws + 32 * 256) = S.st_k1; } while (0)
#define SWRITE_HV(bf) do { *(LAS h8*)(V_lds + (bf) * SHM_V + vst0) = S.st_v0; *(LAS h8*)(V_lds + (bf) * SHM_V + vst1) = S.st_v1; } while (0)
#define SWRITE_H(bf) do { SWRITE_HV(bf); SWRITE_HK(bf); } while (0)
__device__ __forceinline__ void blk_prime(const BlkRef& cur, LAS char* lds, Seam& S) {
    int tid = threadIdx.x; asm volatile("" : "+v"(tid));
    const int wid = __builtin_amdgcn_readfirstlane(tid >> 6), lane = tid & 63, r32 = lane & 31, hi = lane >> 5;
    const int sr = tid >> 4, sc = (tid & 15) * 8, kws = KSWZ(sr, sc * 2); LAS char* K_lds = lds + 2 * SHM_V;
    const int kb0 = cur.j_lo * KVBLK;
    { const long qrow = q_row_of(cur.list, cur.cnt, wid * QBLK + r32, S.ent);
#pragma unroll
      for (int d0 = 0; d0 < 8; ++d0) S.qr[d0] = *(const h8*)(cur.Q + qrow * cur.qs + d0 * 16 + hi * 8); }
    SLOAD_H(cur.K, cur.V, cur.ks, kb0); VMW(); SWRITE_HK(0);
    __syncthreads();
}
__device__ __forceinline__ void blk_run(const BlkRef& cur, const NxtRef& nxt, LAS char* lds, Seam& S, unsigned tk, volatile LAS int* qw, int qbase) {
    int tid = threadIdx.x; asm volatile("" : "+v"(tid));
    const int wid = __builtin_amdgcn_readfirstlane(tid >> 6), lane = tid & 63, r32 = lane & 31, hi = lane >> 5;
    const int j_lo = cur.j_lo, NT = cur.j_hi - cur.j_lo, W = cur.W;
    const int kbn = nxt.j_lo * KVBLK;
    const int qlo = cur.P0 + wid * QBLK, qm = qlo + r32 - 4 * hi;
    LAS char* V_lds = lds; LAS char* K_lds = lds + 2 * SHM_V;
    LAS float* ws = (LAS float*)(lds + LDS_WS) + wid * 96; LAS float* li_l = ws; LAS float* al_l = ws + 32;
    float m_reg = -1e30f, l_reg = 0; f32x16 o[4] = {}; int epi_r32;
    const int sr = tid >> 4, sc = (tid & 15) * 8, vst0 = v_st(sr, sc), vst1 = v_st(32 + sr, sc), kws = KSWZ(sr, sc * 2);
    const int vb0 = (int)(unsigned)(uintptr_t)V_lds + v_rd_base(lane);
    const hf* Kh = cur.K; const hf* Vh = cur.V; const int kst = cur.ks;
    const unsigned ent_cur = S.ent;
    LAS unsigned* rt_l = (LAS unsigned*)(ws + 64);
    if (cur.list != nullptr && hi == 0) rt_l[r32] = ent_cur;
#define RESC(a) do { if (__any((a) < 1.f)) { if (hi == 0) al_l[r32] = (a); asm volatile("s_waitcnt lgkmcnt(0)" ::: "memory");              \
                     for (int d_ = 0; d_ < 4; ++d_) for (int r = 0; r < 16; ++r) o[d_][r] *= al_l[crow(r, hi)]; } } while (0)
#define KBASE(t) ((j_lo + (t)) * KVBLK)
#define ACT(t) (KBASE(t) <= qlo + QBLK - 1 && KBASE(t) + KVBLK - 1 >= qlo - W + 1)
#define MASKT(P0_, P1_, t) do { const int kb_ = KBASE(t); if (ACT(t) && (kb_ + KVBLK - 1 > qlo || kb_ <= qlo + QBLK - 1 - W)) mask_tile(P0_, P1_, qm - kb_, (unsigned)W); } while (0)
    constexpr int NQL = 8;
#define SEAM_K0() do { VMWN(NQL); SWRITE_HK(0); SBAR(); } while (0)
    f32x16 pA0, pA1, pB0, pB1; float mnA, mnB, alA, alB; h8 pa0, pa1, pa2, pa3;
    SWRITE_HV(0); SBAR();
    if (NT > 1) { SLOAD_H(Kh, Vh, kst, KBASE(1)); }
    SBAR(); qkt<0>(pA0, pA1, K_lds, r32, hi, S.qr, ACT(0));
    if (ACT(0)) { MASKT(pA0, pA1, 0); partialSM(pA0, pA1, m_reg, mnA, alA); } else { mnA = m_reg; alA = 1.f; }
    if (NT > 1) { VMW(); SWRITE_H(1); SBAR(); }
    if (NT > 2) { SLOAD_H(Kh, Vh, kst, KBASE(2)); SBAR(); }
    __syncthreads();
#define HALF_STEP(PX0, PX1, mnX, alX, PY0, PY1, alY, t, KB, VB, SB) do {                                                      \
        SBAR(); qkt<KB>(PX0, PX1, K_lds, r32, hi, S.qr, ACT(t));                                             \
        if (ACT((t) - 1)) finishSM(PY0, PY1, alY, l_reg, pa0, pa1, pa2, pa3); SBAR();                                         \
        pv_tile<VB>(o, vb0, pa0, pa1, pa2, pa3, ACT((t) - 1));                                                                \
        if (ACT(t)) { MASKT(PX0, PX1, (t)); partialSM(PX0, PX1, m_reg, mnX, alX); } else { mnX = m_reg; alX = 1.f; }          \
        __syncthreads();                                                                                                      \
        if ((t) + 1 < NT) { VMW(); SWRITE_H(SB); SBAR(); }                                                                  \
        if ((t) + 2 < NT) { SLOAD_H(Kh, Vh, kst, KBASE((t) + 2)); SBAR(); }                                               \
        RESC(alX); __syncthreads(); } while (0)
    for (int t = 1; t + 1 < NT; t += 2) {
        HALF_STEP(pB0, pB1, mnB, alB, pA0, pA1, alA, t, 1, 0, 0);
        HALF_STEP(pA0, pA1, mnA, alA, pB0, pB1, alB, t + 1, 0, 1, 1);
    }
    const bool even = (NT & 1) == 0;
    if (even) { SBAR(); qkt<1>(pB0, pB1, K_lds, r32, hi, S.qr, ACT(NT - 1)); SBAR(); }
    { SLOAD_H(nxt.K, nxt.V, nxt.ks, kbn); SBAR();
      const long qrow = q_row_of(nxt.list, nxt.cnt, wid * QBLK + r32, S.ent);
#pragma unroll
      for (int d0 = 0; d0 < 8; ++d0) S.qr[d0] = *(const h8*)(nxt.Q + qrow * nxt.qs + d0 * 16 + hi * 8); }
    SBAR();
    if (ACT(even ? NT - 2 : NT - 1)) finishSM(pA0, pA1, alA, l_reg, pa0, pa1, pa2, pa3); SBAR();
    pv_tile<0>(o, vb0, pa0, pa1, pa2, pa3, ACT(even ? NT - 2 : NT - 1));
    if (even) { if (ACT(NT - 1)) { MASKT(pB0, pB1, NT - 1); partialSM(pB0, pB1, m_reg, mnB, alB); } else { mnB = m_reg; alB = 1.f; } __syncthreads(); RESC(alB);
        if (ACT(NT - 1)) finishSM(pB0, pB1, alB, l_reg, pa0, pa1, pa2, pa3); SBAR(); pv_tile<1>(o, vb0, pa0, pa1, pa2, pa3, ACT(NT - 1)); }
    SBAR(); SEAM_K0();
    if (hi == 0) li_l[r32] = l_reg; asm volatile("s_waitcnt lgkmcnt(0)" ::: "memory");
    { int lane_e = lane; asm volatile("" : "+v"(lane_e)); epi_r32 = lane_e & 31; }
    float rli[16];
#pragma unroll
    for (int r = 0; r < 16; ++r) { const float lv = li_l[crow(r, hi)]; rli[r] = lv > 0.f ? __builtin_amdgcn_rcpf(lv) : 0.f; }
    __syncthreads();
    {
        LAS char* ost = V_lds + wid * 4096;
        const bool odd = (epi_r32 & 1) != 0;
        const bool gat = cur.list != nullptr;
        hf* Ow = cur.O + (long)(wid * QBLK) * cur.os;
#pragma unroll
        for (int ps = 0; ps < 2; ++ps) {
#pragma unroll
            for (int r = 0; r < 16; ++r) {
                const float va = o[2 * ps][r] * rli[r], vb = o[2 * ps + 1][r] * rli[r];
                const float got = shx_l(odd ? va : vb, hi * 32 + epi_r32, 1);
                const unsigned w = odd ? cvtpk(got, vb) : cvtpk(va, got);
                *(LAS unsigned*)(ost + crow(r, hi) * 128 + (odd ? 64 : 0) + (epi_r32 & ~1) * 2) = w;
            }
            asm volatile("s_waitcnt lgkmcnt(0)" ::: "memory");
#pragma unroll
            for (int it = 0; it < 4; ++it) {
                const int idx = it * 64 + (hi * 32 + epi_r32), row = idx >> 3, ch = idx & 7;
                const u32x4 v = *(const LAS u32x4*)(ost + row * 128 + ch * 16);
                if (!gat) *(u32x4*)(Ow + (long)row * cur.os + ps * 64 + ch * 8) = v;
                else { const unsigned e = rt_l[row]; if (e != 0xFFFFFFFFu) *(u32x4*)(cur.O + ((long)(e >> 16) * NTOK + (long)(e & 0xFFFFu)) * GW + ps * 64 + ch * 8) = v; }
            }
            asm volatile("s_waitcnt lgkmcnt(0)" ::: "memory");
        }
        if (!gat) { if (cur.LSE != nullptr && hi == 0) cur.LSE[(long)(wid * QBLK + epi_r32) * cur.ls] = l_reg > 0.f ? m_reg + __builtin_amdgcn_logf(l_reg) : -1e30f; }
        else if (hi == 0 && ent_cur != 0xFFFFFFFFu) cur.LSE[((long)(ent_cur >> 16) * NTOK + (long)(ent_cur & 0xFFFFu)) * 4] = l_reg > 0.f ? m_reg + __builtin_amdgcn_logf(l_reg) : -1e30f;
    }
    if (tid == 0) qw[0] = qbase + (int)tk;
    __syncthreads();
#undef RESC
#undef KBASE
#undef ACT
#undef MASKT
#undef SEAM_K0
#undef HALF_STEP
}
#undef ROWP
#undef VMW
#undef VMWN
#undef SLOAD_H
#undef SWRITE_HK
#undef SWRITE_HV
#undef SWRITE_H
#undef KSWZ
#undef SBAR
}

constexpr int VROW = 288;
constexpr int WAVE_LDS = 10240;
constexpr int NG = 1;
constexpr int QW = 16 * NG;
constexpr int NPH = SEQ / QW;

__device__ __forceinline__ void load_q(h8 (&qf)[NG][4], const hf* qb, long qstride, int fr, int quad) {
#pragma unroll
    for (int g = 0; g < NG; ++g) { const hf* p = qb + (long)(16 * g + fr) * qstride + 8 * quad;
#pragma unroll
        for (int c = 0; c < 4; ++c) qf[g][c] = *(const h8*)(p + 32 * c); }
}
__device__ __forceinline__ void v_stage_load(h8 (&vs)[8], const hf* Vt, long stride, int rlo, int rhi, int fr, int quad) {
#pragma unroll
    for (int it = 0; it < 8; ++it) { int r = 4 * it + quad; r = r < rlo ? rlo : r; r = r > rhi ? rhi : r; vs[it] = *(const h8*)(Vt + (long)r * stride + 8 * fr); }
}
__device__ __forceinline__ void v_stage_store(const h8 (&vs)[8], LAS unsigned char* vl, int fr, int quad) {
#pragma unroll
    for (int it = 0; it < 8; ++it) *(LAS h8*)(vl + (4 * it + quad) * VROW + fr * 16) = vs[it];
}
__device__ __forceinline__ void pv_mma(f32x4 (&o)[NG][8], const h8 (&pf)[NG], LAS unsigned char* vl, int fr, int quad) {
    LAS unsigned char* base = vl + (4 * quad + (fr >> 2)) * VROW + 8 * (fr & 3);
#pragma unroll
    for (int dt = 0; dt < 8; ++dt) {
        const s16x4 a = __builtin_amdgcn_ds_read_tr16_b64_v4i16((LAS s16x4*)(base + 32 * dt));
        const s16x4 b = __builtin_amdgcn_ds_read_tr16_b64_v4i16((LAS s16x4*)(base + 16 * VROW + 32 * dt));
        const h4 x = __builtin_bit_cast(h4, a), y = __builtin_bit_cast(h4, b);
        const h8 vf = __builtin_shufflevector(x, y, 0, 1, 2, 3, 4, 5, 6, 7);
#pragma unroll
        for (int g = 0; g < NG; ++g) o[g][dt] = __builtin_amdgcn_mfma_f32_16x16x32_f16(vf, pf[g], o[g][dt], 0, 0, 0);
    }
}
struct AttnAcc { f32x4 o[NG][8]; float m[NG], l[NG]; };
__device__ __forceinline__ void attn_init(AttnAcc& a) {
#pragma unroll
    for (int g = 0; g < NG; ++g) { a.m[g] = -1e30f; a.l[g] = 0.f;
#pragma unroll
        for (int dt = 0; dt < 8; ++dt) a.o[g][dt] = (f32x4){0.f, 0.f, 0.f, 0.f}; }
}
template <class Mask>
__device__ __forceinline__ void attn_step(AttnAcc& a, const h8 (&qf)[NG][4], const hf* Kt, const hf* Vt, long stride, int rlo, int rhi, LAS unsigned char* vl, int fr, int quad, Mask mask) {
    __builtin_amdgcn_sched_barrier(0);
    f32x4 s[NG][2];
    {
        h8 kf[2][4];
#pragma unroll
        for (int kb = 0; kb < 2; ++kb) { int r = 16 * kb + fr; r = r < rlo ? rlo : r; r = r > rhi ? rhi : r; const hf* p = Kt + (long)r * stride + 8 * quad;
#pragma unroll
            for (int c = 0; c < 4; ++c) kf[kb][c] = *(const h8*)(p + 32 * c); }
#pragma unroll
        for (int g = 0; g < NG; ++g)
#pragma unroll
            for (int kb = 0; kb < 2; ++kb) { s[g][kb] = (f32x4){0.f, 0.f, 0.f, 0.f};
#pragma unroll
                for (int c = 0; c < 4; ++c) s[g][kb] = __builtin_amdgcn_mfma_f32_16x16x32_f16(kf[kb][c], qf[g][c], s[g][kb], 0, 0, 0); }
    }
    h8 vs[8];
    v_stage_load(vs, Vt, stride, rlo, rhi, fr, quad);
    h8 pf[NG];
#pragma unroll
    for (int g = 0; g < NG; ++g) {
        float mx = -3e38f;
#pragma unroll
        for (int kb = 0; kb < 2; ++kb)
#pragma unroll
            for (int r = 0; r < 4; ++r) { const float v = mask(g, kb, r) ? s[g][kb][r] : -3e38f; s[g][kb][r] = v; mx = fmaxf(mx, v); }
        { const int ln_ = quad * 16 + fr; mx = fmaxf(mx, shx_l(mx, ln_, 16)); mx = fmaxf(mx, shx_l(mx, ln_, 32)); }
        const float mn = fmaxf(a.m[g], mx), alpha = __builtin_amdgcn_exp2f(a.m[g] - mn);
        a.m[g] = mn; a.l[g] *= alpha;
#pragma unroll
        for (int dt = 0; dt < 8; ++dt) a.o[g][dt] = a.o[g][dt] * alpha;
        f32x4 p0, p1; float ps = 0.f;
#pragma unroll
        for (int r = 0; r < 4; ++r) { p0[r] = __builtin_amdgcn_exp2f(s[g][0][r] - mn); p1[r] = __builtin_amdgcn_exp2f(s[g][1][r] - mn); ps += p0[r] + p1[r]; }
        a.l[g] += ps;
        pf[g] = pack8(p0, p1);
    }
    v_stage_store(vs, vl, fr, quad);
    pv_mma(a.o, pf, vl, fr, quad);
    __builtin_amdgcn_sched_barrier(0);
}
__device__ __forceinline__ void attn_finish(AttnAcc& a, hf* ob, long ostride, float* lsep, long lstride, int fr, int quad) {
#pragma unroll
    for (int g = 0; g < NG; ++g) {
        float lt = a.l[g]; { const int ln_ = quad * 16 + fr; lt += shx_l(lt, ln_, 16); lt += shx_l(lt, ln_, 32); }
        const float inv = lt > 0.f ? 1.0f / lt : 0.f;
        hf* p = ob + (long)(16 * g + fr) * ostride + 4 * quad;
#pragma unroll
        for (int dt = 0; dt < 8; ++dt) { const f32x4 v = a.o[g][dt] * inv; *(h4*)(p + 16 * dt) = __builtin_convertvector(v, h4); }
        if (lsep != nullptr && quad == 0) lsep[(long)(16 * g + fr) * lstride] = lt > 0.f ? a.m[g] + __builtin_log2f(lt) : -1e30f;
    }
}

struct MixP {
    const hf* proj; const hf* kvmem; hf* oa; float* lsea; hf* ob; hf* ocp; float* lsec; hf* ox;
    const float* kpart; const f32x2* vstat; const hf* sguw; const float* sgurs; const float* sgub; const float* lng; const float* lnb;
};
constexpr int N_A = 3 * 8 * NPH, N_X = 8 * NPH, N_C = 40 * 8 * (256 / QW), N_B = 2 * 32 * 4 * (128 / QW);

__device__ __forceinline__ void item_A(const MixP& P, int idx, LAS unsigned char* vl, int fr, int quad) {
    asm volatile("" : "+v"(fr), "+v"(quad));
    const int p = idx / (8 * NPH), r10 = idx % (8 * NPH), b = r10 / (4 * NPH), h = (r10 / NPH) & 3, slot = r10 % NPH;
    const int dsh = 2 * p, d = 1 << dsh, cpr = NPH >> dsh, Lsub = SEQ >> dsh;
    const int res = slot / cpr, ch = slot % cpr, l0 = QW * ch;
    const long rowbase = (long)b * SEQ + res, stride = (long)d * NCOL;
    h8 qf[NG][4];
    load_q(qf, P.proj + (rowbase + (long)l0 * d) * NCOL + SL_AQ * GW + h * 128, stride, fr, quad);
    const hf* Kb = P.proj + rowbase * NCOL + SL_AK * GW + h * 128;
    const hf* Vb = P.proj + rowbase * NCOL + SL_AV * GW + h * 128;
    AttnAcc a; attn_init(a);
    constexpr int NST = (128 + QW + 31) / 32;
    for (int s = NST - 1; s >= 0; --s) {
        const int lk0 = l0 - 128 + 32 * s;
        if (lk0 + 31 < 0) break;
        const int rlo = lk0 < 0 ? -lk0 : 0, rhi = (Lsub - 1 - lk0) < 31 ? (Lsub - 1 - lk0) : 31;
        attn_step(a, qf, Kb + (long)lk0 * stride, Vb + (long)lk0 * stride, stride, rlo, rhi, vl, fr, quad,
                  [&](int g, int kb, int r) { const int lq = l0 + 16 * g + fr, lk = lk0 + 16 * kb + 4 * quad + r; return lk >= 0 && lk <= lq && lq - lk <= 128; });
    }
    const long orow = (long)p * NTOK + rowbase + (long)l0 * d;
    attn_finish(a, P.oa + orow * GW + h * 128, (long)d * GW, P.lsea + orow * 4 + h, (long)d * 4, fr, quad);
}
__device__ __forceinline__ void item_X(const MixP& P, int idx, LAS unsigned char* vl, int fr, int quad) {
    asm volatile("" : "+v"(fr), "+v"(quad));
    const int b = idx / (4 * NPH), h = (idx / NPH) & 3, ch = idx % NPH;
    const long row0 = (long)b * SEQ + QW * ch;
    h8 qf[NG][4];
    load_q(qf, P.proj + row0 * NCOL + SL_XQ * GW + h * 128, NCOL, fr, quad);
    const hf* Kb = P.kvmem + (long)b * NMEM * 1024 + h * 128;
    AttnAcc a; attn_init(a);
    for (int s = 0; s < 8; ++s)
        attn_step(a, qf, Kb + (long)(32 * s) * 1024, Kb + (long)(32 * s) * 1024 + GW, 1024, 0, 31, vl, fr, quad, [&](int, int, int) { return true; });
    attn_finish(a, P.ox + row0 * GW + h * 128, GW, nullptr, 0, fr, quad);
}
__device__ const unsigned char CTAB[40] = {60,61,62,63,56,57,58,52,53,54,48,49,50,44,45,46,40,41,36,37,32,33,28,29,24,20,16,12,59,42,25,8,55,38,21,4,51,34,17,0};
__device__ __forceinline__ void item_C(const MixP& P, int idx, LAS unsigned char* vl, int fr, int quad) {
    asm volatile("" : "+v"(fr), "+v"(quad));
    constexpr int NSUB = 256 / QW;
    const int e = idx / (8 * NSUB), rest = idx % (8 * NSUB), bh = rest / NSUB, sub = rest % NSUB, b = bh >> 2, h = bh & 3;
    const int code = CTAB[e], qblk = code >> 2, part = code & 3;
    const long row0 = (long)b * SEQ + qblk * 256 + sub * QW;
    h8 qf[NG][4];
    load_q(qf, P.proj + row0 * NCOL + SL_CQ * GW + h * 128, NCOL, fr, quad);
    unsigned sel[NG];
    {
        float v1[NG], v2[NG], v3[NG]; int i1[NG], i2[NG], i3[NG];
#pragma unroll
        for (int g = 0; g < NG; ++g) { v1[g] = v2[g] = v3[g] = -3e38f; i1[g] = i2[g] = i3[g] = -1; }
        for (int n = 0; n < qblk; ++n) {
            const float* k0 = P.kpart + (size_t)((b * 16 + n) * 2) * GW + h * 128 + 8 * quad;
            float dv[NG];
#pragma unroll
            for (int g = 0; g < NG; ++g) dv[g] = 0.f;
#pragma unroll
            for (int c = 0; c < 4; ++c) {
                const f32x4 ka = *(const f32x4*)(k0 + 32 * c) + *(const f32x4*)(k0 + GW + 32 * c);
                const f32x4 kb = *(const f32x4*)(k0 + 32 * c + 4) + *(const f32x4*)(k0 + GW + 32 * c + 4);
#pragma unroll
                for (int g = 0; g < NG; ++g)
#pragma unroll
                    for (int i = 0; i < 4; ++i) dv[g] += (float)qf[g][c][i] * ka[i] + (float)qf[g][c][4 + i] * kb[i];
            }
#pragma unroll
            for (int g = 0; g < NG; ++g) {
                float v = dv[g]; { const int ln_ = quad * 16 + fr; v += shx_l(v, ln_, 16); v += shx_l(v, ln_, 32); }
                if (v > v1[g]) { v3[g] = v2[g]; i3[g] = i2[g]; v2[g] = v1[g]; i2[g] = i1[g]; v1[g] = v; i1[g] = n; }
                else if (v > v2[g]) { v3[g] = v2[g]; i3[g] = i2[g]; v2[g] = v; i2[g] = n; }
                else if (v > v3[g]) { v3[g] = v; i3[g] = n; }
            }
        }
#pragma unroll
        for (int g = 0; g < NG; ++g) sel[g] = (i1[g] >= 0 ? 1u << i1[g] : 0u) | (i2[g] >= 0 ? 1u << i2[g] : 0u) | (i3[g] >= 0 ? 1u << i3[g] : 0u);
    }
    unsigned selany = 0u;
#pragma unroll
    for (int g = 0; g < NG; ++g) selany |= sel[g];
    AttnAcc a; attn_init(a);
    const int nlo = 4 * part, nhi = (4 * part + 3 < qblk) ? 4 * part + 3 : qblk;
    for (int n = nlo; n <= nhi; ++n) {
        const hf* Kb = P.proj + ((long)b * SEQ + n * 256) * NCOL + SL_CK * GW + h * 128;
        if (n == qblk) {
            const int tlmax = (QW * sub + QW - 1) >> 5;
            for (int tl = 0; tl <= tlmax; ++tl)
                attn_step(a, qf, Kb + (long)(32 * tl) * NCOL, Kb + (long)(32 * tl) * NCOL + GW, NCOL, 0, 31, vl, fr, quad,
                          [&](int g, int kb, int r) { return 32 * tl + 16 * kb + 4 * quad + r <= QW * sub + 16 * g + fr; });
        } else {
            const bool any = __any((int)((selany >> n) & 1u));
            if (any) {
                for (int tl = 0; tl < 8; ++tl)
                    attn_step(a, qf, Kb + (long)(32 * tl) * NCOL, Kb + (long)(32 * tl) * NCOL + GW, NCOL, 0, 31, vl, fr, quad,
                              [&](int g, int, int) { return ((sel[g] >> n) & 1u) != 0u; });
            }
        }
    }
    const long orow = (long)part * NTOK + row0;
    attn_finish(a, P.ocp + orow * GW + h * 128, GW, P.lsec + orow * 4 + h, 4, fr, quad);
}
__device__ __forceinline__ void item_B(const MixP& P, int idx, LAS unsigned char* vl, int lane, int fr, int quad) {
    asm volatile("" : "+v"(lane)); fr = lane & 15; quad = lane >> 4;
    constexpr int NIG = 128 / QW;
    const int ig = NIG - 1 - (idx >> 8), rest = idx & 255, b = rest >> 7, chunk = (rest >> 2) & 31, g = rest & 3;
    const int smax = (QW * ig + QW - 1) >> 5;
    const long tok0 = (long)b * SEQ + chunk * 128;
    LAS f32x2* stl = (LAS f32x2*)(vl + 32 * VROW);
#pragma unroll
    for (int k = 0; k < 2; ++k) { const int tt = lane + 64 * k;
        if (tt < 32 * (smax + 1)) { const f32x2* sp = P.vstat + (size_t)(tok0 + tt) * 8; float s1 = 0.f, s2 = 0.f;
#pragma unroll
            for (int q = 0; q < 8; ++q) { const f32x2 v = sp[q]; s1 += v.x; s2 += v.y; }
            const float mu = s1 * (1.0f / 512.0f), var = fmaxf(s2 * (1.0f / 512.0f) - mu * mu, 0.f);
            stl[tt] = (f32x2){mu, __builtin_amdgcn_rsqf(var + NORM_EPS)}; } }
    AttnAcc a; attn_init(a);
    float aacc[NG];
#pragma unroll
    for (int g2 = 0; g2 < NG; ++g2) aacc[g2] = 0.f;
    const hf* Vb = P.proj + tok0 * NCOL + SL_BV * GW + g * 128;
    h8 vsa[4][8];
#pragma unroll
    for (int s = 0; s < 4; ++s) if (s <= smax) v_stage_load(vsa[s], Vb + (long)(32 * s) * NCOL, NCOL, 0, 31, fr, quad);
#pragma unroll
    for (int s = 0; s < 4; ++s) { if (s <= smax) {
        const int j0 = 32 * s;
        h8 (&vs)[8] = vsa[s];
        h8 pf[NG];
#pragma unroll
        for (int g2 = 0; g2 < NG; ++g2) {
            const int i = QW * ig + 16 * g2 + fr;
            f32x4 pv[2];
#pragma unroll
            for (int kb = 0; kb < 2; ++kb) { const int j = j0 + 16 * kb + 4 * quad;
                const h4 w = *(const h4*)(P.sguw + ((size_t)(g * 128 + i)) * 128 + j);
#pragma unroll
                for (int r = 0; r < 4; ++r) { const f32x2 st = stl[j + r]; pv[kb][r] = (float)w[r] * st.y; } }
            pf[g2] = pack8(pv[0], pv[1]);
#pragma unroll
            for (int kb = 0; kb < 2; ++kb)
#pragma unroll
                for (int r = 0; r < 4; ++r) aacc[g2] += (float)pf[g2][4 * kb + r] * stl[j0 + 16 * kb + 4 * quad + r].x;
        }
        v_stage_store(vs, vl, fr, quad);
        pv_mma(a.o, pf, vl, fr, quad);
    } }
#pragma unroll
    for (int g2 = 0; g2 < NG; ++g2) {
        float as = aacc[g2]; as += shx_l(as, lane, 16); as += shx_l(as, lane, 32);
        const int i = QW * ig + 16 * g2 + fr;
        const float rs = P.sgurs[g * 128 + i], bs = P.sgub[g * 128 + i];
        const hf* up = P.proj + (tok0 + i) * NCOL + SL_BU * GW + g * 128 + 4 * quad;
        hf* op = P.ob + (tok0 + i) * GW + g * 128 + 4 * quad;
#pragma unroll
        for (int dt = 0; dt < 8; ++dt) {
            const f32x4 gm = *(const f32x4*)(P.lng + g * 128 + 16 * dt + 4 * quad), bt = *(const f32x4*)(P.lnb + g * 128 + 16 * dt + 4 * quad);
            const h4 u = *(const h4*)(up + 16 * dt);
            f32x4 o;
#pragma unroll
            for (int r = 0; r < 4; ++r) o[r] = (float)u[r] * (gm[r] * (a.o[g2][dt][r] - as) + bt[r] * rs + bs);
            *(h4*)(op + 16 * dt) = __builtin_convertvector(o, h4);
        }
    }
}

struct Args { const float* in[14]; float* out; unsigned char* ws; int ph_lo, ph_hi; };

__device__ __forceinline__ int win_phys_row(int n) {
    const int slice = n >> 9, ch = n & 511;
    if (slice == SL_AQ || slice == SL_AK || slice == SL_CQ || slice == SL_CK) { const int d = n & 127, dd = d & 63; return (n & ~127) + 8 * (dd >> 2) + (d >= 64 ? 4 : 0) + (dd & 3); }
    if (slice == SL_BU) return 4 * 512 + (ch >> 2) * 8 + (ch & 3);
    if (slice == SL_BG) return 4 * 512 + (ch >> 2) * 8 + 4 + (ch & 3);
    if (slice == SL_BV) return 6 * 512 + ch;
    if (slice == SL_DB) return 11 * 512 + (ch >> 2) * 8 + (ch & 3);
    if (slice == SL_DG) return 11 * 512 + (ch >> 2) * 8 + 4 + (ch & 3);
    if (slice == SL_DC) return 13 * 512 + (ch >> 2) * 8 + (ch & 3);
    if (slice == SL_DH) return 13 * 512 + (ch >> 2) * 8 + 4 + (ch & 3);
    return n;
}
__device__ __forceinline__ void tr_item(const float* W, int K, int N, hf* WT, LAS float* scr, int item, int lane, bool perm, const float* kscale = nullptr) {
    const int nblk = N / 32, kb = item / nblk, nb = item % nblk, k0 = 64 * kb, n0 = 32 * nb;
#pragma unroll 8
    for (int i = 0; i < 32; ++i) { const int kk = 2 * i + (lane >> 5); scr[kk * 33 + (lane & 31)] = W[(size_t)(k0 + kk) * N + n0 + (lane & 31)]; }
    asm volatile("s_waitcnt lgkmcnt(0)" ::: "memory");
    const int c = lane & 7;
    f32x4 ga = (f32x4){1.f, 1.f, 1.f, 1.f}, gb = ga;
    if (kscale) { ga = *(const f32x4*)(kscale + k0 + 8 * c); gb = *(const f32x4*)(kscale + k0 + 8 * c + 4); }
#pragma unroll
    for (int j = 0; j < 4; ++j) { const int n = (lane >> 3) + 8 * j; const LAS float* s = scr + (8 * c) * 33 + n;
        const f32x4 a = (f32x4){s[0], s[33], s[66], s[99]} * ga, b = (f32x4){s[132], s[165], s[198], s[231]} * gb;
        const int nr = perm ? win_phys_row(n0 + n) : (n0 + n);
        *(h8*)(WT + (size_t)nr * K + k0 + 8 * c) = pack8(a, b); }
    asm volatile("s_waitcnt lgkmcnt(0)" ::: "memory");
}
__device__ __forceinline__ void rms_row(const float* xrow, const float* g, hf* oh, float* of, int lane) {
    f32x4 v[8]; float ss = 0.f;
#pragma unroll
    for (int j = 0; j < 8; ++j) { v[j] = *(const f32x4*)(xrow + 4 * (lane + 64 * j)); ss += v[j][0] * v[j][0] + v[j][1] * v[j][1] + v[j][2] * v[j][2] + v[j][3] * v[j][3]; }
    const float r = __builtin_amdgcn_rsqf(wave_sum(ss, lane) * (1.0f / DM) + NORM_EPS);
#pragma unroll
    for (int j = 0; j < 8; ++j) { const f32x4 gg = *(const f32x4*)(g + 4 * (lane + 64 * j)); const f32x4 o = v[j] * r * gg;
        if (oh) *(h4*)(oh + 4 * (lane + 64 * j)) = __builtin_convertvector(o, h4); else *(f32x4*)(of + 4 * (lane + 64 * j)) = o; }
}

#define CAS __attribute__((address_space(4)))
#define KA_BEGIN() const CAS Args* ka = (const CAS Args*)__builtin_amdgcn_kernarg_segment_ptr(); asm volatile("" : "+s"(ka)); \
    int tid_ = threadIdx.x; asm volatile("" : "+v"(tid_)); const int lane = tid_ & 63; \
    const int wave = __builtin_amdgcn_readfirstlane(tid_ >> 6), fr = lane & 15, quad = lane >> 4; \
    const int G = gridDim.x, gw = blockIdx.x * NWAVES + wave, NGW = G * NWAVES; unsigned char* ws = ka->ws; \
    (void)fr; (void)quad; (void)gw; (void)NGW; (void)ws

struct ConvDesc { const float* W; hf* WT; const float* kscale; int K, N, k0, n0; bool perm; };
__device__ __forceinline__ ConvDesc conv_decode(int it, const float* w_in, const float* w_out, const float* w_mem_kv, hf* winT, hf* woutT, hf* wmemT, const float* norm_g) {
    constexpr int I_IN = (DM / 64) * (NCOL / 32), I_OUT = (MIXW / 64) * (DM / 32), I_MEM = (DM / 64) * (1024 / 32), I_ALL = I_IN + I_OUT + I_MEM;
    const int l = it >= I_ALL ? 1 : 0; int r = it - l * I_ALL; ConvDesc d;
    if (r < I_IN) { d.W = w_in + (size_t)l * DM * NCOL; d.WT = winT + (size_t)l * NCOL * DM; d.K = DM; d.N = NCOL; d.perm = true; d.kscale = norm_g + l * DM; }
    else if (r < I_IN + I_OUT) { r -= I_IN; d.W = w_out + (size_t)l * MIXW * DM; d.WT = woutT + (size_t)l * DM * MIXW; d.K = MIXW; d.N = DM; d.perm = false; d.kscale = nullptr; }
    else { r -= I_IN + I_OUT; d.W = w_mem_kv + (size_t)l * DM * 1024; d.WT = wmemT + (size_t)l * 1024 * DM; d.K = DM; d.N = 1024; d.perm = false; d.kscale = nullptr; }
    const int nblk = d.N / 32; d.k0 = 64 * (r / nblk); d.n0 = 32 * (r % nblk);
    return d;
}
__device__ __forceinline__ void conv_load(f32x4 (&v)[8], const ConvDesc& d, int lane) {
    const float* p = d.W + (size_t)(d.k0 + (lane >> 3)) * d.N + d.n0 + 4 * (lane & 7);
#pragma unroll
    for (int i = 0; i < 8; ++i) v[i] = *(const f32x4*)(p + (size_t)(8 * i) * d.N);
}
__device__ __forceinline__ int win_phys_row(int n);
__device__ __forceinline__ void conv_store(const f32x4 (&v)[8], const ConvDesc& d, LAS float* scr, int lane) {
    { LAS float* s = scr + (lane >> 3) * 33 + 4 * (lane & 7);
#pragma unroll
      for (int i = 0; i < 8; ++i) { s[(8 * i) * 33 + 0] = v[i][0]; s[(8 * i) * 33 + 1] = v[i][1]; s[(8 * i) * 33 + 2] = v[i][2]; s[(8 * i) * 33 + 3] = v[i][3]; } }
    asm volatile("s_waitcnt lgkmcnt(0)" ::: "memory");
    const int c = lane & 7;
    f32x4 ga = (f32x4){1.f, 1.f, 1.f, 1.f}, gb = ga;
    if (d.kscale) { ga = *(const f32x4*)(d.kscale + d.k0 + 8 * c); gb = *(const f32x4*)(d.kscale + d.k0 + 8 * c + 4); }
#pragma unroll
    for (int j = 0; j < 4; ++j) { const int n = (lane >> 3) + 8 * j; const LAS float* s = scr + (8 * c) * 33 + n;
        const f32x4 a = (f32x4){s[0], s[33], s[66], s[99]} * ga, b = (f32x4){s[132], s[165], s[198], s[231]} * gb;
        const int nr = d.perm ? win_phys_row(d.n0 + n) : (d.n0 + n);
        *(h8*)(d.WT + (size_t)nr * d.K + d.k0 + 8 * c) = pack8(a, b); }
    asm volatile("s_waitcnt lgkmcnt(0)" ::: "memory");
}
constexpr int CT_IN = (DM / 128) * (NCOL / 128), CT_OUT = (MIXW / 128) * (DM / 128), CT_MEM = (DM / 128) * (1024 / 128), CT_ALL = CT_IN + CT_OUT + CT_MEM;
__device__ __forceinline__ ConvDesc ctile_decode(int it, const float* w_in, const float* w_out, const float* w_mem_kv, hf* winT, hf* woutT, hf* wmemT, const float* norm_g) {
    const int l = it >= CT_ALL ? 1 : 0; int r = it - l * CT_ALL; ConvDesc d;
    if (r < CT_IN) { d.W = w_in + (size_t)l * DM * NCOL; d.WT = winT + (size_t)l * NCOL * DM; d.K = DM; d.N = NCOL; d.perm = true; d.kscale = norm_g + l * DM; }
    else if (r < CT_IN + CT_OUT) { r -= CT_IN; d.W = w_out + (size_t)l * MIXW * DM; d.WT = woutT + (size_t)l * DM * MIXW; d.K = MIXW; d.N = DM; d.perm = false; d.kscale = nullptr; }
    else { r -= CT_IN + CT_OUT; d.W = w_mem_kv + (size_t)l * DM * 1024; d.WT = wmemT + (size_t)l * 1024 * DM; d.K = DM; d.N = 1024; d.perm = false; d.kscale = nullptr; }
    const int nblk = d.N / 128; d.k0 = 128 * (r / nblk); d.n0 = 128 * (r % nblk);
    return d;
}
__device__ __forceinline__ void ctile_load(f32x4 (&v)[8], const ConvDesc& d, int tid) {
    const float* p = d.W + (size_t)(d.k0 + (tid >> 5)) * d.N + d.n0 + 4 * (tid & 31);
#pragma unroll
    for (int i = 0; i < 8; ++i) v[i] = __builtin_nontemporal_load((const f32x4*)(p + (size_t)(16 * i) * d.N));
}
__device__ __forceinline__ void ctile_store(const f32x4 (&v)[8], const ConvDesc& d, LAS float* t129, int tid) {
    { LAS float* s = t129 + (tid >> 5) * 129 + 4 * (tid & 31);
#pragma unroll
      for (int i = 0; i < 8; ++i) { s[(16 * i) * 129 + 0] = v[i][0]; s[(16 * i) * 129 + 1] = v[i][1]; s[(16 * i) * 129 + 2] = v[i][2]; s[(16 * i) * 129 + 3] = v[i][3]; } }
    __syncthreads();
    const int c = tid & 15;
    f32x4 ga = (f32x4){1.f, 1.f, 1.f, 1.f}, gb = ga;
    if (d.kscale) { ga = *(const f32x4*)(d.kscale + d.k0 + 8 * c); gb = *(const f32x4*)(d.kscale + d.k0 + 8 * c + 4); }
#pragma unroll
    for (int j = 0; j < 4; ++j) { const int n = (tid >> 4) + 32 * j; const LAS float* s = t129 + (8 * c) * 129 + n;
        const f32x4 a = (f32x4){s[0], s[129], s[258], s[387]} * ga, b = (f32x4){s[516], s[645], s[774], s[903]} * gb;
        const int nr = d.perm ? win_phys_row(d.n0 + n) : (d.n0 + n);
        *(h8*)(d.WT + (size_t)nr * d.K + d.k0 + 8 * c) = pack8(a, b); }
    __syncthreads();
}
constexpr int CONV_I_IN = (DM / 64) * (NCOL / 32), CONV_I_OUT = (MIXW / 64) * (DM / 32), CONV_I_MEM = (DM / 64) * (1024 / 32);
constexpr int CONV_ITEMS = CONV_I_IN + CONV_I_OUT + CONV_I_MEM;
__device__ __forceinline__ void conv_item(const float* w_in, const float* w_out, const float* w_mem_kv, hf* winT, hf* woutT, hf* wmemT, int l, int it, LAS float* scr, int lane, const float* norm_g) {
    int r = it;
    if (r < CONV_I_IN) { tr_item(w_in + (size_t)l * DM * NCOL, DM, NCOL, winT + (size_t)l * NCOL * DM, scr, r, lane, true, norm_g + l * DM); return; } r -= CONV_I_IN;
    if (r < CONV_I_OUT) { tr_item(w_out + (size_t)l * MIXW * DM, MIXW, DM, woutT + (size_t)l * DM * MIXW, scr, r, lane, false); return; } r -= CONV_I_OUT;
    tr_item(w_mem_kv + (size_t)l * DM * 1024, DM, 1024, wmemT + (size_t)l * 1024 * DM, scr, r, lane, false);
}
__device__ __forceinline__ void xg_row(const float* xrow, const float* g, hf* oh, float* ssp, int lane) {
    f32x4 v[8]; float ss = 0.f;
#pragma unroll
    for (int j = 0; j < 8; ++j) { v[j] = __builtin_nontemporal_load((const f32x4*)(xrow + 4 * (lane + 64 * j))); ss += v[j][0] * v[j][0] + v[j][1] * v[j][1] + v[j][2] * v[j][2] + v[j][3] * v[j][3]; }
    ss = wave_sum(ss, lane);
#pragma unroll
    for (int j = 0; j < 8; ++j) { (void)g; *(h4*)(oh + 4 * (lane + 64 * j)) = __builtin_convertvector(v[j], h4); }
    if (lane < 8) ssp[lane] = lane == 0 ? ss : 0.f;
}
__device__ const double ROPE_REV[64] = {0.15915494309189535,0.13782250260398285,0.11934937021124886,0.10335229661843406,0.08949940160889101,0.07750328875537406,0.06711508300522726,0.058119267441876246,0.050329212104487035,0.04358330210530733,0.03774158471741977,0.032682865872357,0.0283021958306234,0.024508691862069852,0.02122365276477766,0.018378926105679667,0.015915494309189534,0.013782250260398284,0.011934937021124886,0.010335229661843406,0.008949940160889102,0.0077503288755374055,0.006711508300522725,0.005811926744187624,0.005032921210448704,0.004358330210530733,0.003774158471741977,0.0032682865872356993,0.00283021958306234,0.002450869186206985,0.0021223652764777662,0.0018378926105679667,0.0015915494309189536,0.0013782250260398288,0.0011934937021124885,0.0010335229661843405,0.0008949940160889102,0.0007750328875537405,0.0006711508300522726,0.0005811926744187624,0.0005032921210448703,0.0004358330210530733,0.00037741584717419774,0.0003268286587235699,0.00028302195830623395,0.00024508691862069854,0.0002122365276477766,0.00018378926105679666,0.00015915494309189535,0.00013782250260398286,0.00011934937021124886,0.00010335229661843406,8.949940160889102e-05,7.750328875537406e-05,6.711508300522725e-05,5.811926744187624e-05,5.0329212104487035e-05,4.358330210530732e-05,3.774158471741978e-05,3.2682865872357e-05,2.8302195830623396e-05,2.4508691862069852e-05,2.122365276477766e-05,1.8378926105679668e-05};
__device__ __forceinline__ void phase_prologue(LAS unsigned char* lds) {
    KA_BEGIN();
    const float* x = ka->in[0]; const float* mem = ka->in[1]; const float* norm_g = ka->in[2]; const float* w_in = ka->in[3];
    const float* sgu_w = ka->in[4]; const float* mem_norm_g = ka->in[9]; const float* w_mem_kv = ka->in[10]; const float* w_out = ka->in[12];
    float* cosT = (float*)(ws + WS_ROPE); float* sinT = cosT + SEQ * 64;
    hf* sguw = (hf*)(ws + WS_SGUW); float* sgurs = (float*)(ws + WS_SGUW + 512 * 1024);
    hf* memn = (hf*)(ws + WS_MEMN); hf* wmemT = (hf*)(ws + WS_WMEMT); hf* woutT = (hf*)(ws + WS_WOUTT); hf* winT = (hf*)(ws + WS_WINT); hf* xn = (hf*)(ws + WS_XN);
    LAS float* scr = (LAS float*)(lds + wave * 16384);
    {
        int tid_c = wave * 64 + lane;
        LAS float* t129 = (LAS float*)lds;
        f32x4 va[8], vb[8];
        int it = blockIdx.x;
        ConvDesc da = ctile_decode(it < 2 * CT_ALL ? it : 0, w_in, w_out, w_mem_kv, winT, woutT, wmemT, norm_g), db = da;
        if (it < 2 * CT_ALL) ctile_load(va, da, tid_c);
        while (it < 2 * CT_ALL) {
            const int it1 = it + G;
            if (it1 < 2 * CT_ALL) { db = ctile_decode(it1, w_in, w_out, w_mem_kv, winT, woutT, wmemT, norm_g); ctile_load(vb, db, tid_c); }
            ctile_store(va, da, t129, tid_c);
            const int it2 = it1 + G;
            if (it2 < 2 * CT_ALL) { da = ctile_decode(it2, w_in, w_out, w_mem_kv, winT, woutT, wmemT, norm_g); ctile_load(va, da, tid_c); }
            if (it1 < 2 * CT_ALL) ctile_store(vb, db, t129, tid_c);
            it = it2;
        }
    }
    for (int e = blockIdx.x * 512 + wave * 64 + lane; e < SEQ * 64; e += G * 512) {
        const int t = e >> 6, i = e & 63;
        const double rev = (double)t * ROPE_REV[i];
        const float f = (float)(rev - floor(rev));
        cosT[e] = __builtin_amdgcn_cosf(f); sinT[e] = __builtin_amdgcn_sinf(f);
    }
    for (int rw = gw; rw < 2 * 4 * 128; rw += NGW) {
        const int i = rw & 127; const float* wr_ = sgu_w + (size_t)rw * 128; float s = 0.f;
#pragma unroll
        for (int k = 0; k < 2; ++k) { const int j = lane + 64 * k; const float w = (j <= i) ? wr_[j] : 0.f; s += w; sguw[(size_t)rw * 128 + j] = (hf)w; }
        s = wave_sum(s, lane); if (lane == 0) sgurs[rw] = s;
    }
    for (int m = gw; m < NTOK; m += NGW) xg_row(x + (size_t)m * DM, norm_g, xn + (size_t)m * DM, (float*)(ws + WS_ROWSS) + (size_t)m * 8, lane);
    for (int m = gw; m < 2 * 512; m += NGW) { const int l = m >> 9, r = m & 511; rms_row(mem + (size_t)r * DM, mem_norm_g + l * DM, memn + (size_t)m * DM, nullptr, lane); }
}

__device__ __forceinline__ void phase_proj(LAS unsigned char* lds, int L) {
    {
        KA_BEGIN();
        pg8::Gemm g{(const hf*)(ws + WS_XN), (const hf*)(ws + WS_WINT) + (size_t)L * NCOL * DM, NTOK, PROJ_N1, DM}; pg8::StaticOrder S; S.init(NTOK, PROJ_N1, G, (int)blockIdx.x);
        float* cosT = (float*)(ws + WS_ROPE);
        pg8::EpiProj E{(hf*)(ws + WS_PROJ), cosT, cosT + SEQ * 64, (float*)(ws + WS_KPART), (f32x2*)(ws + WS_VSTAT), (const float*)(ws + WS_ROWSS), (hf*)(ws + WS_HM)};
        pg8::gemm_phase<pg8::EpiProj, pg8::StaticOrder, true, true>(lds, g, S, E);
    }
}

__device__ __forceinline__ void memkv_tile(int tl, LAS unsigned char* lds) {
    KA_BEGIN();
    const hf* memn = (const hf*)(ws + WS_MEMN); const hf* wmemT = (const hf*)(ws + WS_WMEMT); hf* kvmem = (hf*)(ws + WS_KVMEM);
    const int l = tl >> 7, r = tl & 127, mt = r >> 4, nt = r & 15, m0 = mt * 64, n0 = nt * 64;
    const hf* ap = memn + ((size_t)l * 512 + m0 + fr) * DM + wave * 256 + 8 * quad;
    const hf* bp = wmemT + ((size_t)l * 1024 + n0 + fr) * DM + wave * 256 + 8 * quad;
    f32x4 c[4][4];
#pragma unroll
    for (int ni = 0; ni < 4; ++ni)
#pragma unroll
        for (int mi = 0; mi < 4; ++mi) c[ni][mi] = (f32x4){0.f, 0.f, 0.f, 0.f};
#pragma unroll 2
    for (int kk = 0; kk < 8; ++kk) {
        h8 av[4], bv[4];
#pragma unroll
        for (int i = 0; i < 4; ++i) { av[i] = *(const h8*)(ap + (size_t)(16 * i) * DM + 32 * kk); bv[i] = *(const h8*)(bp + (size_t)(16 * i) * DM + 32 * kk); }
#pragma unroll
        for (int ni = 0; ni < 4; ++ni)
#pragma unroll
            for (int mi = 0; mi < 4; ++mi) c[ni][mi] = __builtin_amdgcn_mfma_f32_16x16x32_f16(bv[ni], av[mi], c[ni][mi], 0, 0, 0);
    }
    LAS float* red = (LAS float*)lds + wave * 4096;
#pragma unroll
    for (int ni = 0; ni < 4; ++ni)
#pragma unroll
        for (int mi = 0; mi < 4; ++mi) *(LAS f32x4*)(red + (16 * mi + fr) * 64 + 16 * ni + 4 * quad) = c[ni][mi];
    __syncthreads();
    { const int t = wave * 64 + lane, m = t >> 3, n8 = (t & 7) * 8;
      f32x4 s0 = (f32x4){0.f, 0.f, 0.f, 0.f}, s1 = s0;
#pragma unroll
      for (int w = 0; w < 8; ++w) { const LAS float* p = (const LAS float*)lds + w * 4096 + m * 64 + n8; s0 += *(const LAS f32x4*)p; s1 += *(const LAS f32x4*)(p + 4); }
      const h8 hv = pack8(s0, s1); const unsigned long long* q2 = (const unsigned long long*)&hv; unsigned long long* dst = (unsigned long long*)(kvmem + ((size_t)l * 512 + m0 + m) * 1024 + n0 + n8);
      __hip_atomic_store(dst, q2[0], __ATOMIC_RELAXED, __HIP_MEMORY_SCOPE_AGENT); __hip_atomic_store(dst + 1, q2[1], __ATOMIC_RELAXED, __HIP_MEMORY_SCOPE_AGENT); }
    asm volatile("s_waitcnt vmcnt(0)" ::: "memory");
    __syncthreads();
    if (threadIdx.x == 0) __hip_atomic_fetch_add((unsigned*)(ws + WS_CTL) + CW_BAR + 48, 1u, __ATOMIC_RELAXED, __HIP_MEMORY_SCOPE_AGENT);
}

__device__ __forceinline__ void moba_gate_item(int g, unsigned char* ws, int L, LAS unsigned char* lds) {
    int tid = threadIdx.x; asm volatile("" : "+v"(tid));
    const int wid = __builtin_amdgcn_readfirstlane(tid >> 6), lane = tid & 63, r32 = lane & 31, hi = lane >> 5;
    const int bh = g & 7, qblk = g >> 3, b = bh >> 2, h = bh & 3;
    const int pos = qblk * 256 + wid * 32 + r32;
    float* lsec = (float*)(ws + WS_LSE + MiB) + ((size_t)b * SEQ) * 4 + h;
    {
        if (tid < 256) for (int s = (qblk < 3 ? qblk : 3); s < 3; ++s) __hip_atomic_store(&lsec[((size_t)s * NTOK + qblk * 256 + tid) * 4], -1e30f, __ATOMIC_RELAXED, __HIP_MEMORY_SCOPE_AGENT);
    }
    if (qblk > 0) {
        const hf* Q = (const hf*)(ws + WS_HM) + 3 * (size_t)NTOK * GW + ((size_t)(b * 4 + h) * SEQ + pos) * 128;
        h8 qr[8];
#pragma unroll
        for (int d0 = 0; d0 < 8; ++d0) qr[d0] = *(const h8*)(Q + d0 * 16 + hi * 8);
        const float* ksum = (const float*)(ws + WS_KPART) + (size_t)(b * 16 * 2) * GW + h * 128;
        LAS float* ksl = (LAS float*)(lds + att::LDS_KSUM);
        { const int n = tid >> 5, d4 = (tid & 31) * 4;
          if (n < qblk) { const float* kp = ksum + (size_t)(n * 2) * GW + d4; *(LAS f32x4*)(ksl + n * 128 + d4) = *(const f32x4*)kp + *(const f32x4*)(kp + GW); } }
        __syncthreads();
        float v1 = -3e38f, v2 = -3e38f, v3 = -3e38f; int i1 = -1, i2 = -1, i3 = -1;
        for (int n = 0; n < qblk; ++n) {
            const LAS float* kr = ksl + n * 128 + hi * 8; float dv = 0.f;
#pragma unroll
            for (int d0 = 0; d0 < 8; ++d0) { const f32x4 ka = *(const LAS f32x4*)(kr + d0 * 16), kb = *(const LAS f32x4*)(kr + d0 * 16 + 4);
#pragma unroll
                for (int i = 0; i < 4; ++i) dv += (float)qr[d0][i] * ka[i] + (float)qr[d0][4 + i] * kb[i]; }
            dv += shx_l(dv, lane, 32);
            if (dv > v1) { v3 = v2; i3 = i2; v2 = v1; i2 = i1; v1 = dv; i1 = n; }
            else if (dv > v2) { v3 = v2; i3 = i2; v2 = dv; i2 = n; }
            else if (dv > v3) { v3 = dv; i3 = n; }
        }
        const unsigned sel = (i1 >= 0 ? 1u << i1 : 0u) | (i2 >= 0 ? 1u << i2 : 0u) | (i3 >= 0 ? 1u << i3 : 0u);
        unsigned* cnt = (unsigned*)(ws + WS_CTL) + CW_CNT + L * 128 + bh * 16;
        unsigned* list = (unsigned*)(ws + WS_LIST) + (size_t)bh * 16 * SEQ;
        for (int n = 0; n < qblk; ++n) {
            const bool pred = (hi == 0) && (((sel >> n) & 1u) != 0u);
            const unsigned long long m = __ballot(pred);
            if (m != 0ull) {
                const int leader = __ffsll((unsigned long long)m) - 1;
                unsigned base = 0u;
                if (lane == leader) base = __hip_atomic_fetch_add(cnt + n, (unsigned)__popcll(m), __ATOMIC_RELAXED, __HIP_MEMORY_SCOPE_AGENT);
                base = (unsigned)__builtin_amdgcn_readlane((int)base, leader);
                if (pred) { const unsigned off = (unsigned)__popcll(m & ((1ull << lane) - 1ull)); const unsigned slot = (unsigned)__popc(sel & ((1u << n) - 1u));
                    __hip_atomic_store(&list[(size_t)n * SEQ + base + off], (unsigned)pos | (slot << 16), __ATOMIC_RELAXED, __HIP_MEMORY_SCOPE_AGENT); }
            }
        }
    }
    asm volatile("s_waitcnt vmcnt(0)" ::: "memory");
    __syncthreads();
    if (tid == 0) __hip_atomic_fetch_add((unsigned*)(ws + WS_CTL) + CW_BAR + 32 + 64 * L, 1u, __ATOMIC_RELAXED, __HIP_MEMORY_SCOPE_AGENT);
}

constexpr int NI_G = 64, NI_K = 256, NI_M = 128, NI_C = 128, NI_A = 3 * 8 * 16, NI_X = 8 * 16, NI_B = N_B / 8;
constexpr int LDS_Q_OFF = 131072 + 64;
constexpr int LDS_GTAB = att::LDS_KSUM;
__device__ __forceinline__ att::BlkRef mix_decode(int Li, unsigned char* ws, int L) {
    const hf* hm = (const hf*)(ws + WS_HM); constexpr long HMS = (long)NTOK * GW;
    att::BlkRef r;
    r.list = nullptr; r.cnt = 0;
    if (Li < NI_C) {
        const int bh = Li & 7, qblk = 15 - (Li >> 3), b = bh >> 2, h = bh & 3;
        const long row0 = (long)b * SEQ + qblk * 256, hrow = (long)(b * 4 + h) * SEQ;
        r.Q = hm + 3 * HMS + (hrow + qblk * 256) * 128; r.qs = 128;
        r.K = hm + 4 * HMS + hrow * 128; r.V = hm + 5 * HMS + hrow * 128; r.ks = 128;
        r.O = (hf*)(ws + WS_OCP) + ((long)3 * NTOK + row0) * GW + h * 128; r.os = GW;
        r.LSE = (float*)(ws + WS_LSE + MiB) + ((long)3 * NTOK + row0) * 4 + h; r.ls = 4;
        r.P0 = qblk * 256; r.W = 1 << 30; r.j_lo = qblk * 4; r.j_hi = qblk * 4 + 4;
    } else if (Li < NI_C + NI_A) {
        const int i = Li - NI_C, p = i >> 7, rr = i & 127, b = rr >> 6, h = (rr >> 4) & 3, slot = rr & 15;
        const int dsh = 2 * p, d = 1 << dsh, bpr = 16 >> dsh, res = slot / bpr, blk = slot % bpr, l0 = 256 * blk, Lsub = SEQ >> dsh;
        const long rowb = (long)b * SEQ + res, q0 = rowb + (long)l0 * d, hrow = (long)(b * 4 + h) * SEQ + res;
        r.Q = hm + 0 * HMS + (hrow + (long)l0 * d) * 128; r.qs = d * 128;
        r.K = hm + 1 * HMS + hrow * 128; r.V = hm + 2 * HMS + hrow * 128; r.ks = d * 128;
        r.O = (hf*)(ws + WS_OA) + ((long)p * NTOK + q0) * GW + h * 128; r.os = d * GW;
        r.LSE = (float*)(ws + WS_LSE) + ((long)p * NTOK + q0) * 4 + h; r.ls = d * 4;
        r.P0 = l0; r.W = 129; r.j_lo = (l0 >= 128) ? (l0 - 128) / 64 : 0; r.j_hi = (l0 + 255) / 64 + 1; if (r.j_hi > Lsub / 64) r.j_hi = Lsub / 64;
    } else {
        const int i = Li - NI_C - NI_A, b = i >> 6, h = (i >> 4) & 3, blk = i & 15;
        const long row0 = (long)b * SEQ + 256 * blk;
        const hf* kv = (const hf*)(ws + WS_KVMEM) + (size_t)L * 512 * 1024 + (long)b * NMEM * 1024 + h * 128;
        r.Q = hm + 6 * HMS + ((long)(b * 4 + h) * SEQ + 256 * blk) * 128; r.qs = 128;
        r.K = kv; r.V = kv + GW; r.ks = 1024;
        r.O = (hf*)(ws + WS_OX) + row0 * GW + h * 128; r.os = GW; r.LSE = nullptr; r.ls = 0;
        r.P0 = 1 << 20; r.W = 1 << 30; r.j_lo = 0; r.j_hi = 4;
    }
    return r;
}
__device__ __forceinline__ att::BlkRef gather_decode(int gi, unsigned char* ws, int L, const LAS int* tab) {
    int k = 0;
#pragma unroll 1
    for (int s = 64; s > 0; s >>= 1) if (tab[k + s] <= gi) k += s;
    const int chunk = gi - tab[k], bh = k >> 4, n = k & 15, b = bh >> 2, h = bh & 3;
    const hf* hm = (const hf*)(ws + WS_HM); constexpr long HMS = (long)NTOK * GW;
    const long hrow = (long)(b * 4 + h) * SEQ;
    const unsigned total = __hip_atomic_load((unsigned*)(ws + WS_CTL) + CW_CNT + L * 128 + k, __ATOMIC_RELAXED, __HIP_MEMORY_SCOPE_AGENT);
    att::BlkRef r;
    r.list = (const unsigned*)(ws + WS_LIST) + (size_t)k * SEQ + chunk * 256; r.cnt = (int)total - chunk * 256; if (r.cnt > 256) r.cnt = 256;
    r.Q = hm + 3 * HMS + hrow * 128; r.qs = 128;
    r.K = hm + 4 * HMS + hrow * 128; r.V = hm + 5 * HMS + hrow * 128; r.ks = 128;
    r.O = (hf*)(ws + WS_OCP) + ((long)b * SEQ) * GW + h * 128; r.os = GW;
    r.LSE = (float*)(ws + WS_LSE + MiB) + ((long)b * SEQ) * 4 + h; r.ls = 4;
    r.P0 = 1 << 20; r.W = 1 << 30; r.j_lo = n * 4; r.j_hi = n * 4 + 4;
    return r;
}
__device__ __forceinline__ att::NxtRef nxt_of(const att::BlkRef& n2) { att::NxtRef nx; nx.Q = n2.Q; nx.K = n2.K; nx.V = n2.V; nx.list = n2.list; nx.qs = n2.qs; nx.ks = n2.ks; nx.j_lo = n2.j_lo; nx.cnt = n2.cnt; return nx; }
__device__ __forceinline__ int wg_dequeue(unsigned* ctr, LAS unsigned char* lds, int base) {
    volatile LAS int* qw = (volatile LAS int*)(lds + LDS_Q_OFF);
    if (threadIdx.x == 0) qw[0] = base + (int)__hip_atomic_fetch_add(ctr, 1u, __ATOMIC_RELAXED, __HIP_MEMORY_SCOPE_AGENT);
    __syncthreads();
    const int v = qw[0];
    __syncthreads();
    return __builtin_amdgcn_readfirstlane(v);
}
__device__ __forceinline__ void phase_mix(LAS unsigned char* lds, int L) {
    const CAS Args* ka0 = (const CAS Args*)__builtin_amdgcn_kernarg_segment_ptr(); asm volatile("" : "+s"(ka0));
    const int Gq = gridDim.x;
    unsigned* qctr = (unsigned*)(ka0->ws + WS_CTL) + CW_BAR + 64 * L;
    unsigned* gdone = (unsigned*)(ka0->ws + WS_CTL) + CW_BAR + 32 + 64 * L;
    unsigned* kdone = (unsigned*)(ka0->ws + WS_CTL) + CW_BAR + 48;
    const int Q_M0 = NI_G, Q_C0 = Q_M0 + NI_M, Q_K0 = Q_C0 + NI_C, Q_A0 = Q_K0 + (L == 0 ? NI_K : 0), Q_DYN = Q_A0 + NI_A;
    const int QBASE = 2 * Gq - NI_G;
    LAS int* tab = (LAS int*)(lds + LDS_GTAB);
    bool tabok = false; int GT = 0;
    int L0 = blockIdx.x, L1 = ((int)blockIdx.x >= NI_G) ? (int)blockIdx.x + Gq - NI_G : -1;
    unsigned char* ws = ka0->ws;
#define IS_ATT(i) (((i) >= Q_C0 && (i) < Q_K0) || ((i) >= Q_A0 && (i) < Q_DYN) || (tabok && (i) >= Q_DYN && (i) < Q_DYN + GT + NI_X))
#define ATT_DECODE(i) ((i) < Q_K0 ? mix_decode((i) - Q_C0, ws, L) : ((i) < Q_DYN ? mix_decode(NI_C + (i) - Q_A0, ws, L) : \
                       ((i) < Q_DYN + GT ? gather_decode((i) - Q_DYN, ws, L, tab) : mix_decode(NI_C + NI_A + (i) - Q_DYN - GT, ws, L))))
    for (;;) {
        if (L0 >= Q_DYN && !tabok) {
            __syncthreads();
            if (threadIdx.x == 0) { unsigned sp = 0u;
                while (__hip_atomic_load(gdone, __ATOMIC_RELAXED, __HIP_MEMORY_SCOPE_AGENT) < (unsigned)NI_M || __hip_atomic_load(kdone, __ATOMIC_RELAXED, __HIP_MEMORY_SCOPE_AGENT) < (unsigned)NI_K) { __builtin_amdgcn_s_sleep(2); if (++sp > (1u << 22)) break; }
                __builtin_amdgcn_fence(__ATOMIC_ACQUIRE, "agent"); asm volatile("s_waitcnt vmcnt(0)" ::: "memory"); }
            __syncthreads();
            {
                int tid_s = threadIdx.x; asm volatile("" : "+v"(tid_s));
                LAS int* cl = tab + 160;
                if (tid_s < 128) cl[tid_s] = ((int)__hip_atomic_load((unsigned*)(ws + WS_CTL) + CW_CNT + L * 128 + tid_s, __ATOMIC_RELAXED, __HIP_MEMORY_SCOPE_AGENT) + 255) >> 8;
                __syncthreads();
                if (tid_s <= 128) { int s = 0; for (int k = 0; k < tid_s; ++k) s += cl[k]; tab[tid_s] = s; }
            }
            __syncthreads();
            GT = tab[128]; tabok = true;
        }
        if (tabok && L0 >= Q_DYN + GT + NI_X + NI_B) break;
        if (L0 < Q_M0) {
            {
                KA_BEGIN();
                pg8::Gemm g{(const hf*)(ws + WS_XN), (const hf*)(ws + WS_WINT) + (size_t)L * NCOL * DM, NTOK, NCOL, DM};
                pg8::OneUnit S{L0 & 31, (PROJ_N1 / 256) + (L0 >> 5)};
                float* cosT = (float*)(ws + WS_ROPE);
                pg8::EpiProj E{(hf*)(ws + WS_PROJ), cosT, cosT + SEQ * 64, (float*)(ws + WS_KPART), (f32x2*)(ws + WS_VSTAT), (const float*)(ws + WS_ROWSS), (hf*)(ws + WS_HM)};
                pg8::gemm_phase<pg8::EpiProj, pg8::OneUnit, true, true>(lds, g, S, E);
            }
            L0 = wg_dequeue(qctr, lds, QBASE); L1 = wg_dequeue(qctr, lds, QBASE);
        } else if (L0 < Q_C0) {
            moba_gate_item(L0 - Q_M0, ws, L, lds);
            L0 = L1; L1 = wg_dequeue(qctr, lds, QBASE);
        } else if (L0 >= Q_K0 && L0 < Q_A0) {
            memkv_tile(L0 - Q_K0, lds);
            L0 = L1; L1 = wg_dequeue(qctr, lds, QBASE);
        } else if (tabok && L0 >= Q_DYN + GT + NI_X) {
            KA_BEGIN();
            MixP P{(const hf*)(ws + WS_PROJ), (const hf*)(ws + WS_KVMEM) + (size_t)L * 512 * 1024, (hf*)(ws + WS_OA), (float*)(ws + WS_LSE), (hf*)(ws + WS_OB), (hf*)(ws + WS_OCP),
                   (float*)(ws + WS_LSE + MiB), (hf*)(ws + WS_OX), (const float*)(ws + WS_KPART), (const f32x2*)(ws + WS_VSTAT), (const hf*)(ws + WS_SGUW) + (size_t)L * 4 * 128 * 128,
                   (const float*)(ws + WS_SGUW + 512 * 1024) + L * 512, ka->in[5] + L * 512, ka->in[6] + L * GW, ka->in[7] + L * GW};
            const int it = (L0 - (Q_DYN + GT + NI_X)) * 8 + wave;
            const int itx = ((it & 7) << 8) | (it >> 3);
            item_B(P, itx, lds + wave * WAVE_LDS, lane, fr, quad);
            L0 = L1; L1 = wg_dequeue(qctr, lds, QBASE);
        } else {
            att::Seam S;
            { const att::BlkRef c0 = ATT_DECODE(L0); att::blk_prime(c0, (LAS char*)lds, S); }
            for (;;) {
                const bool more = IS_ATT(L1);
                unsigned tk = 0u;
                if (threadIdx.x == 0) tk = __hip_atomic_fetch_add(qctr, 1u, __ATOMIC_RELAXED, __HIP_MEMORY_SCOPE_AGENT);
                const att::BlkRef cur = ATT_DECODE(L0);
                const int Ln = more ? L1 : L0;
                const att::NxtRef nx = nxt_of(ATT_DECODE(Ln));
                volatile LAS int* qw = (volatile LAS int*)(lds + LDS_Q_OFF);
                att::blk_run(cur, nx, (LAS char*)lds, S, tk, qw, QBASE);
                const int L2 = __builtin_amdgcn_readfirstlane(qw[0]);
                L0 = L1; L1 = L2;
                if (!more) break;
            }
            asm volatile("s_waitcnt vmcnt(0)" ::: "memory");
            __syncthreads();
        }
    }
#undef IS_ATT
#undef ATT_DECODE
}

__device__ __forceinline__ void phase_finalize(int L) {
    KA_BEGIN();
    const hf* proj = (const hf*)(ws + WS_PROJ); const hf* oa = (const hf*)(ws + WS_OA); const hf* ob = (const hf*)(ws + WS_OB); const hf* ocp = (const hf*)(ws + WS_OCP); const hf* ox = (const hf*)(ws + WS_OX);
    const float* lsea = (const float*)(ws + WS_LSE); const float* lsec = (const float*)(ws + WS_LSE + MiB); hf* yb = (hf*)(ws + WS_Y);
    const float* cw = ka->in[8] + (size_t)L * 3 * GW; const float* ong = ka->in[11] + (size_t)L * MIXW;
    f32x4 ogv[5][2];
#pragma unroll
    for (int gq = 0; gq < 5; ++gq) { ogv[gq][0] = *(const f32x4*)(ong + gq * GW + 8 * lane); ogv[gq][1] = *(const f32x4*)(ong + gq * GW + 8 * lane + 4); }
    for (int t = gw; t < NTOK; t += NGW) {
        const int pos = t & (SEQ - 1), hd = lane >> 4, c8 = 8 * lane;
        const hf* prow = proj + (size_t)t * NCOL;
        float u[5][8];
        {
            float ls[3], mx = -3e38f;
#pragma unroll
            for (int p = 0; p < 3; ++p) { ls[p] = lsea[((size_t)p * NTOK + t) * 4 + hd]; mx = fmaxf(mx, ls[p]); }
            float wsum = 0.f, acc[8] = {0, 0, 0, 0, 0, 0, 0, 0};
#pragma unroll
            for (int p = 0; p < 3; ++p) { const float w = __builtin_amdgcn_exp2f(ls[p] - mx); wsum += w; const h8 o = __builtin_nontemporal_load((const h8*)(oa + ((size_t)p * NTOK + t) * GW + c8));
#pragma unroll
                for (int i = 0; i < 8; ++i) acc[i] += w * (float)o[i]; }
            const float inv = 1.0f / wsum; const h8 gt = __builtin_nontemporal_load((const h8*)(prow + SL_AG * GW + c8));
#pragma unroll
            for (int i = 0; i < 8; ++i) u[0][i] = acc[i] * inv * (float)gt[i];
        }
        {
            const h8 o = __builtin_nontemporal_load((const h8*)(ob + (size_t)t * GW + c8));
#pragma unroll
            for (int i = 0; i < 8; ++i) u[1][i] = (float)o[i];
        }
        {
            float ls[4], mx = -3e38f;
#pragma unroll
            for (int p = 0; p < 4; ++p) { ls[p] = lsec[((size_t)p * NTOK + t) * 4 + hd]; mx = fmaxf(mx, ls[p]); }
            float wsum = 0.f, acc[8] = {0, 0, 0, 0, 0, 0, 0, 0};
#pragma unroll
            for (int p = 0; p < 4; ++p) if (ls[p] > -1e29f) { const float w = __builtin_amdgcn_exp2f(ls[p] - mx); wsum += w; const h8 o = __builtin_nontemporal_load((const h8*)(ocp + ((size_t)p * NTOK + t) * GW + c8));
#pragma unroll
                for (int i = 0; i < 8; ++i) acc[i] += w * (float)o[i]; }
            const float inv = 1.0f / wsum; const h8 gt = __builtin_nontemporal_load((const h8*)(prow + SL_CG * GW + c8));
#pragma unroll
            for (int i = 0; i < 8; ++i) u[2][i] = acc[i] * inv * (float)gt[i];
        }
        {
            float y[8] = {0, 0, 0, 0, 0, 0, 0, 0};
#pragma unroll
            for (int k = 0; k < 3; ++k) { const int back = 2 - k;
                if (pos - back >= 0) { const hf* pr = prow - (size_t)back * NCOL; const h8 z = *(const h8*)(pr + SL_DC * GW + c8);
                    const f32x4 w0 = *(const f32x4*)(cw + k * GW + c8), w1 = *(const f32x4*)(cw + k * GW + c8 + 4);
#pragma unroll
                    for (int i = 0; i < 4; ++i) { y[i] += w0[i] * (float)z[i]; y[4 + i] += w1[i] * (float)z[4 + i]; } } }
            const h8 dbg = __builtin_nontemporal_load((const h8*)(prow + SL_DB * GW + c8));
#pragma unroll
            for (int i = 0; i < 8; ++i) u[3][i] = (float)dbg[i] * y[i];
        }
        {
            const h8 o = __builtin_nontemporal_load((const h8*)(ox + (size_t)t * GW + c8)), gt = __builtin_nontemporal_load((const h8*)(prow + SL_XG * GW + c8));
#pragma unroll
            for (int i = 0; i < 8; ++i) u[4][i] = (float)o[i] * (float)gt[i];
        }
        float ssv[5];
#pragma unroll
        for (int gq = 0; gq < 5; ++gq) { float ss = 0.f;
#pragma unroll
            for (int i = 0; i < 8; ++i) ss += u[gq][i] * u[gq][i];
            ssv[gq] = ss; }
#pragma unroll
        for (int o_ = 1; o_ < 64; o_ <<= 1) {
            float tv[5];
#pragma unroll
            for (int gq = 0; gq < 5; ++gq) tv[gq] = shx_l(ssv[gq], lane, o_);
#pragma unroll
            for (int gq = 0; gq < 5; ++gq) ssv[gq] += tv[gq];
        }
#pragma unroll
        for (int gq = 0; gq < 5; ++gq) {
            const float r = __builtin_amdgcn_rsqf(ssv[gq] * (1.0f / GW) + NORM_EPS);
            const f32x4 g0 = ogv[gq][0], g1 = ogv[gq][1];
            f32x4 o0, o1;
#pragma unroll
            for (int i = 0; i < 4; ++i) { o0[i] = u[gq][i] * r * g0[i]; o1[i] = u[gq][4 + i] * r * g1[i]; }
            *(h8*)(yb + (size_t)t * MIXW + gq * GW + c8) = pack8(o0, o1);
        }
    }
}

__device__ __forceinline__ void phase_out(LAS unsigned char* lds, int L) {
    KA_BEGIN();
    float* x1 = (float*)(ws + WS_X1);
    pg8::Gemm g{(const hf*)(ws + WS_Y), (const hf*)(ws + WS_WOUTT) + (size_t)L * DM * MIXW, NTOK, DM, MIXW}; pg8::StaticOrder S; S.init(NTOK, DM, G, (int)blockIdx.x);
    pg8::EpiRes E{L == 0 ? ka->in[0] : (const float*)nullptr, (const hf*)(ws + WS_XN), L == 0 ? (hf*)(ws + WS_XN) : (hf*)x1, (float*)(ws + WS_ROWSS),
                  L == 0 ? (float*)nullptr : ka->out, ka->in[13], (unsigned*)(ws + WS_CTL) + CW_CNT + 256};
    pg8::gemm_phase<pg8::EpiRes, pg8::StaticOrder, true, true>(lds, g, S, E);
}
__device__ __forceinline__ void phase_norm_mid() {
    KA_BEGIN();
    const float* x1 = (const float*)(ws + WS_X1); hf* xn = (hf*)(ws + WS_XN); const float* g1 = ka->in[2] + DM;
    for (int m = gw; m < NTOK; m += NGW) rms_row(x1 + (size_t)m * DM, g1, xn + (size_t)m * DM, nullptr, lane);
}
__device__ __forceinline__ void phase_norm_final() {
    KA_BEGIN();
    float* out = ka->out; const float* gf = ka->in[13]; const hf* x2 = (const hf*)(ws + WS_X1); const float* rowss = (const float*)(ws + WS_ROWSS);
    for (int m = gw; m < NTOK; m += NGW) {
        const f32x4 pa = *(const f32x4*)(rowss + (size_t)m * 8), pb = *(const f32x4*)(rowss + (size_t)m * 8 + 4);
        const float r = __builtin_amdgcn_rsqf(((pa[0] + pa[1]) + (pa[2] + pa[3]) + (pb[0] + pb[1]) + (pb[2] + pb[3])) * (1.0f / DM) + NORM_EPS);
#pragma unroll
        for (int j = 0; j < 4; ++j) { const int c = 8 * (lane + 64 * j); const h8 v = *(const h8*)(x2 + (size_t)m * DM + c);
            const f32x4 g0 = *(const f32x4*)(gf + c), g1 = *(const f32x4*)(gf + c + 4); f32x4 o0, o1;
#pragma unroll
            for (int i = 0; i < 4; ++i) { o0[i] = (float)v[i] * r * g0[i]; o1[i] = (float)v[4 + i] * r * g1[i]; }
            *(f32x4*)(out + (size_t)m * DM + c) = o0; *(f32x4*)(out + (size_t)m * DM + c + 4) = o1; }
    }
}


#define XB_TMO      128
#define XB_XCNT(j)  (256  + 64 * (j))
#define XB_XSUB(j)  (1280 + 64 * (j))
#define XB_XGEN(j)  (2304 + 64 * (j))
#define XB_TOP      3328
#define XB_TOPGEN   3392
#define XCD_BAR_WORDS 3456
#define XB_SPIN_CAP (1u << 18)
__device__ __forceinline__ unsigned xb_ld(unsigned* p)              { return __hip_atomic_load(p, __ATOMIC_RELAXED, __HIP_MEMORY_SCOPE_AGENT); }
__device__ __forceinline__ unsigned xb_add(unsigned* p, unsigned v) { return __hip_atomic_fetch_add(p, v, __ATOMIC_RELAXED, __HIP_MEMORY_SCOPE_AGENT); }
__device__ __forceinline__ unsigned xb_xcc_id() { return (unsigned)__builtin_amdgcn_s_getreg((3 << 11) | 20) & 0xFu; }
#define XB_SPIN(cond, bar) do { unsigned _sp = 0; while (cond) { __builtin_amdgcn_s_sleep(1); \
    if ((++_sp & 255u) == 0u) { if (xb_ld(&(bar)[XB_TMO])) break; if (_sp > XB_SPIN_CAP) { atomicAdd(&(bar)[XB_TMO], 1u); break; } } } } while (0)
struct XcdBarrier { unsigned* bar; unsigned x; volatile LAS unsigned* st; };
__device__ __forceinline__ XcdBarrier xcd_barrier_post(unsigned* bar, volatile LAS unsigned* st) {
    XcdBarrier b; b.bar = bar; b.x = xb_xcc_id(); b.st = st;
    if (threadIdx.x == 0) (void)xb_add(&bar[XB_XCNT(b.x)], 1u);
    return b;
}
__device__ __forceinline__ void xcd_barrier_complete(unsigned* bar, unsigned x, unsigned& nloc, unsigned& nx) {
    const unsigned G = gridDim.x * gridDim.y * gridDim.z;
    unsigned sum, cnt, mine, sp = 0u;
    for (;;) {
        sum = 0u; cnt = 0u; mine = 0u;
#pragma unroll
        for (unsigned j = 0; j < 16; ++j) { const unsigned c = xb_ld(&bar[XB_XCNT(j)]); sum += c; cnt += (c > 0u) ? 1u : 0u; mine = (j == x) ? c : mine; }
        if (sum == G) break;
        __builtin_amdgcn_s_sleep(1);
        if ((++sp & 255u) == 0u) { if (xb_ld(&bar[XB_TMO])) break; if (sp > XB_SPIN_CAP) { atomicAdd(&bar[XB_TMO], 1u); break; } }
    }
    nloc = mine > 0u ? mine : 1u; nx = cnt > 0u ? cnt : 1u;
}
__device__ __forceinline__ void xcd_barrier(const XcdBarrier& b) {
    asm volatile("s_waitcnt vmcnt(0)" ::: "memory");
    __syncthreads();
    if (threadIdx.x == 0) {
        unsigned* bar = b.bar;
        __builtin_amdgcn_s_waitcnt(0);
        unsigned nloc = b.st[0], nx = b.st[1];
        if (nloc == 0u) { xcd_barrier_complete(bar, b.x, nloc, nx); b.st[0] = nloc; b.st[1] = nx; }
        const unsigned old = xb_add(&bar[XB_XSUB(b.x)], 1u);
        const unsigned gen = old / nloc;
        if (old + 1u == (gen + 1u) * nloc) {
            __builtin_amdgcn_fence(__ATOMIC_RELEASE, "agent");
            asm volatile("s_waitcnt vmcnt(0)" ::: "memory");
            const unsigned og = xb_add(&bar[XB_TOP], 1u);
            const unsigned tg = og / nx;
            if (og + 1u == (tg + 1u) * nx) xb_add(&bar[XB_TOPGEN], 1u);
            else XB_SPIN(xb_ld(&bar[XB_TOPGEN]) == tg, bar);
            __builtin_amdgcn_fence(__ATOMIC_ACQUIRE, "agent");
            xb_add(&bar[XB_XGEN(b.x)], 1u);
            asm volatile("s_waitcnt vmcnt(0)" ::: "memory");
        } else {
            XB_SPIN(xb_ld(&bar[XB_XGEN(b.x)]) == gen, bar);
            __builtin_amdgcn_fence(__ATOMIC_ACQUIRE, "agent");
            asm volatile("s_waitcnt vmcnt(0)" ::: "memory");
        }
    }
    __syncthreads();
}
constexpr int LDS_BAR_OFF = 131072;

__global__ void __launch_bounds__(NWAVES * 64, 2) mk_fwd(Args args) {
    extern __shared__ __attribute__((aligned(16))) unsigned char lds_raw[];
    LAS unsigned char* lds = (LAS unsigned char*)lds_raw;
    const int ph_lo = args.ph_lo, ph_hi = args.ph_hi;
    if (threadIdx.x < 4) ((LAS unsigned*)(lds + LDS_BAR_OFF))[threadIdx.x] = 0u;
    if (COOP && blockIdx.x == 0) { unsigned* bw = (unsigned*)(args.ws + WS_CTL) + 4096; for (int i = threadIdx.x; i < XCD_BAR_WORDS; i += NWAVES * 64) __hip_atomic_store(bw + i, 0u, __ATOMIC_RELAXED, __HIP_MEMORY_SCOPE_AGENT); }
    __syncthreads();
    XcdBarrier xbar; xbar.bar = (unsigned*)(args.ws + WS_CTL) + 4096; xbar.x = 0; xbar.st = (volatile LAS unsigned*)(lds + LDS_BAR_OFF);
    if (!COOP) xbar = xcd_barrier_post(xbar.bar, xbar.st);
    for (int ph = ph_lo; ph < ph_hi; ++ph) {
        if (ph == 10 || ph == 5 || ph == 11) continue;
        int kind = 6;
        if (ph == 0) kind = 0; else if (ph < 11) kind = 1 + (ph - 1) % 5;
        const int nrep = 1 + ((REP_MASK >> kind) & 1);
        for (int rep = 0; rep < nrep; ++rep) {
        if (ph == 0) { if (PH_EN(0)) phase_prologue(lds); }
        else if (ph == 11) { if (PH_EN(6)) phase_norm_final(); }
        else {
            const int L = (ph - 1) / 5, sp = (ph - 1) % 5;
            if (sp == 0) { if (PH_EN(1)) phase_proj(lds, L); }
            else if (sp == 1) { if (PH_EN(2)) phase_mix(lds, L); }
            else if (sp == 2) { if (PH_EN(3)) phase_finalize(L); }
            else if (sp == 3) { if (PH_EN(4)) phase_out(lds, L); }
            else if (L == 0) { if (PH_EN(5)) phase_norm_mid(); }
        }
        __syncthreads();
        }
        if (ph + 1 < ph_hi) { for (int r = 0; r < SYNC_REP; ++r) { if (COOP && (ph == 0 || !XB_USE)) { __syncthreads(); cg::this_grid().sync(); if (ph == 0 && r == 0) xbar = xcd_barrier_post(xbar.bar, xbar.st); } else xcd_barrier(xbar); } }
    }
}

extern "C" void kernel_launch(void* const* d_in, const int* in_sizes, int n_in, void* d_out, int out_size, void* d_ws, size_t ws_size, hipStream_t stream) {
    static int grid = 0;
    if (grid == 0) {
        if (n_in != 14 || out_size != NTOK * DM || ws_size < WS_END) { fprintf(stderr, "kernel_launch: unexpected shapes (n_in %d, out %d, ws %zu)\n", n_in, out_size, ws_size); grid = -1; return; }
        int dev = 0, cus = 0, per_cu = 0;
        hipGetDevice(&dev); hipDeviceGetAttribute(&cus, hipDeviceAttributeMultiprocessorCount, dev);
        if (hipFuncSetAttribute((const void*)mk_fwd, hipFuncAttributeMaxDynamicSharedMemorySize, LDS_BYTES) != hipSuccess) { fprintf(stderr, "kernel_launch: hipFuncSetAttribute failed\n"); grid = -1; return; }
        if (hipOccupancyMaxActiveBlocksPerMultiprocessor(&per_cu, (const void*)mk_fwd, NWAVES * 64, LDS_BYTES) != hipSuccess || per_cu < 1) { fprintf(stderr, "kernel_launch: occupancy query says %d\n", per_cu); per_cu = 1; }
        (void)hipGetLastError();
        grid = cus;
    }
    if (grid < 0) return;
    Args a{};
    for (int i = 0; i < 14; ++i) a.in[i] = (const float*)d_in[i];
    a.out = (float*)d_out; a.ws = (unsigned char*)d_ws;
#if MK_FUSED
    a.ph_lo = 0; a.ph_hi = 10;
#if COOP
    void* kargs[] = {&a};
    hipError_t e = hipLaunchCooperativeKernel((const void*)mk_fwd, dim3(grid), dim3(NWAVES * 64), kargs, LDS_BYTES, stream);
    if (e != hipSuccess) fprintf(stderr, "cooperative launch failed: %s (grid %d)\n", hipGetErrorString(e), grid);
#else
    if (hipMemsetAsync((char*)d_ws + WS_CTL, 0, 65536, stream) != hipSuccess) { fprintf(stderr, "kernel_launch: memset of the control words failed\n"); return; }
    hipLaunchKernelGGL(mk_fwd, dim3(grid), dim3(NWAVES * 64), LDS_BYTES, stream, a);
#endif
#else
    for (int ph = 0; ph < 12; ++ph) {
        if (ph == 10) continue;
        a.ph_lo = ph; a.ph_hi = ph + 1;
        hipLaunchKernelGGL(mk_fwd, dim3(grid), dim3(NWAVES * 64), LDS_BYTES, stream, a);
    }
#endif
}
```

```cpp
#include <hip/hip_runtime.h>
#include <hip/hip_cooperative_groups.h>
#include <cstdio>
#include <cstdint>
namespace cg = cooperative_groups;

#ifndef REP_MASK
#define REP_MASK 0
#endif
#ifndef SYNC_REP
#define SYNC_REP 1
#endif
#define REPS(k) (1 + ((REP_MASK >> (k)) & 1))
#ifndef PH_MASK
#define PH_MASK 0x7f
#endif
#define PH_EN(k) ((PH_MASK >> (k)) & 1)
#ifndef XB_USE
#define XB_USE 1
#endif
#ifndef COOP
#define COOP 0
#endif
#ifndef MK_FUSED
#define MK_FUSED 1
#endif
#ifndef F8_OUT
#define F8_OUT 1
#endif
#ifndef F8_PROJ
#define F8_PROJ 0
#endif

#define LAS __attribute__((address_space(3)))
typedef _Float16 hf;
typedef _Float16 h8 __attribute__((ext_vector_type(8)));
typedef _Float16 h4 __attribute__((ext_vector_type(4)));
typedef short s16x4 __attribute__((ext_vector_type(4)));
typedef float f32x4 __attribute__((ext_vector_type(4)));
typedef float f32x2 __attribute__((ext_vector_type(2)));
typedef unsigned u32x4 __attribute__((ext_vector_type(4)));

constexpr int SEQ = 4096, NTOK = 8192, DM = 2048, NCOL = 8704, GW = 512, MIXW = 2560, NMEM = 256;
constexpr float NORM_EPS = 1e-6f;
constexpr float QSCALE = 0.08838834764831845f * 1.4426950408889634f;
enum { SL_AQ = 0, SL_AK, SL_AV, SL_AG, SL_BU, SL_BV, SL_BG, SL_CQ, SL_CK, SL_CV, SL_CG, SL_DB, SL_DC, SL_DH, SL_DG, SL_XQ, SL_XG };

constexpr size_t MiB = 1u << 20;
constexpr size_t WS_CTL = 0;
constexpr size_t WS_ROPE = 1 * MiB;
constexpr size_t WS_SGUW = 3 * MiB;
constexpr size_t WS_KPART = 4 * MiB;
constexpr size_t WS_VSTAT = 5 * MiB;
constexpr size_t WS_LSE = 6 * MiB;
constexpr size_t WS_ROWSS = 7 * MiB + 512 * 1024;
constexpr size_t WS_KVMEM = 8 * MiB;
constexpr size_t WS_MEMN = 10 * MiB;
constexpr size_t WS_WMEMT = 16 * MiB;
constexpr size_t WS_WOUTT = 24 * MiB;
constexpr size_t WS_WINT = 48 * MiB;
constexpr size_t WS_XN = 116 * MiB;
constexpr size_t WS_PROJ = 148 * MiB;
constexpr size_t WS_OA = 284 * MiB;
constexpr size_t WS_OB = 308 * MiB;
constexpr size_t WS_OCP = 316 * MiB;
constexpr size_t WS_OX = 348 * MiB;
constexpr size_t WS_Y = 356 * MiB;
constexpr size_t WS_X1 = 396 * MiB;
constexpr size_t WS_HM = 460 * MiB;
constexpr size_t WS_LIST = 520 * MiB;
constexpr size_t WS_END = 524 * MiB;
constexpr int CW_BAR = 4096;
constexpr int CW_CNT = 8192;

constexpr int PROJ_N1 = 8192;
constexpr int LDS_BYTES = 147456;
constexpr int NWAVES = 8;

__device__ __forceinline__ float shx_l(float v, int lane, int mask) { return __builtin_bit_cast(float, __builtin_amdgcn_ds_bpermute((lane ^ mask) << 2, __builtin_bit_cast(int, v))); }
__device__ __forceinline__ float wave_sum(float v, int lane) {
#pragma unroll
    for (int o = 1; o < 64; o <<= 1) v += shx_l(v, lane, o);
    return v;
}
__device__ __forceinline__ h8 pack8(f32x4 a, f32x4 b) {
    h4 x = __builtin_convertvector(a, h4), y = __builtin_convertvector(b, h4);
    return __builtin_shufflevector(x, y, 0, 1, 2, 3, 4, 5, 6, 7);
}
__device__ __forceinline__ float silu_f(float x) { return x * __builtin_amdgcn_rcpf(1.0f + __builtin_amdgcn_exp2f(-1.4426950408889634f * x)); }
__device__ __forceinline__ float gelu_f(float x) {
    const float z2 = 1.5957691216057308f * (x + 0.044715f * x * x * x);
    return x * __builtin_amdgcn_rcpf(1.0f + __builtin_amdgcn_exp2f(-1.4426950408889634f * z2));
}

typedef int i32x8 __attribute__((ext_vector_type(8)));
typedef int i32x4 __attribute__((ext_vector_type(4)));
typedef unsigned u32x2 __attribute__((ext_vector_type(2)));
__device__ __forceinline__ i32x8 cat8(h8 a, h8 b) { return __builtin_shufflevector(__builtin_bit_cast(i32x4, a), __builtin_bit_cast(i32x4, b), 0, 1, 2, 3, 4, 5, 6, 7); }
__device__ __forceinline__ unsigned pk4_f8(f32x4 a) { int w = __builtin_amdgcn_cvt_pk_fp8_f32(a[0], a[1], 0, false); return (unsigned)__builtin_amdgcn_cvt_pk_fp8_f32(a[2], a[3], w, true); }
__device__ __forceinline__ u32x2 pk8_f8(f32x4 a, f32x4 b) { return (u32x2){pk4_f8(a), pk4_f8(b)}; }
constexpr float W8_SCALE = 8.0f, A8_SCALE = 0.125f;

namespace pg8 {
constexpr int BM = 256, BK = 64, HALF = 128, HTB = HALF * BK * 2, STAGE_BYTES = 8 * HTB, NXCD = 8, WGM = 8;
__host__ __device__ __forceinline__ int lds_byte(int r, int c) { const int st = (r >> 4) * 2 + (c >> 5), rr = r & 15, cc = c & 31, ob = rr * 64 + cc * 2; return st * 1024 + (ob ^ (((ob >> 9) & 1) << 5)); }
__host__ __device__ __forceinline__ void stage_rc(int b, int& R, int& C) { const int st = b / 1024, sb = b % 1024, swz = sb ^ (((sb >> 9) & 1) << 5); R = (st >> 1) * 16 + swz / 64; C = (st & 1) * 32 + (swz % 64) / 2; }
__host__ __device__ __forceinline__ int perm32(int rho) { const int n = rho >> 4, i = rho & 15; return 8 * (i >> 2) + 4 * n + (i & 3); }
struct Unit { int pm, pn; };
struct Gemm { const void* A; const void* Bt; int M, N, K; };
struct StaticOrder {
    int nM, nN, nwg, G, c;
    __host__ __device__ void init(int M, int N, int G_, int c_) { nM = M / BM; nN = N / BM; nwg = nM * nN; G = G_; c = c_; }
    __host__ __device__ bool next(int i, Unit& u) const {
        const long L = (long)i * G + c; if (L >= nwg) return false;
        int wgid = (int)L; { const int q = nwg / NXCD, r = nwg % NXCD, xcd = wgid % NXCD, off = wgid / NXCD; wgid = (xcd < r ? xcd * (q + 1) : r * (q + 1) + (xcd - r) * q) + off; }
        const int nig = WGM * nN, gid = wgid / nig, fm = gid * WGM, gsz = (nM - fm) < WGM ? (nM - fm) : WGM;
        u.pm = fm + ((wgid % nig) % gsz); u.pn = (wgid % nig) / gsz; return true;
    }
    __device__ __forceinline__ void a_ready(const Unit&) const {}
    __device__ __forceinline__ void done(const Unit&) const {}
};

struct OneUnit {
    int pm, pn;
    __device__ __forceinline__ bool next(int i, Unit& u) const { if (i != 0) return false; u.pm = pm; u.pn = pn; return true; }
    __device__ __forceinline__ void a_ready(const Unit&) const {}
    __device__ __forceinline__ void done(const Unit&) const {}
};
template <class Epi, class Sched, bool ALIGN_EPI, bool SP2, bool F8 = false>
__device__ __forceinline__ void gemm_phase(LAS unsigned char* lds, const Gemm g, const Sched& S, const Epi& E) {
    static_assert(SP2, "only the SP2 loop is kept");
    int tid = threadIdx.x; asm volatile("" : "+v"(tid));
    const int wid = __builtin_amdgcn_readfirstlane(tid >> 6), lane = tid & 63, wr = wid >> 2, wc = wid & 3, fr = lane & 15, fq = lane >> 4;
    constexpr int EB = F8 ? 1 : 2;
    const int K = g.K, nt = K * EB / (BK * 2);
    unsigned voffA[2], voffB[2];
#pragma unroll
    for (int i = 0; i < 2; ++i) { int R, C; stage_rc(tid * 16 + i * 8192, R, C); const int Rb = Epi::PERM ? ((R & ~31) + perm32(R & 31)) : R;
        voffA[i] = (unsigned)(R * K * EB + C * 2); voffB[i] = (unsigned)(Rb * K * EB + C * 2); }
    const size_t kstep = (size_t)(BK * 2);
    const size_t hstep = (size_t)HALF * K * EB;
    const size_t tstep = 2 * hstep;
    const unsigned ldsw = (unsigned)wid * 1024u;
    const int aoff = lds_byte(wr * 64 + fr, fq * 8), boff = lds_byte(wc * 32 + fr, fq * 8);
#define PG8_SA(b, h) (((b) * 2 + (h)) * HTB)
#define PG8_SB(b, h) ((4 + (b) * 2 + (h)) * HTB)
#define PG8_STAGE(bufoff, gbase, voff) do { _Pragma("unroll") for (int _i = 0; _i < 2; ++_i) \
        __builtin_amdgcn_global_load_lds((const unsigned*)((const char*)(gbase) + (voff)[_i]), (LAS unsigned*)(lds + (bufoff) + ldsw + _i * 8192), 16, 0, 0); } while (0)
#define PG8_LDA(dst, b, h) do { _Pragma("unroll") for (int m = 0; m < 4; ++m) _Pragma("unroll") for (int k = 0; k < 2; ++k) dst[m][k] = *(const LAS h8*)(lds + PG8_SA(b, h) + aoff + m * 2048 + k * 1024); } while (0)
#define PG8_LDB(dst, b, h) do { _Pragma("unroll") for (int n = 0; n < 2; ++n) _Pragma("unroll") for (int k = 0; k < 2; ++k) dst[n][k] = *(const LAS h8*)(lds + PG8_SB(b, h) + boff + n * 2048 + k * 1024); } while (0)
#define PG8_MMA(ai, bj, At, Bt) do { __builtin_amdgcn_s_setprio(1); _Pragma("unroll") for (int m = 0; m < 4; ++m) _Pragma("unroll") for (int n = 0; n < 2; ++n) { \
        if constexpr (F8) asm volatile("v_mfma_f32_16x16x128_f8f6f4 %0, %1, %2, %0" : "+v"(acc[ai][bj][m][n]) : "v"(cat8(Bt[n][0], Bt[n][1])), "v"(cat8(At[m][0], At[m][1]))); \
        else { _Pragma("unroll") for (int k = 0; k < 2; ++k) acc[ai][bj][m][n] = __builtin_amdgcn_mfma_f32_16x16x32_f16(Bt[n][k], At[m][k], acc[ai][bj][m][n], 0, 0, 0); } } \
        __builtin_amdgcn_s_setprio(0); } while (0)
#define PG8_WAIT_V(n) asm volatile("s_waitcnt vmcnt(" #n ")" ::: "memory")
#define PG8_WAIT_L(n) asm volatile("s_waitcnt lgkmcnt(" #n ")" ::: "memory")
#define PG8_BAR __builtin_amdgcn_s_barrier()
#define PG8_SCHED __builtin_amdgcn_sched_barrier(0)
    Unit cur, nxt; int ui = 0;
    if (!S.next(0, cur)) return;
    f32x4 acc[2][2][4][2];
    E.init(acc, cur, wr, wc, fr, fq);
    h8 At[4][2], B0[2][2], B1[2][2];
    const char* cA = (const char*)g.A + (size_t)cur.pm * tstep; const char* cB = (const char*)g.Bt + (size_t)cur.pn * tstep;
    S.a_ready(cur);
    {
        PG8_STAGE(PG8_SB(0, 0), cB, voffB); PG8_STAGE(PG8_SB(0, 1), cB + hstep, voffB); PG8_STAGE(PG8_SA(0, 0), cA, voffA); PG8_STAGE(PG8_SA(0, 1), cA + hstep, voffA);
        if (wr == 1) PG8_BAR;
        PG8_WAIT_V(2); PG8_BAR;
        PG8_STAGE(PG8_SB(1, 0), cB + kstep, voffB); PG8_STAGE(PG8_SA(1, 0), cA + kstep, voffA); PG8_STAGE(PG8_SB(1, 1), cB + hstep + kstep, voffB);
        PG8_WAIT_V(6); PG8_BAR;
    }
    for (;;) {
        const bool has_next = S.next(ui + 1, nxt);
        const char* nA = has_next ? (const char*)g.A + (size_t)nxt.pm * tstep : cA; const char* nB = has_next ? (const char*)g.Bt + (size_t)nxt.pn * tstep : cB;
        for (int t = 0; t < nt; t += 2) {
            const bool last = (t == nt - 2);
            const char* a1 = cA + (size_t)(t + 1) * kstep;
            const char* a2 = last ? nA : cA + (size_t)(t + 2) * kstep; const char* b2 = last ? nB : cB + (size_t)(t + 2) * kstep;
            const char* a3 = a2 + kstep; const char* b3 = b2 + kstep;
            if (last && has_next) S.a_ready(nxt);
            PG8_LDB(B0, 0, 0); PG8_LDB(B1, 0, 1); PG8_SCHED; PG8_LDA(At, 0, 0); PG8_STAGE(PG8_SA(1, 1), a1 + hstep, voffA);
            PG8_WAIT_V(8); PG8_WAIT_L(0); PG8_BAR; PG8_MMA(0, 0, At, B0); PG8_MMA(0, 1, At, B1); PG8_BAR; PG8_SCHED;
            PG8_LDA(At, 0, 1); PG8_STAGE(PG8_SB(0, 0), b2, voffB); PG8_STAGE(PG8_SB(0, 1), b2 + hstep, voffB); PG8_STAGE(PG8_SA(0, 0), a2, voffA);
            PG8_WAIT_V(8); PG8_WAIT_L(0); PG8_BAR; PG8_MMA(1, 0, At, B0); PG8_MMA(1, 1, At, B1); PG8_BAR; PG8_SCHED;
            PG8_LDB(B0, 1, 0); PG8_LDB(B1, 1, 1); PG8_SCHED; PG8_LDA(At, 1, 0); PG8_STAGE(PG8_SA(0, 1), a2 + hstep, voffA);
            PG8_WAIT_V(8); PG8_WAIT_L(0); PG8_BAR; PG8_MMA(0, 0, At, B0); PG8_MMA(0, 1, At, B1); PG8_BAR; PG8_SCHED;
            PG8_LDA(At, 1, 1); PG8_STAGE(PG8_SB(1, 0), b3, voffB); PG8_STAGE(PG8_SB(1, 1), b3 + hstep, voffB); PG8_STAGE(PG8_SA(1, 0), a3, voffA);
            PG8_WAIT_V(8); PG8_WAIT_L(0); PG8_BAR; PG8_MMA(1, 0, At, B0); PG8_MMA(1, 1, At, B1); PG8_BAR; PG8_SCHED;
        }
        if constexpr (F8) asm volatile("s_nop 15\n\ts_nop 15" ::: "memory");
        if constexpr (ALIGN_EPI) { if (wr == 0) PG8_BAR; }
        if constexpr (!Epi::AFTER_DRAIN) { E(acc, cur, wr, wc, fr, fq); S.done(cur); }
        if (!has_next) break;
        E.init(acc, nxt, wr, wc, fr, fq);
        cur = nxt; cA = nA; cB = nB; ++ui;
        if constexpr (ALIGN_EPI) { if (wr == 1) PG8_BAR; }
    }
    PG8_WAIT_V(0);
    if constexpr (!ALIGN_EPI) { if (wr == 0) PG8_BAR; }
    PG8_BAR;
    if constexpr (Epi::AFTER_DRAIN) { E.fused(acc, cur, wr, wc, fr, fq, lds); S.done(cur); }
#undef PG8_SA
#undef PG8_SB
#undef PG8_STAGE
#undef PG8_LDA
#undef PG8_LDB
#undef PG8_MMA
#undef PG8_WAIT_V
#undef PG8_WAIT_L
#undef PG8_BAR
#undef PG8_SCHED
}

struct EpiProj {
    static constexpr bool PERM = true, AFTER_DRAIN = false;
    hf* O; const float* cosT; const float* sinT; float* kpart; f32x2* vstat; const float* rowss; hf* HM;
    __device__ __forceinline__ void init(f32x4 (&acc)[2][2][4][2], const Unit&, int, int, int, int) const {
#pragma unroll
        for (int a = 0; a < 2; ++a)
#pragma unroll
            for (int b = 0; b < 2; ++b)
#pragma unroll
                for (int m = 0; m < 4; ++m)
#pragma unroll
                    for (int n = 0; n < 2; ++n) acc[a][b][m][n] = (f32x4){0.f, 0.f, 0.f, 0.f};
    }
    template <int TYPE>
    __device__ __forceinline__ void run(const f32x4 (&acc)[2][2][4][2], const Unit& u, int wr, int wc, int fr, int fq, int hmi, int colbase) const {
        asm volatile("" : "+v"(fr), "+v"(fq));
        const int row0 = u.pm * BM + wr * 64 + fr, col0 = colbase + wc * 32 + 8 * fq;
        const int jj = 4 * wc + fq;
        if (TYPE >= 8) {
#pragma unroll
            for (int ai = 0; ai < 2; ++ai)
#pragma unroll
                for (int m = 0; m < 4; ++m) {
                    const int row = row0 + ai * HALF + m * 16;
                    const f32x4 pa = *(const f32x4*)(rowss + (size_t)row * 8), pb = *(const f32x4*)(rowss + (size_t)row * 8 + 4);
                    const float rsc = __builtin_amdgcn_rsqf(((pa[0] + pa[1]) + (pa[2] + pa[3]) + (pb[0] + pb[1]) + (pb[2] + pb[3])) * (1.0f / DM) + NORM_EPS);
#pragma unroll
                    for (int bj = 0; bj < 2; ++bj) {
                        const f32x4 v0 = acc[ai][bj][m][0] * rsc, v1 = acc[ai][bj][m][1] * rsc; f32x4 pr;
#pragma unroll
                        for (int i = 0; i < 4; ++i) pr[i] = (TYPE == 8 ? gelu_f(v0[i]) : v0[i]) * (TYPE == 10 ? v1[i] : silu_f(v1[i]));
                        *(h4*)(O + (size_t)row * NCOL + colbase + bj * 64 + wc * 16 + 4 * fq) = __builtin_convertvector(pr, h4);
                    }
                    asm volatile("" ::: "memory");
                }
            return;
        }
        f32x4 cs[2][2];
        if (TYPE == 3) {
#pragma unroll
            for (int bj = 0; bj < 2; ++bj)
#pragma unroll
                for (int n = 0; n < 2; ++n) cs[bj][n] = (f32x4){0.f, 0.f, 0.f, 0.f};
        }
        float rscv[8];
        {
            f32x4 pa[8], pb[8];
#pragma unroll
            for (int i = 0; i < 8; ++i) { const int row = row0 + (i >> 2) * HALF + (i & 3) * 16; pa[i] = *(const f32x4*)(rowss + (size_t)row * 8); pb[i] = *(const f32x4*)(rowss + (size_t)row * 8 + 4); }
#pragma unroll
            for (int i = 0; i < 8; ++i) rscv[i] = __builtin_amdgcn_rsqf(((pa[i][0] + pa[i][1]) + (pa[i][2] + pa[i][3]) + (pb[i][0] + pb[i][1]) + (pb[i][2] + pb[i][3])) * (1.0f / DM) + NORM_EPS);
        }
        f32x4 cv_n = (f32x4){1.f, 1.f, 1.f, 1.f}, sv_n = (f32x4){0.f, 0.f, 0.f, 0.f};
        if (TYPE >= 1 && TYPE <= 3) { const int t = row0 & (SEQ - 1); cv_n = *(const f32x4*)(cosT + t * 64 + 4 * jj); sv_n = *(const f32x4*)(sinT + t * 64 + 4 * jj); }
#pragma unroll
        for (int ai = 0; ai < 2; ++ai)
#pragma unroll
            for (int m = 0; m < 4; ++m) {
                const int row = row0 + ai * HALF + m * 16;
                hf* rowp = O + (size_t)row * NCOL + col0;
                const f32x4 cv = cv_n, sv = sv_n;
                if (TYPE >= 1 && TYPE <= 3 && (ai * 4 + m) < 7) {
                    const int in_ = ai * 4 + m + 1, t = (row0 + (in_ >> 2) * HALF + (in_ & 3) * 16) & (SEQ - 1);
                    cv_n = *(const f32x4*)(cosT + t * 64 + 4 * jj); sv_n = *(const f32x4*)(sinT + t * 64 + 4 * jj); }
                float s1 = 0.f, s2 = 0.f;
                const float rsc = rscv[ai * 4 + m];
#pragma unroll
                for (int bj = 0; bj < 2; ++bj) {
                    f32x4 v0 = acc[ai][bj][m][0] * rsc, v1 = acc[ai][bj][m][1] * rsc;
                    if (TYPE >= 1 && TYPE <= 3) {
                        const f32x4 r0 = v0 * cv - v1 * sv, r1 = v1 * cv + v0 * sv; v0 = r0; v1 = r1;
                        if (TYPE == 1) { v0 = v0 * QSCALE; v1 = v1 * QSCALE; }
                        if (TYPE == 3) { cs[bj][0] += v0; cs[bj][1] += v1; asm volatile("" : "+v"(cs[bj][0]), "+v"(cs[bj][1])); }
                    } else if (TYPE == 4 || TYPE == 5) {
#pragma unroll
                        for (int i = 0; i < 4; ++i) { v0[i] = gelu_f(v0[i]); v1[i] = gelu_f(v1[i]); }
                    } else if (TYPE == 6) {
#pragma unroll
                        for (int i = 0; i < 4; ++i) { v0[i] = silu_f(v0[i]); v1[i] = silu_f(v1[i]); }
                    } else if (TYPE == 7) { v0 = v0 * QSCALE; v1 = v1 * QSCALE; }
                    const h8 hv = pack8(v0, v1);
                    if (TYPE == 5) {
#pragma unroll
                        for (int i = 0; i < 8; ++i) { const float x = (float)hv[i]; s1 += x; s2 += x * x; }
                    }
                    if ((TYPE <= 3 || TYPE == 7) && hmi >= 0) {
                        const int hh = (u.pn & 1) * 2 + bj;
                        *(h8*)(HM + (size_t)hmi * NTOK * GW + ((size_t)((row >> 12) * 4 + hh) * SEQ + (row & (SEQ - 1))) * 128 + wc * 32 + 8 * fq) = hv;
                    } else *(h8*)(rowp + bj * HALF) = hv;
                }
                if (TYPE == 5) {
                    { const int ln_ = fq * 16 + fr; s1 += shx_l(s1, ln_, 16); s1 += shx_l(s1, ln_, 32); s2 += shx_l(s2, ln_, 16); s2 += shx_l(s2, ln_, 32); }
                    if (fq == 0) vstat[(size_t)row * 8 + (u.pn & 1) * 4 + wc] = (f32x2){s1, s2};
                }
                asm volatile("" ::: "memory");
            }
        if (TYPE == 3) {
#pragma unroll
            for (int bj = 0; bj < 2; ++bj)
#pragma unroll
                for (int n = 0; n < 2; ++n) {
                    f32x4 c = cs[bj][n];
#pragma unroll
                    for (int o = 1; o < 16; o <<= 1) { const int ln_ = fq * 16 + fr; c[0] += shx_l(c[0], ln_, o); c[1] += shx_l(c[1], ln_, o); c[2] += shx_l(c[2], ln_, o); c[3] += shx_l(c[3], ln_, o); }
                    if (fr == 0) *(f32x4*)(kpart + (size_t)(u.pm * 2 + wr) * GW + (u.pn & 1) * BM + bj * HALF + wc * 32 + 8 * fq + 4 * n) = c;
                }
        }
    }
    __device__ __forceinline__ void operator()(const f32x4 (&acc)[2][2][4][2], const Unit& u, int wr, int wc, int fr, int fq) const {
        const int pn = u.pn, slice = pn >> 1, cb = pn * BM;
        if (pn >= 8 && pn < 12) run<8>(acc, u, wr, wc, fr, fq, -1, SL_BU * GW + (pn - 8) * 128);
        else if (pn == 12 || pn == 13) run<5>(acc, u, wr, wc, fr, fq, -1, SL_BV * GW + (pn - 12) * BM);
        else if (pn >= 22 && pn < 26) run<9>(acc, u, wr, wc, fr, fq, -1, SL_DB * GW + (pn - 22) * 128);
        else if (pn >= 26 && pn < 30) run<10>(acc, u, wr, wc, fr, fq, -1, SL_DC * GW + (pn - 26) * 128);
        else if (slice == SL_AQ || slice == SL_CQ) run<1>(acc, u, wr, wc, fr, fq, slice == SL_AQ ? 0 : 3, cb);
        else if (slice == SL_AK) run<2>(acc, u, wr, wc, fr, fq, 1, cb);
        else if (slice == SL_CK) run<3>(acc, u, wr, wc, fr, fq, 4, cb);
        else if (slice == SL_AG || slice == SL_CG || slice == SL_XG) run<6>(acc, u, wr, wc, fr, fq, -1, cb);
        else if (slice == SL_XQ) run<7>(acc, u, wr, wc, fr, fq, 6, cb);
        else run<0>(acc, u, wr, wc, fr, fq, slice == SL_AV ? 2 : (slice == SL_CV ? 5 : -1), cb);
    }
};
struct EpiRes {
    static constexpr bool PERM = false, AFTER_DRAIN = true;
    const float* res32; const hf* res16; hf* out16; float* rowss; float* out32; const float* gfin; unsigned* pcnt;
    __device__ __forceinline__ void init(f32x4 (&acc)[2][2][4][2], const Unit& u, int wr, int wc, int fr, int fq) const {
        asm volatile("" : "+v"(fr), "+v"(fq));
        const int row0 = u.pm * BM + wr * 64 + fr, col0 = u.pn * BM + wc * 32 + 4 * fq;
#pragma unroll
        for (int ai = 0; ai < 2; ++ai)
#pragma unroll
            for (int m = 0; m < 4; ++m) { const size_t off = (size_t)(row0 + ai * HALF + m * 16) * DM + col0;
#pragma unroll
                for (int bj = 0; bj < 2; ++bj)
#pragma unroll
                    for (int n = 0; n < 2; ++n) {
                        if (res32 != nullptr) acc[ai][bj][m][n] = __builtin_nontemporal_load((const f32x4*)(res32 + off + bj * HALF + n * 16));
                        else acc[ai][bj][m][n] = __builtin_convertvector(__builtin_nontemporal_load((const h4*)(res16 + off + bj * HALF + n * 16)), f32x4); } }
    }
    __device__ __forceinline__ void fused(const f32x4 (&acc)[2][2][4][2], const Unit& u, int wr, int wc, int fr, int fq, LAS unsigned char* lds) const {
        asm volatile("" : "+v"(fr), "+v"(fq));
        const int row0 = u.pm * BM + wr * 64 + fr, col0 = u.pn * BM + wc * 32 + 4 * fq;
        LAS float* red = (LAS float*)lds;
#pragma unroll
        for (int ai = 0; ai < 2; ++ai)
#pragma unroll
            for (int m = 0; m < 4; ++m) { const size_t off = (size_t)(row0 + ai * HALF + m * 16) * DM + col0; float ss = 0.f;
#pragma unroll
                for (int bj = 0; bj < 2; ++bj)
#pragma unroll
                    for (int n = 0; n < 2; ++n) { const f32x4 o = acc[ai][bj][m][n];
                        if (out32 == nullptr) *(h4*)(out16 + off + bj * HALF + n * 16) = __builtin_convertvector(o, h4);
                        ss += (o[0] * o[0] + o[1] * o[1]) + (o[2] * o[2] + o[3] * o[3]); }
                { const int ln_ = fq * 16 + fr; ss += shx_l(ss, ln_, 16); ss += shx_l(ss, ln_, 32); } if (fq == 0) red[(wr * 64 + ai * HALF + m * 16 + fr) * 4 + wc] = ss;
                asm volatile("" ::: "memory"); }
        __syncthreads();
        int t = threadIdx.x; asm volatile("" : "+v"(t));
        if (t < 256) { const f32x4 p = *(const LAS f32x4*)(red + t * 4); __hip_atomic_store(&rowss[(size_t)(u.pm * BM + t) * 8 + u.pn], (p[0] + p[1]) + (p[2] + p[3]), __ATOMIC_RELAXED, __HIP_MEMORY_SCOPE_AGENT); }
        if (out32 != nullptr) {
            asm volatile("s_waitcnt vmcnt(0)" ::: "memory");
            __syncthreads();
            if (t == 0) {
                __hip_atomic_fetch_add(pcnt + u.pm, 1u, __ATOMIC_RELAXED, __HIP_MEMORY_SCOPE_AGENT);
                unsigned sp = 0u;
                while (__hip_atomic_load(pcnt + u.pm, __ATOMIC_RELAXED, __HIP_MEMORY_SCOPE_AGENT) < 8u) { __builtin_amdgcn_s_sleep(1); if (++sp > (1u << 22)) break; }
                __builtin_amdgcn_fence(__ATOMIC_ACQUIRE, "agent"); asm volatile("s_waitcnt vmcnt(0)" ::: "memory");
            }
            __syncthreads();
#pragma unroll
            for (int ai = 0; ai < 2; ++ai)
#pragma unroll
                for (int m = 0; m < 4; ++m) { const int row = row0 + ai * HALF + m * 16; const size_t off = (size_t)row * DM + col0;
                    const f32x4 pa = *(const f32x4*)(rowss + (size_t)row * 8), pb = *(const f32x4*)(rowss + (size_t)row * 8 + 4);
                    const float r = __builtin_amdgcn_rsqf(((pa[0] + pa[1]) + (pa[2] + pa[3]) + (pb[0] + pb[1]) + (pb[2] + pb[3])) * (1.0f / DM) + NORM_EPS);
#pragma unroll
                    for (int bj = 0; bj < 2; ++bj)
#pragma unroll
                        for (int n = 0; n < 2; ++n) { const f32x4 gg = *(const f32x4*)(gfin + col0 + bj * HALF + n * 16);
                            __builtin_nontemporal_store(acc[ai][bj][m][n] * r * gg, (f32x4*)(out32 + off + bj * HALF + n * 16)); }
                    asm volatile("" ::: "memory"); }
        }
    }
};
}

namespace att {
constexpr int NWV = 8, QBLK = 32, KVBLK = 64, QB = NWV * QBLK, D = 128;
constexpr int SHM_V = KVBLK * D * 2, SHM_K = KVBLK * D * 2;
constexpr int LDS_WS = 2 * SHM_V + 2 * SHM_K;
constexpr int LDS_KSUM = LDS_WS + NWV * 96 * 4;
constexpr int LDS_BYTES_ATT = LDS_KSUM + 16 * 128 * 4;
constexpr float THR2 = 11.5f;
typedef float f32x16 __attribute__((ext_vector_type(16)));
typedef short s16x8 __attribute__((ext_vector_type(8)));
typedef _Float16 h2 __attribute__((ext_vector_type(2)));
#define KSWZ(row, colB) ((row) * 256 + ((colB) ^ (((row) & 7) << 4)))
#define SBAR() __builtin_amdgcn_sched_barrier(0)
__device__ __forceinline__ int v_st(int k, int c) { const int kk = (k & ~0xC) | ((k & 4) << 1) | ((k & 8) >> 1); return ((kk >> 3) * 4 + (c >> 5)) * 512 + ((kk & 7) * 32 + (c & 31)) * 2; }
__device__ __forceinline__ int v_rd_base(int lane) { return ((lane & 3) << 3) | (((lane >> 2) & 3) << 6) | (((lane >> 4) & 1) << 5) | (((lane >> 5) & 1) << 8); }
constexpr int v_rd_off(int d0, int ks, int half) { return d0 * 512 + ks * 4096 + half * 2048; }
__device__ __forceinline__ int crow(int r, int hi) { return (r & 3) + 8 * (r >> 2) + 4 * hi; }
__device__ __forceinline__ unsigned cvtpk(float lo, float hi) { const f32x2 v = {lo, hi}; const h2 b = __builtin_convertvector(v, h2); return __builtin_bit_cast(unsigned, b); }
__device__ __forceinline__ void mask_tile(f32x16& p0, f32x16& p1, int dq, unsigned W) {
    float NEG = -__builtin_inff(); asm volatile("" : "+v"(NEG));
#pragma unroll
    for (int r = 0; r < 16; ++r) {
        const int c = (r & 3) + 8 * (r >> 2);
        if ((unsigned)(dq - c) >= W) p0[r] = NEG;
        if ((unsigned)(dq - c - 32) >= W) p1[r] = NEG;
    }
}
__device__ __forceinline__ void partialSM(f32x16& p0, f32x16& p1, float& m_reg, float& mn, float& alpha) {
    float pmax = p0[0];
#pragma unroll
    for (int r = 1; r < 16; ++r) pmax = fmaxf(pmax, p0[r]);
#pragma unroll
    for (int r = 0; r < 16; ++r) pmax = fmaxf(pmax, p1[r]);
    { auto rr = __builtin_amdgcn_permlane32_swap(__float_as_uint(pmax), __float_as_uint(pmax), false, false);
      pmax = fmaxf(__uint_as_float(rr[0]), __uint_as_float(rr[1])); }
    mn = ((pmax - m_reg) <= THR2) ? m_reg : fmaxf(m_reg, pmax); alpha = __builtin_amdgcn_exp2f(m_reg - mn); m_reg = mn;
#pragma unroll
    for (int r = 0; r < 16; ++r) p0[r] = p0[r] - mn;
#pragma unroll
    for (int r = 0; r < 16; ++r) p1[r] = p1[r] - mn;
#pragma unroll
    for (int r = 0; r < 16; ++r) p0[r] = __builtin_amdgcn_exp2f(p0[r]);
}
__device__ __forceinline__ void finishSM(f32x16& p0, f32x16& p1, float alpha, float& l_reg, h8& pa0, h8& pa1, h8& pa2, h8& pa3) {
#pragma unroll
    for (int r = 0; r < 16; ++r) p1[r] = __builtin_amdgcn_exp2f(p1[r]);
    float ps = 0;
#pragma unroll
    for (int r = 0; r < 16; ++r) ps += p0[r];
#pragma unroll
    for (int r = 0; r < 16; ++r) ps += p1[r];
    { auto rr = __builtin_amdgcn_permlane32_swap(__float_as_uint(ps), __float_as_uint(ps), false, false);
      ps = __uint_as_float(rr[0]) + __uint_as_float(rr[1]); }
    l_reg = l_reg * alpha + ps;
#define PK4(P, B_, OUT) do { unsigned a0 = cvtpk(P[B_+0], P[B_+1]), a1 = cvtpk(P[B_+2], P[B_+3]);                          \
        unsigned b0 = cvtpk(P[B_+4], P[B_+5]), b1 = cvtpk(P[B_+6], P[B_+7]);                                             \
        auto r0 = __builtin_amdgcn_permlane32_swap(a0, b0, false, false); auto r1 = __builtin_amdgcn_permlane32_swap(a1, b1, false, false); \
        u32x4 w = {r0[0], r1[0], r0[1], r1[1]}; OUT = __builtin_bit_cast(h8, w); } while (0)
    PK4(p0, 0, pa0); PK4(p0, 8, pa1); PK4(p1, 0, pa2); PK4(p1, 8, pa3);
#undef PK4
}
template <int KB>
__device__ __forceinline__ void qkt(f32x16& p0, f32x16& p1, const LAS char* K_lds, int r32, int hi, const h8* qr, bool act) {
    if (!act) { float NEG = -__builtin_inff(); asm volatile("" : "+v"(NEG));
#pragma unroll
        for (int r = 0; r < 16; ++r) { p0[r] = NEG; p1[r] = NEG; } return; }
    p0 = f32x16{}; p1 = f32x16{};
    const LAS char* kb[4];
#pragma unroll
    for (int dd = 0; dd < 4; ++dd) kb[dd] = K_lds + KB * SHM_K + KSWZ(r32, (dd * 16 + hi * 8) * 2);
#pragma unroll
    for (int d0 = 0; d0 < 8; ++d0) { const LAS char* a = kb[d0 & 3] + (d0 >> 2) * 128;
        const h8 b0 = *reinterpret_cast<const LAS h8*>(a);
        const h8 b1 = *reinterpret_cast<const LAS h8*>(a + 32 * 256);
        p0 = __builtin_amdgcn_mfma_f32_32x32x16_f16(b0, qr[d0], p0, 0, 0, 0);
        p1 = __builtin_amdgcn_mfma_f32_32x32x16_f16(b1, qr[d0], p1, 0, 0, 0); }
}
template <int VB>
__device__ __forceinline__ void pv_tile(f32x16* o, int vb0, h8 pa0, h8 pa1, h8 pa2, h8 pa3, bool act) {
    if (!act) return;
#define TRRD(dst, off) asm volatile("ds_read_b64_tr_b16 %0, %1 offset:%2" : "=&v"(dst) : "v"(vb0), "i"(off) : "memory")
#define MKH8(l, h) __builtin_bit_cast(h8, (s16x8){l[0], l[1], l[2], l[3], h[0], h[1], h[2], h[3]})
#define PV_D0(d0) do { s16x4 l0, l1, l2, l3, h0, h1, h2, h3; constexpr int b_ = VB * SHM_V + v_rd_off(d0, 0, 0); \
        TRRD(l0, b_); TRRD(h0, b_ + 2048); TRRD(l1, b_ + 4096); TRRD(h1, b_ + 6144); TRRD(l2, b_ + 8192); TRRD(h2, b_ + 10240); TRRD(l3, b_ + 12288); TRRD(h3, b_ + 14336); \
        asm volatile("s_waitcnt lgkmcnt(0)" ::: "memory"); SBAR();   \
        o[d0] = __builtin_amdgcn_mfma_f32_32x32x16_f16(pa0, MKH8(l0, h0), o[d0], 0, 0, 0);   \
        o[d0] = __builtin_amdgcn_mfma_f32_32x32x16_f16(pa1, MKH8(l1, h1), o[d0], 0, 0, 0);   \
        o[d0] = __builtin_amdgcn_mfma_f32_32x32x16_f16(pa2, MKH8(l2, h2), o[d0], 0, 0, 0);   \
        o[d0] = __builtin_amdgcn_mfma_f32_32x32x16_f16(pa3, MKH8(l3, h3), o[d0], 0, 0, 0); } while (0)
    PV_D0(0); PV_D0(1); PV_D0(2); PV_D0(3);
#undef PV_D0
#undef MKH8
#undef TRRD
}
struct BlkRef { const hf* Q; const hf* K; const hf* V; hf* O; float* LSE; const unsigned* list; int qs, ks, os, ls; int P0, W, j_lo, j_hi, cnt; };
struct NxtRef { const hf* Q; const hf* K; const hf* V; const unsigned* list; int qs, ks, j_lo, cnt; };
struct Seam { h8 qr[8]; h8 st_v0, st_v1, st_k0, st_k1; unsigned ent; };
__device__ __forceinline__ long q_row_of(const unsigned* list, int cnt, int idx, unsigned& ent) {
    ent = 0xFFFFFFFFu; if (list == nullptr) return idx;
    if (idx < cnt) ent = list[idx];
    return ent == 0xFFFFFFFFu ? 0 : (long)(ent & 0xFFFFu);
}
#define ROWP(p, st, k0, rr) ((p) + (long)((k0) + (rr)) * (st) + sc)
#define VMW() asm volatile("s_waitcnt vmcnt(0)" ::: "memory")
#define VMWN(n) asm volatile("s_waitcnt vmcnt(%0)" :: "i"(n) : "memory")
#define SLOAD_H(Kp, Vp, st, k0) do { S.st_v0 = *(const h8*)ROWP(Vp, st, k0, sr); S.st_v1 = *(const h8*)ROWP(Vp, st, k0, 32 + sr);              \
                         S.st_k0 = *(const h8*)ROWP(Kp, st, k0, sr); S.st_k1 = *(const h8*)ROWP(Kp, st, k0, 32 + sr); } while (0)
#define SWRITE_HK(bf) do { *(LAS h8*)(K_lds + (bf) * SHM_K + kws) = S.st_k0; *(LAS h8*)(K_lds + (bf) * SHM_K + kws + 32 * 256) = S.st_k1; } while (0)
#define SWRITE_HV(bf) do { *(LAS h8*)(V_lds + (bf) * SHM_V + vst0) = S.st_v0; *(LAS h8*)(V_lds + (bf) * SHM_V + vst1) = S.st_v1; } while (0)
#define SWRITE_H(bf) do { SWRITE_HV(bf); SWRITE_HK(bf); } while (0)
__device__ __forceinline__ void blk_prime(const BlkRef& cur, LAS char* lds, Seam& S) {
    int tid = threadIdx.x; asm volatile("" : "+v"(tid));
    const int wid = __builtin_amdgcn_readfirstlane(tid >> 6), lane = tid & 63, r32 = lane & 31, hi = lane >> 5;
    const int sr = tid >> 4, sc = (tid & 15) * 8, kws = KSWZ(sr, sc * 2); LAS char* K_lds = lds + 2 * SHM_V;
    const int kb0 = cur.j_lo * KVBLK;
    { const long qrow = q_row_of(cur.list, cur.cnt, wid * QBLK + r32, S.ent);
#pragma unroll
      for (int d0 = 0; d0 < 8; ++d0) S.qr[d0] = *(const h8*)(cur.Q + qrow * cur.qs + d0 * 16 + hi * 8); }
    SLOAD_H(cur.K, cur.V, cur.ks, kb0); VMW(); SWRITE_HK(0);
    __syncthreads();
}
__device__ __forceinline__ void blk_run(const BlkRef& cur, const NxtRef& nxt, LAS char* lds, Seam& S, unsigned tk, volatile LAS int* qw, int qbase) {
    int tid = threadIdx.x; asm volatile("" : "+v"(tid));
    const int wid = __builtin_amdgcn_readfirstlane(tid >> 6), lane = tid & 63, r32 = lane & 31, hi = lane >> 5;
    const int j_lo = cur.j_lo, NT = cur.j_hi - cur.j_lo, W = cur.W;
    const int kbn = nxt.j_lo * KVBLK;
    const int qlo = cur.P0 + wid * QBLK, qm = qlo + r32 - 4 * hi;
    LAS char* V_lds = lds; LAS char* K_lds = lds + 2 * SHM_V;
    LAS float* ws = (LAS float*)(lds + LDS_WS) + wid * 96; LAS float* li_l = ws; LAS float* al_l = ws + 32;
    float m_reg = -1e30f, l_reg = 0; f32x16 o[4] = {}; int epi_r32;
    const int sr = tid >> 4, sc = (tid & 15) * 8, vst0 = v_st(sr, sc), vst1 = v_st(32 + sr, sc), kws = KSWZ(sr, sc * 2);
    const int vb0 = (int)(unsigned)(uintptr_t)V_lds + v_rd_base(lane);
    const hf* Kh = cur.K; const hf* Vh = cur.V; const int kst = cur.ks;
    const unsigned ent_cur = S.ent;
    LAS unsigned* rt_l = (LAS unsigned*)(ws + 64);
    if (cur.list != nullptr && hi == 0) rt_l[r32] = ent_cur;
#define RESC(a) do { if (__any((a) < 1.f)) { if (hi == 0) al_l[r32] = (a); asm volatile("s_waitcnt lgkmcnt(0)" ::: "memory");              \
                     for (int d_ = 0; d_ < 4; ++d_) for (int r = 0; r < 16; ++r) o[d_][r] *= al_l[crow(r, hi)]; } } while (0)
#define KBASE(t) ((j_lo + (t)) * KVBLK)
#define ACT(t) (KBASE(t) <= qlo + QBLK - 1 && KBASE(t) + KVBLK - 1 >= qlo - W + 1)
#define MASKT(P0_, P1_, t) do { const int kb_ = KBASE(t); if (ACT(t) && (kb_ + KVBLK - 1 > qlo || kb_ <= qlo + QBLK - 1 - W)) mask_tile(P0_, P1_, qm - kb_, (unsigned)W); } while (0)
    constexpr int NQL = 8;
#define SEAM_K0() do { VMWN(NQL); SWRITE_HK(0); SBAR(); } while (0)
    f32x16 pA0, pA1, pB0, pB1; float mnA, mnB, alA, alB; h8 pa0, pa1, pa2, pa3;
    SWRITE_HV(0); SBAR();
    if (NT > 1) { SLOAD_H(Kh, Vh, kst, KBASE(1)); }
    SBAR(); qkt<0>(pA0, pA1, K_lds, r32, hi, S.qr, ACT(0));
    if (ACT(0)) { MASKT(pA0, pA1, 0); partialSM(pA0, pA1, m_reg, mnA, alA); } else { mnA = m_reg; alA = 1.f; }
    if (NT > 1) { VMW(); SWRITE_H(1); SBAR(); }
    if (NT > 2) { SLOAD_H(Kh, Vh, kst, KBASE(2)); SBAR(); }
    __syncthreads();
#define HALF_STEP(PX0, PX1, mnX, alX, PY0, PY1, alY, t, KB, VB, SB) do {                                                      \
        SBAR(); qkt<KB>(PX0, PX1, K_lds, r32, hi, S.qr, ACT(t));                                             \
        if (ACT((t) - 1)) finishSM(PY0, PY1, alY, l_reg, pa0, pa1, pa2, pa3); SBAR();                                         \
        pv_tile<VB>(o, vb0, pa0, pa1, pa2, pa3, ACT((t) - 1));                                                                \
        if (ACT(t)) { MASKT(PX0, PX1, (t)); partialSM(PX0, PX1, m_reg, mnX, alX); } else { mnX = m_reg; alX = 1.f; }          \
        __syncthreads();                                                                                                      \
        if ((t) + 1 < NT) { VMW(); SWRITE_H(SB); SBAR(); }                                                                  \
        if ((t) + 2 < NT) { SLOAD_H(Kh, Vh, kst, KBASE((t) + 2)); SBAR(); }                                               \
        RESC(alX); __syncthreads(); } while (0)
    for (int t = 1; t + 1 < NT; t += 2) {
        HALF_STEP(pB0, pB1, mnB, alB, pA0, pA1, alA, t, 1, 0, 0);
        HALF_STEP(pA0, pA1, mnA, alA, pB0, pB1, alB, t + 1, 0, 1, 1);
    }
    const bool even = (NT & 1) == 0;
    if (even) { SBAR(); qkt<1>(pB0, pB1, K_lds, r32, hi, S.qr, ACT(NT - 1)); SBAR(); }
    { SLOAD_H(nxt.K, nxt.V, nxt.ks, kbn); SBAR();
      const long qrow = q_row_of(nxt.list, nxt.cnt, wid * QBLK + r32, S.ent);
#pragma unroll
      for (int d0 = 0; d0 < 8; ++d0) S.qr[d0] = *(const h8*)(nxt.Q + qrow * nxt.qs + d0 * 16 + hi * 8); }
    SBAR();
    if (ACT(even ? NT - 2 : NT - 1)) finishSM(pA0, pA1, alA, l_reg, pa0, pa1, pa2, pa3); SBAR();
    pv_tile<0>(o, vb0, pa0, pa1, pa2, pa3, ACT(even ? NT - 2 : NT - 1));
    if (even) { if (ACT(NT - 1)) { MASKT(pB0, pB1, NT - 1); partialSM(pB0, pB1, m_reg, mnB, alB); } else { mnB = m_reg; alB = 1.f; } __syncthreads(); RESC(alB);
        if (ACT(NT - 1)) finishSM(pB0, pB1, alB, l_reg, pa0, pa1, pa2, pa3); SBAR(); pv_tile<1>(o, vb0, pa0, pa1, pa2, pa3, ACT(NT - 1)); }
    SBAR(); SEAM_K0();
    if (hi == 0) li_l[r32] = l_reg; asm volatile("s_waitcnt lgkmcnt(0)" ::: "memory");
    { int lane_e = lane; asm volatile("" : "+v"(lane_e)); epi_r32 = lane_e & 31; }
    float rli[16];
#pragma unroll
    for (int r = 0; r < 16; ++r) { const float lv = li_l[crow(r, hi)]; rli[r] = lv > 0.f ? __builtin_amdgcn_rcpf(lv) : 0.f; }
    __syncthreads();
    {
        LAS char* ost = V_lds + wid * 4096;
        const bool odd = (epi_r32 & 1) != 0;
        const bool gat = cur.list != nullptr;
        hf* Ow = cur.O + (long)(wid * QBLK) * cur.os;
#pragma unroll
        for (int ps = 0; ps < 2; ++ps) {
#pragma unroll
            for (int r = 0; r < 16; ++r) {
                const float va = o[2 * ps][r] * rli[r], vb = o[2 * ps + 1][r] * rli[r];
                const float got = shx_l(odd ? va : vb, hi * 32 + epi_r32, 1);
                const unsigned w = odd ? cvtpk(got, vb) : cvtpk(va, got);
                *(LAS unsigned*)(ost + crow(r, hi) * 128 + (odd ? 64 : 0) + (epi_r32 & ~1) * 2) = w;
            }
            asm volatile("s_waitcnt lgkmcnt(0)" ::: "memory");
#pragma unroll
            for (int it = 0; it < 4; ++it) {
                const int idx = it * 64 + (hi * 32 + epi_r32), row = idx >> 3, ch = idx & 7;
                const u32x4 v = *(const LAS u32x4*)(ost + row * 128 + ch * 16);
                if (!gat) *(u32x4*)(Ow + (long)row * cur.os + ps * 64 + ch * 8) = v;
                else { const unsigned e = rt_l[row]; if (e != 0xFFFFFFFFu) *(u32x4*)(cur.O + ((long)(e >> 16) * NTOK + (long)(e & 0xFFFFu)) * GW + ps * 64 + ch * 8) = v; }
            }
            asm volatile("s_waitcnt lgkmcnt(0)" ::: "memory");
        }
        if (!gat) { if (cur.LSE != nullptr && hi == 0) cur.LSE[(long)(wid * QBLK + epi_r32) * cur.ls] = l_reg > 0.f ? m_reg + __builtin_amdgcn_logf(l_reg) : -1e30f; }
        else if (hi == 0 && ent_cur != 0xFFFFFFFFu) cur.LSE[((long)(ent_cur >> 16) * NTOK + (long)(ent_cur & 0xFFFFu)) * 4] = l_reg > 0.f ? m_reg + __builtin_amdgcn_logf(l_reg) : -1e30f;
    }
    if (tid == 0) qw[0] = qbase + (int)tk;
    __syncthreads();
#undef RESC
#undef KBASE
#undef ACT
#undef MASKT
#undef SEAM_K0
#undef HALF_STEP
}
#undef ROWP
#undef VMW
#undef VMWN
#undef SLOAD_H
#undef SWRITE_HK
#undef SWRITE_HV
#undef SWRITE_H
#undef KSWZ
#undef SBAR
}

constexpr int VROW = 288;
constexpr int WAVE_LDS = 10240;
constexpr int NG = 1;
constexpr int QW = 16 * NG;
constexpr int NPH = SEQ / QW;

__device__ __forceinline__ void load_q(h8 (&qf)[NG][4], const hf* qb, long qstride, int fr, int quad) {
#pragma unroll
    for (int g = 0; g < NG; ++g) { const hf* p = qb + (long)(16 * g + fr) * qstride + 8 * quad;
#pragma unroll
        for (int c = 0; c < 4; ++c) qf[g][c] = *(const h8*)(p + 32 * c); }
}
__device__ __forceinline__ void v_stage_load(h8 (&vs)[8], const hf* Vt, long stride, int rlo, int rhi, int fr, int quad) {
#pragma unroll
    for (int it = 0; it < 8; ++it) { int r = 4 * it + quad; r = r < rlo ? rlo : r; r = r > rhi ? rhi : r; vs[it] = *(const h8*)(Vt + (long)r * stride + 8 * fr); }
}
__device__ __forceinline__ void v_stage_store(const h8 (&vs)[8], LAS unsigned char* vl, int fr, int quad) {
#pragma unroll
    for (int it = 0; it < 8; ++it) *(LAS h8*)(vl + (4 * it + quad) * VROW + fr * 16) = vs[it];
}
__device__ __forceinline__ void pv_mma(f32x4 (&o)[NG][8], const h8 (&pf)[NG], LAS unsigned char* vl, int fr, int quad) {
    LAS unsigned char* base = vl + (4 * quad + (fr >> 2)) * VROW + 8 * (fr & 3);
#pragma unroll
    for (int dt = 0; dt < 8; ++dt) {
        const s16x4 a = __builtin_amdgcn_ds_read_tr16_b64_v4i16((LAS s16x4*)(base + 32 * dt));
        const s16x4 b = __builtin_amdgcn_ds_read_tr16_b64_v4i16((LAS s16x4*)(base + 16 * VROW + 32 * dt));
        const h4 x = __builtin_bit_cast(h4, a), y = __builtin_bit_cast(h4, b);
        const h8 vf = __builtin_shufflevector(x, y, 0, 1, 2, 3, 4, 5, 6, 7);
#pragma unroll
        for (int g = 0; g < NG; ++g) o[g][dt] = __builtin_amdgcn_mfma_f32_16x16x32_f16(vf, pf[g], o[g][dt], 0, 0, 0);
    }
}
struct AttnAcc { f32x4 o[NG][8]; float m[NG], l[NG]; };
__device__ __forceinline__ void attn_init(AttnAcc& a) {
#pragma unroll
    for (int g = 0; g < NG; ++g) { a.m[g] = -1e30f; a.l[g] = 0.f;
#pragma unroll
        for (int dt = 0; dt < 8; ++dt) a.o[g][dt] = (f32x4){0.f, 0.f, 0.f, 0.f}; }
}
template <class Mask>
__device__ __forceinline__ void attn_step(AttnAcc& a, const h8 (&qf)[NG][4], const hf* Kt, const hf* Vt, long stride, int rlo, int rhi, LAS unsigned char* vl, int fr, int quad, Mask mask) {
    __builtin_amdgcn_sched_barrier(0);
    f32x4 s[NG][2];
    {
        h8 kf[2][4];
#pragma unroll
        for (int kb = 0; kb < 2; ++kb) { int r = 16 * kb + fr; r = r < rlo ? rlo : r; r = r > rhi ? rhi : r; const hf* p = Kt + (long)r * stride + 8 * quad;
#pragma unroll
            for (int c = 0; c < 4; ++c) kf[kb][c] = *(const h8*)(p + 32 * c); }
#pragma unroll
        for (int g = 0; g < NG; ++g)
#pragma unroll
            for (int kb = 0; kb < 2; ++kb) { s[g][kb] = (f32x4){0.f, 0.f, 0.f, 0.f};
#pragma unroll
                for (int c = 0; c < 4; ++c) s[g][kb] = __builtin_amdgcn_mfma_f32_16x16x32_f16(kf[kb][c], qf[g][c], s[g][kb], 0, 0, 0); }
    }
    h8 vs[8];
    v_stage_load(vs, Vt, stride, rlo, rhi, fr, quad);
    h8 pf[NG];
#pragma unroll
    for (int g = 0; g < NG; ++g) {
        float mx = -3e38f;
#pragma unroll
        for (int kb = 0; kb < 2; ++kb)
#pragma unroll
            for (int r = 0; r < 4; ++r) { const float v = mask(g, kb, r) ? s[g][kb][r] : -3e38f; s[g][kb][r] = v; mx = fmaxf(mx, v); }
        { const int ln_ = quad * 16 + fr; mx = fmaxf(mx, shx_l(mx, ln_, 16)); mx = fmaxf(mx, shx_l(mx, ln_, 32)); }
        const float mn = fmaxf(a.m[g], mx), alpha = __builtin_amdgcn_exp2f(a.m[g] - mn);
        a.m[g] = mn; a.l[g] *= alpha;
#pragma unroll
        for (int dt = 0; dt < 8; ++dt) a.o[g][dt] = a.o[g][dt] * alpha;
        f32x4 p0, p1; float ps = 0.f;
#pragma unroll
        for (int r = 0; r < 4; ++r) { p0[r] = __builtin_amdgcn_exp2f(s[g][0][r] - mn); p1[r] = __builtin_amdgcn_exp2f(s[g][1][r] - mn); ps += p0[r] + p1[r]; }
        a.l[g] += ps;
        pf[g] = pack8(p0, p1);
    }
    v_stage_store(vs, vl, fr, quad);
    pv_mma(a.o, pf, vl, fr, quad);
    __builtin_amdgcn_sched_barrier(0);
}
__device__ __forceinline__ void attn_finish(AttnAcc& a, hf* ob, long ostride, float* lsep, long lstride, int fr, int quad) {
#pragma unroll
    for (int g = 0; g < NG; ++g) {
        float lt = a.l[g]; { const int ln_ = quad * 16 + fr; lt += shx_l(lt, ln_, 16); lt += shx_l(lt, ln_, 32); }
        const float inv = lt > 0.f ? 1.0f / lt : 0.f;
        hf* p = ob + (long)(16 * g + fr) * ostride + 4 * quad;
#pragma unroll
        for (int dt = 0; dt < 8; ++dt) { const f32x4 v = a.o[g][dt] * inv; *(h4*)(p + 16 * dt) = __builtin_convertvector(v, h4); }
        if (lsep != nullptr && quad == 0) lsep[(long)(16 * g + fr) * lstride] = lt > 0.f ? a.m[g] + __builtin_log2f(lt) : -1e30f;
    }
}

struct MixP {
    const hf* proj; const hf* kvmem; hf* oa; float* lsea; hf* ob; hf* ocp; float* lsec; hf* ox;
    const float* kpart; const f32x2* vstat; const hf* sguw; const float* sgurs; const float* sgub; const float* lng; const float* lnb;
};
constexpr int N_A = 3 * 8 * NPH, N_X = 8 * NPH, N_C = 40 * 8 * (256 / QW), N_B = 2 * 32 * 4 * (128 / QW);

__device__ __forceinline__ void item_A(const MixP& P, int idx, LAS unsigned char* vl, int fr, int quad) {
    asm volatile("" : "+v"(fr), "+v"(quad));
    const int p = idx / (8 * NPH), r10 = idx % (8 * NPH), b = r10 / (4 * NPH), h = (r10 / NPH) & 3, slot = r10 % NPH;
    const int dsh = 2 * p, d = 1 << dsh, cpr = NPH >> dsh, Lsub = SEQ >> dsh;
    const int res = slot / cpr, ch = slot % cpr, l0 = QW * ch;
    const long rowbase = (long)b * SEQ + res, stride = (long)d * NCOL;
    h8 qf[NG][4];
    load_q(qf, P.proj + (rowbase + (long)l0 * d) * NCOL + SL_AQ * GW + h * 128, stride, fr, quad);
    const hf* Kb = P.proj + rowbase * NCOL + SL_AK * GW + h * 128;
    const hf* Vb = P.proj + rowbase * NCOL + SL_AV * GW + h * 128;
    AttnAcc a; attn_init(a);
    constexpr int NST = (128 + QW + 31) / 32;
    for (int s = NST - 1; s >= 0; --s) {
        const int lk0 = l0 - 128 + 32 * s;
        if (lk0 + 31 < 0) break;
        const int rlo = lk0 < 0 ? -lk0 : 0, rhi = (Lsub - 1 - lk0) < 31 ? (Lsub - 1 - lk0) : 31;
        attn_step(a, qf, Kb + (long)lk0 * stride, Vb + (long)lk0 * stride, stride, rlo, rhi, vl, fr, quad,
                  [&](int g, int kb, int r) { const int lq = l0 + 16 * g + fr, lk = lk0 + 16 * kb + 4 * quad + r; return lk >= 0 && lk <= lq && lq - lk <= 128; });
    }
    const long orow = (long)p * NTOK + rowbase + (long)l0 * d;
    attn_finish(a, P.oa + orow * GW + h * 128, (long)d * GW, P.lsea + orow * 4 + h, (long)d * 4, fr, quad);
}
__device__ __forceinline__ void item_X(const MixP& P, int idx, LAS unsigned char* vl, int fr, int quad) {
    asm volatile("" : "+v"(fr), "+v"(quad));
    const int b = idx / (4 * NPH), h = (idx / NPH) & 3, ch = idx % NPH;
    const long row0 = (long)b * SEQ + QW * ch;
    h8 qf[NG][4];
    load_q(qf, P.proj + row0 * NCOL + SL_XQ * GW + h * 128, NCOL, fr, quad);
    const hf* Kb = P.kvmem + (long)b * NMEM * 1024 + h * 128;
    AttnAcc a; attn_init(a);
    for (int s = 0; s < 8; ++s)
        attn_step(a, qf, Kb + (long)(32 * s) * 1024, Kb + (long)(32 * s) * 1024 + GW, 1024, 0, 31, vl, fr, quad, [&](int, int, int) { return true; });
    attn_finish(a, P.ox + row0 * GW + h * 128, GW, nullptr, 0, fr, quad);
}
__device__ const unsigned char CTAB[40] = {60,61,62,63,56,57,58,52,53,54,48,49,50,44,45,46,40,41,36,37,32,33,28,29,24,20,16,12,59,42,25,8,55,38,21,4,51,34,17,0};
__device__ __forceinline__ void item_C(const MixP& P, int idx, LAS unsigned char* vl, int fr, int quad) {
    asm volatile("" : "+v"(fr), "+v"(quad));
    constexpr int NSUB = 256 / QW;
    const int e = idx / (8 * NSUB), rest = idx % (8 * NSUB), bh = rest / NSUB, sub = rest % NSUB, b = bh >> 2, h = bh & 3;
    const int code = CTAB[e], qblk = code >> 2, part = code & 3;
    const long row0 = (long)b * SEQ + qblk * 256 + sub * QW;
    h8 qf[NG][4];
    load_q(qf, P.proj + row0 * NCOL + SL_CQ * GW + h * 128, NCOL, fr, quad);
    unsigned sel[NG];
    {
        float v1[NG], v2[NG], v3[NG]; int i1[NG], i2[NG], i3[NG];
#pragma unroll
        for (int g = 0; g < NG; ++g) { v1[g] = v2[g] = v3[g] = -3e38f; i1[g] = i2[g] = i3[g] = -1; }
        for (int n = 0; n < qblk; ++n) {
            const float* k0 = P.kpart + (size_t)((b * 16 + n) * 2) * GW + h * 128 + 8 * quad;
            float dv[NG];
#pragma unroll
            for (int g = 0; g < NG; ++g) dv[g] = 0.f;
#pragma unroll
            for (int c = 0; c < 4; ++c) {
                const f32x4 ka = *(const f32x4*)(k0 + 32 * c) + *(const f32x4*)(k0 + GW + 32 * c);
                const f32x4 kb = *(const f32x4*)(k0 + 32 * c + 4) + *(const f32x4*)(k0 + GW + 32 * c + 4);
#pragma unroll
                for (int g = 0; g < NG; ++g)
#pragma unroll
                    for (int i = 0; i < 4; ++i) dv[g] += (float)qf[g][c][i] * ka[i] + (float)qf[g][c][4 + i] * kb[i];
            }
#pragma unroll
            for (int g = 0; g < NG; ++g) {
                float v = dv[g]; { const int ln_ = quad * 16 + fr; v += shx_l(v, ln_, 16); v += shx_l(v, ln_, 32); }
                if (v > v1[g]) { v3[g] = v2[g]; i3[g] = i2[g]; v2[g] = v1[g]; i2[g] = i1[g]; v1[g] = v; i1[g] = n; }
                else if (v > v2[g]) { v3[g] = v2[g]; i3[g] = i2[g]; v2[g] = v; i2[g] = n; }
                else if (v > v3[g]) { v3[g] = v; i3[g] = n; }
            }
        }
#pragma unroll
        for (int g = 0; g < NG; ++g) sel[g] = (i1[g] >= 0 ? 1u << i1[g] : 0u) | (i2[g] >= 0 ? 1u << i2[g] : 0u) | (i3[g] >= 0 ? 1u << i3[g] : 0u);
    }
    unsigned selany = 0u;
#pragma unroll
    for (int g = 0; g < NG; ++g) selany |= sel[g];
    AttnAcc a; attn_init(a);
    const int nlo = 4 * part, nhi = (4 * part + 3 < qblk) ? 4 * part + 3 : qblk;
    for (int n = nlo; n <= nhi; ++n) {
        const hf* Kb = P.proj + ((long)b * SEQ + n * 256) * NCOL + SL_CK * GW + h * 128;
        if (n == qblk) {
            const int tlmax = (QW * sub + QW - 1) >> 5;
            for (int tl = 0; tl <= tlmax; ++tl)
                attn_step(a, qf, Kb + (long)(32 * tl) * NCOL, Kb + (long)(32 * tl) * NCOL + GW, NCOL, 0, 31, vl, fr, quad,
                          [&](int g, int kb, int r) { return 32 * tl + 16 * kb + 4 * quad + r <= QW * sub + 16 * g + fr; });
        } else {
            const bool any = __any((int)((selany >> n) & 1u));
            if (any) {
                for (int tl = 0; tl < 8; ++tl)
                    attn_step(a, qf, Kb + (long)(32 * tl) * NCOL, Kb + (long)(32 * tl) * NCOL + GW, NCOL, 0, 31, vl, fr, quad,
                              [&](int g, int, int) { return ((sel[g] >> n) & 1u) != 0u; });
            }
        }
    }
    const long orow = (long)part * NTOK + row0;
    attn_finish(a, P.ocp + orow * GW + h * 128, GW, P.lsec + orow * 4 + h, 4, fr, quad);
}
__device__ __forceinline__ void item_B(const MixP& P, int idx, LAS unsigned char* vl, int lane, int fr, int quad) {
    asm volatile("" : "+v"(lane)); fr = lane & 15; quad = lane >> 4;
    constexpr int NIG = 128 / QW;
    const int ig = NIG - 1 - (idx >> 8), rest = idx & 255, b = rest >> 7, chunk = (rest >> 2) & 31, g = rest & 3;
    const int smax = (QW * ig + QW - 1) >> 5;
    const long tok0 = (long)b * SEQ + chunk * 128;
    LAS f32x2* stl = (LAS f32x2*)(vl + 32 * VROW);
#pragma unroll
    for (int k = 0; k < 2; ++k) { const int tt = lane + 64 * k;
        if (tt < 32 * (smax + 1)) { const f32x2* sp = P.vstat + (size_t)(tok0 + tt) * 8; float s1 = 0.f, s2 = 0.f;
#pragma unroll
            for (int q = 0; q < 8; ++q) { const f32x2 v = sp[q]; s1 += v.x; s2 += v.y; }
            const float mu = s1 * (1.0f / 512.0f), var = fmaxf(s2 * (1.0f / 512.0f) - mu * mu, 0.f);
            stl[tt] = (f32x2){mu, __builtin_amdgcn_rsqf(var + NORM_EPS)}; } }
    AttnAcc a; attn_init(a);
    float aacc[NG];
#pragma unroll
    for (int g2 = 0; g2 < NG; ++g2) aacc[g2] = 0.f;
    const hf* Vb = P.proj + tok0 * NCOL + SL_BV * GW + g * 128;
    h8 vsa[4][8];
#pragma unroll
    for (int s = 0; s < 4; ++s) if (s <= smax) v_stage_load(vsa[s], Vb + (long)(32 * s) * NCOL, NCOL, 0, 31, fr, quad);
#pragma unroll
    for (int s = 0; s < 4; ++s) { if (s <= smax) {
        const int j0 = 32 * s;
        h8 (&vs)[8] = vsa[s];
        h8 pf[NG];
#pragma unroll
        for (int g2 = 0; g2 < NG; ++g2) {
            const int i = QW * ig + 16 * g2 + fr;
            f32x4 pv[2];
#pragma unroll
            for (int kb = 0; kb < 2; ++kb) { const int j = j0 + 16 * kb + 4 * quad;
                const h4 w = *(const h4*)(P.sguw + ((size_t)(g * 128 + i)) * 128 + j);
#pragma unroll
                for (int r = 0; r < 4; ++r) { const f32x2 st = stl[j + r]; pv[kb][r] = (float)w[r] * st.y; } }
            pf[g2] = pack8(pv[0], pv[1]);
#pragma unroll
            for (int kb = 0; kb < 2; ++kb)
#pragma unroll
                for (int r = 0; r < 4; ++r) aacc[g2] += (float)pf[g2][4 * kb + r] * stl[j0 + 16 * kb + 4 * quad + r].x;
        }
        v_stage_store(vs, vl, fr, quad);
        pv_mma(a.o, pf, vl, fr, quad);
    } }
#pragma unroll
    for (int g2 = 0; g2 < NG; ++g2) {
        float as = aacc[g2]; as += shx_l(as, lane, 16); as += shx_l(as, lane, 32);
        const int i = QW * ig + 16 * g2 + fr;
        const float rs = P.sgurs[g * 128 + i], bs = P.sgub[g * 128 + i];
        const hf* up = P.proj + (tok0 + i) * NCOL + SL_BU * GW + g * 128 + 4 * quad;
        hf* op = P.ob + (tok0 + i) * GW + g * 128 + 4 * quad;
#pragma unroll
        for (int dt = 0; dt < 8; ++dt) {
            const f32x4 gm = *(const f32x4*)(P.lng + g * 128 + 16 * dt + 4 * quad), bt = *(const f32x4*)(P.lnb + g * 128 + 16 * dt + 4 * quad);
            const h4 u = *(const h4*)(up + 16 * dt);
            f32x4 o;
#pragma unroll
            for (int r = 0; r < 4; ++r) o[r] = (float)u[r] * (gm[r] * (a.o[g2][dt][r] - as) + bt[r] * rs + bs);
            *(h4*)(op + 16 * dt) = __builtin_convertvector(o, h4);
        }
    }
}

struct Args { const float* in[14]; float* out; unsigned char* ws; int ph_lo, ph_hi; };

__device__ __forceinline__ int win_phys_row(int n) {
    const int slice = n >> 9, ch = n & 511;
    if (slice == SL_AQ || slice == SL_AK || slice == SL_CQ || slice == SL_CK) { const int d = n & 127, dd = d & 63; return (n & ~127) + 8 * (dd >> 2) + (d >= 64 ? 4 : 0) + (dd & 3); }
    if (slice == SL_BU) return 4 * 512 + (ch >> 2) * 8 + (ch & 3);
    if (slice == SL_BG) return 4 * 512 + (ch >> 2) * 8 + 4 + (ch & 3);
    if (slice == SL_BV) return 6 * 512 + ch;
    if (slice == SL_DB) return 11 * 512 + (ch >> 2) * 8 + (ch & 3);
    if (slice == SL_DG) return 11 * 512 + (ch >> 2) * 8 + 4 + (ch & 3);
    if (slice == SL_DC) return 13 * 512 + (ch >> 2) * 8 + (ch & 3);
    if (slice == SL_DH) return 13 * 512 + (ch >> 2) * 8 + 4 + (ch & 3);
    return n;
}
__device__ __forceinline__ void tr_item(const float* W, int K, int N, hf* WT, LAS float* scr, int item, int lane, bool perm, const float* kscale = nullptr) {
    const int nblk = N / 32, kb = item / nblk, nb = item % nblk, k0 = 64 * kb, n0 = 32 * nb;
#pragma unroll 8
    for (int i = 0; i < 32; ++i) { const int kk = 2 * i + (lane >> 5); scr[kk * 33 + (lane & 31)] = W[(size_t)(k0 + kk) * N + n0 + (lane & 31)]; }
    asm volatile("s_waitcnt lgkmcnt(0)" ::: "memory");
    const int c = lane & 7;
    f32x4 ga = (f32x4){1.f, 1.f, 1.f, 1.f}, gb = ga;
    if (kscale) { ga = *(const f32x4*)(kscale + k0 + 8 * c); gb = *(const f32x4*)(kscale + k0 + 8 * c + 4); }
#pragma unroll
    for (int j = 0; j < 4; ++j) { const int n = (lane >> 3) + 8 * j; const LAS float* s = scr + (8 * c) * 33 + n;
        const f32x4 a = (f32x4){s[0], s[33], s[66], s[99]} * ga, b = (f32x4){s[132], s[165], s[198], s[231]} * gb;
        const int nr = perm ? win_phys_row(n0 + n) : (n0 + n);
        *(h8*)(WT + (size_t)nr * K + k0 + 8 * c) = pack8(a, b); }
    asm volatile("s_waitcnt lgkmcnt(0)" ::: "memory");
}
__device__ __forceinline__ void rms_row(const float* xrow, const float* g, hf* oh, float* of, int lane) {
    f32x4 v[8]; float ss = 0.f;
#pragma unroll
    for (int j = 0; j < 8; ++j) { v[j] = *(const f32x4*)(xrow + 4 * (lane + 64 * j)); ss += v[j][0] * v[j][0] + v[j][1] * v[j][1] + v[j][2] * v[j][2] + v[j][3] * v[j][3]; }
    const float r = __builtin_amdgcn_rsqf(wave_sum(ss, lane) * (1.0f / DM) + NORM_EPS);
#pragma unroll
    for (int j = 0; j < 8; ++j) { const f32x4 gg = *(const f32x4*)(g + 4 * (lane + 64 * j)); const f32x4 o = v[j] * r * gg;
        if (oh) *(h4*)(oh + 4 * (lane + 64 * j)) = __builtin_convertvector(o, h4); else *(f32x4*)(of + 4 * (lane + 64 * j)) = o; }
}

#define CAS __attribute__((address_space(4)))
#define KA_BEGIN() const CAS Args* ka = (const CAS Args*)__builtin_amdgcn_kernarg_segment_ptr(); asm volatile("" : "+s"(ka)); \
    int tid_ = threadIdx.x; asm volatile("" : "+v"(tid_)); const int lane = tid_ & 63; \
    const int wave = __builtin_amdgcn_readfirstlane(tid_ >> 6), fr = lane & 15, quad = lane >> 4; \
    const int G = gridDim.x, gw = blockIdx.x * NWAVES + wave, NGW = G * NWAVES; unsigned char* ws = ka->ws; \
    (void)fr; (void)quad; (void)gw; (void)NGW; (void)ws

struct ConvDesc { const float* W; hf* WT; const float* kscale; int K, N, k0, n0; bool perm; bool f8; };
__device__ __forceinline__ ConvDesc conv_decode(int it, const float* w_in, const float* w_out, const float* w_mem_kv, hf* winT, hf* woutT, hf* wmemT, const float* norm_g) {
    constexpr int I_IN = (DM / 64) * (NCOL / 32), I_OUT = (MIXW / 64) * (DM / 32), I_MEM = (DM / 64) * (1024 / 32), I_ALL = I_IN + I_OUT + I_MEM;
    const int l = it >= I_ALL ? 1 : 0; int r = it - l * I_ALL; ConvDesc d;
    if (r < I_IN) { d.W = w_in + (size_t)l * DM * NCOL; d.WT = winT + (size_t)l * NCOL * DM; d.K = DM; d.N = NCOL; d.perm = true; d.kscale = norm_g + l * DM; }
    else if (r < I_IN + I_OUT) { r -= I_IN; d.W = w_out + (size_t)l * MIXW * DM; d.WT = woutT + (size_t)l * DM * MIXW; d.K = MIXW; d.N = DM; d.perm = false; d.kscale = nullptr; }
    else { r -= I_IN + I_OUT; d.W = w_mem_kv + (size_t)l * DM * 1024; d.WT = wmemT + (size_t)l * 1024 * DM; d.K = DM; d.N = 1024; d.perm = false; d.kscale = nullptr; }
    const int nblk = d.N / 32; d.k0 = 64 * (r / nblk); d.n0 = 32 * (r % nblk);
    return d;
}
__device__ __forceinline__ void conv_load(f32x4 (&v)[8], const ConvDesc& d, int lane) {
    const float* p = d.W + (size_t)(d.k0 + (lane >> 3)) * d.N + d.n0 + 4 * (lane & 7);
#pragma unroll
    for (int i = 0; i < 8; ++i) v[i] = *(const f32x4*)(p + (size_t)(8 * i) * d.N);
}
__device__ __forceinline__ int win_phys_row(int n);
__device__ __forceinline__ void conv_store(const f32x4 (&v)[8], const ConvDesc& d, LAS float* scr, int lane) {
    { LAS float* s = scr + (lane >> 3) * 33 + 4 * (lane & 7);
#pragma unroll
      for (int i = 0; i < 8; ++i) { s[(8 * i) * 33 + 0] = v[i][0]; s[(8 * i) * 33 + 1] = v[i][1]; s[(8 * i) * 33 + 2] = v[i][2]; s[(8 * i) * 33 + 3] = v[i][3]; } }
    asm volatile("s_waitcnt lgkmcnt(0)" ::: "memory");
    const int c = lane & 7;
    f32x4 ga = (f32x4){1.f, 1.f, 1.f, 1.f}, gb = ga;
    if (d.kscale) { ga = *(const f32x4*)(d.kscale + d.k0 + 8 * c); gb = *(const f32x4*)(d.kscale + d.k0 + 8 * c + 4); }
#pragma unroll
    for (int j = 0; j < 4; ++j) { const int n = (lane >> 3) + 8 * j; const LAS float* s = scr + (8 * c) * 33 + n;
        const f32x4 a = (f32x4){s[0], s[33], s[66], s[99]} * ga, b = (f32x4){s[132], s[165], s[198], s[231]} * gb;
        const int nr = d.perm ? win_phys_row(d.n0 + n) : (d.n0 + n);
        *(h8*)(d.WT + (size_t)nr * d.K + d.k0 + 8 * c) = pack8(a, b); }
    asm volatile("s_waitcnt lgkmcnt(0)" ::: "memory");
}
constexpr int CT_IN = (DM / 128) * (NCOL / 128), CT_OUT = (MIXW / 128) * (DM / 128), CT_MEM = (DM / 128) * (1024 / 128), CT_ALL = CT_IN + CT_OUT + CT_MEM;
__device__ __forceinline__ ConvDesc ctile_decode(int it, const float* w_in, const float* w_out, const float* w_mem_kv, hf* winT, hf* woutT, hf* wmemT, const float* norm_g) {
    const int l = it >= CT_ALL ? 1 : 0; int r = it - l * CT_ALL; ConvDesc d;
    if (r < CT_IN) { d.W = w_in + (size_t)l * DM * NCOL; d.WT = (hf*)((unsigned char*)winT + (size_t)l * NCOL * DM * (F8_PROJ ? 1 : 2)); d.K = DM; d.N = NCOL; d.perm = true; d.kscale = norm_g + l * DM; d.f8 = F8_PROJ; }
    else if (r < CT_IN + CT_OUT) { r -= CT_IN; d.W = w_out + (size_t)l * MIXW * DM; d.WT = (hf*)((unsigned char*)woutT + (size_t)l * DM * MIXW * (F8_OUT ? 1 : 2)); d.K = MIXW; d.N = DM; d.perm = false; d.kscale = nullptr; d.f8 = F8_OUT; }
    else { r -= CT_IN + CT_OUT; d.W = w_mem_kv + (size_t)l * DM * 1024; d.WT = wmemT + (size_t)l * 1024 * DM; d.K = DM; d.N = 1024; d.perm = false; d.kscale = nullptr; d.f8 = false; }
    const int nblk = d.N / 128; d.k0 = 128 * (r / nblk); d.n0 = 128 * (r % nblk);
    return d;
}
__device__ __forceinline__ void ctile_load(f32x4 (&v)[8], const ConvDesc& d, int tid) {
    const float* p = d.W + (size_t)(d.k0 + (tid >> 5)) * d.N + d.n0 + 4 * (tid & 31);
#pragma unroll
    for (int i = 0; i < 8; ++i) v[i] = __builtin_nontemporal_load((const f32x4*)(p + (size_t)(16 * i) * d.N));
}
__device__ __forceinline__ void ctile_store(const f32x4 (&v)[8], const ConvDesc& d, LAS float* t129, int tid) {
    { LAS float* s = t129 + (tid >> 5) * 129 + 4 * (tid & 31);
#pragma unroll
      for (int i = 0; i < 8; ++i) { s[(16 * i) * 129 + 0] = v[i][0]; s[(16 * i) * 129 + 1] = v[i][1]; s[(16 * i) * 129 + 2] = v[i][2]; s[(16 * i) * 129 + 3] = v[i][3]; } }
    __syncthreads();
    const int c = tid & 15;
    f32x4 ga = (f32x4){1.f, 1.f, 1.f, 1.f}, gb = ga;
    if (d.kscale) { ga = *(const f32x4*)(d.kscale + d.k0 + 8 * c); gb = *(const f32x4*)(d.kscale + d.k0 + 8 * c + 4); }
#pragma unroll
    for (int j = 0; j < 4; ++j) { const int n = (tid >> 4) + 32 * j; const LAS float* s = t129 + (8 * c) * 129 + n;
        const f32x4 a = (f32x4){s[0], s[129], s[258], s[387]} * ga, b = (f32x4){s[516], s[645], s[774], s[903]} * gb;
        const int nr = d.perm ? win_phys_row(d.n0 + n) : (d.n0 + n);
        if (d.f8) *(u32x2*)((unsigned char*)d.WT + (size_t)nr * d.K + d.k0 + 8 * c) = pk8_f8(a * W8_SCALE, b * W8_SCALE);
        else *(h8*)(d.WT + (size_t)nr * d.K + d.k0 + 8 * c) = pack8(a, b); }
    __syncthreads();
}
constexpr int CONV_I_IN = (DM / 64) * (NCOL / 32), CONV_I_OUT = (MIXW / 64) * (DM / 32), CONV_I_MEM = (DM / 64) * (1024 / 32);
constexpr int CONV_ITEMS = CONV_I_IN + CONV_I_OUT + CONV_I_MEM;
__device__ __forceinline__ void conv_item(const float* w_in, const float* w_out, const float* w_mem_kv, hf* winT, hf* woutT, hf* wmemT, int l, int it, LAS float* scr, int lane, const float* norm_g) {
    int r = it;
    if (r < CONV_I_IN) { tr_item(w_in + (size_t)l * DM * NCOL, DM, NCOL, winT + (size_t)l * NCOL * DM, scr, r, lane, true, norm_g + l * DM); return; } r -= CONV_I_IN;
    if (r < CONV_I_OUT) { tr_item(w_out + (size_t)l * MIXW * DM, MIXW, DM, woutT + (size_t)l * DM * MIXW, scr, r, lane, false); return; } r -= CONV_I_OUT;
    tr_item(w_mem_kv + (size_t)l * DM * 1024, DM, 1024, wmemT + (size_t)l * 1024 * DM, scr, r, lane, false);
}
__device__ __forceinline__ void xg_row(const float* xrow, const float* g, hf* oh, float* ssp, int lane) {
    f32x4 v[8]; float ss = 0.f;
#pragma unroll
    for (int j = 0; j < 8; ++j) { v[j] = __builtin_nontemporal_load((const f32x4*)(xrow + 4 * (lane + 64 * j))); ss += v[j][0] * v[j][0] + v[j][1] * v[j][1] + v[j][2] * v[j][2] + v[j][3] * v[j][3]; }
    ss = wave_sum(ss, lane);
#pragma unroll
    for (int j = 0; j < 8; ++j) { (void)g; *(h4*)(oh + 4 * (lane + 64 * j)) = __builtin_convertvector(v[j], h4); }
    if (lane < 8) ssp[lane] = lane == 0 ? ss : 0.f;
}
__device__ const double ROPE_REV[64] = {0.15915494309189535,0.13782250260398285,0.11934937021124886,0.10335229661843406,0.08949940160889101,0.07750328875537406,0.06711508300522726,0.058119267441876246,0.050329212104487035,0.04358330210530733,0.03774158471741977,0.032682865872357,0.0283021958306234,0.024508691862069852,0.02122365276477766,0.018378926105679667,0.015915494309189534,0.013782250260398284,0.011934937021124886,0.010335229661843406,0.008949940160889102,0.0077503288755374055,0.006711508300522725,0.005811926744187624,0.005032921210448704,0.004358330210530733,0.003774158471741977,0.0032682865872356993,0.00283021958306234,0.002450869186206985,0.0021223652764777662,0.0018378926105679667,0.0015915494309189536,0.0013782250260398288,0.0011934937021124885,0.0010335229661843405,0.0008949940160889102,0.0007750328875537405,0.0006711508300522726,0.0005811926744187624,0.0005032921210448703,0.0004358330210530733,0.00037741584717419774,0.0003268286587235699,0.00028302195830623395,0.00024508691862069854,0.0002122365276477766,0.00018378926105679666,0.00015915494309189535,0.00013782250260398286,0.00011934937021124886,0.00010335229661843406,8.949940160889102e-05,7.750328875537406e-05,6.711508300522725e-05,5.811926744187624e-05,5.0329212104487035e-05,4.358330210530732e-05,3.774158471741978e-05,3.2682865872357e-05,2.8302195830623396e-05,2.4508691862069852e-05,2.122365276477766e-05,1.8378926105679668e-05};
__device__ __forceinline__ void phase_prologue(LAS unsigned char* lds) {
    KA_BEGIN();
    const float* x = ka->in[0]; const float* mem = ka->in[1]; const float* norm_g = ka->in[2]; const float* w_in = ka->in[3];
    const float* sgu_w = ka->in[4]; const float* mem_norm_g = ka->in[9]; const float* w_mem_kv = ka->in[10]; const float* w_out = ka->in[12];
    float* cosT = (float*)(ws + WS_ROPE); float* sinT = cosT + SEQ * 64;
    hf* sguw = (hf*)(ws + WS_SGUW); float* sgurs = (float*)(ws + WS_SGUW + 512 * 1024);
    hf* memn = (hf*)(ws + WS_MEMN); hf* wmemT = (hf*)(ws + WS_WMEMT); hf* woutT = (hf*)(ws + WS_WOUTT); hf* winT = (hf*)(ws + WS_WINT); hf* xn = (hf*)(ws + WS_XN);
    LAS float* scr = (LAS float*)(lds + wave * 16384);
    {
        int tid_c = wave * 64 + lane;
        LAS float* t129 = (LAS float*)lds;
        f32x4 va[8], vb[8];
        int it = blockIdx.x;
        ConvDesc da = ctile_decode(it < 2 * CT_ALL ? it : 0, w_in, w_out, w_mem_kv, winT, woutT, wmemT, norm_g), db = da;
        if (it < 2 * CT_ALL) ctile_load(va, da, tid_c);
        while (it < 2 * CT_ALL) {
            const int it1 = it + G;
            if (it1 < 2 * CT_ALL) { db = ctile_decode(it1, w_in, w_out, w_mem_kv, winT, woutT, wmemT, norm_g); ctile_load(vb, db, tid_c); }
            ctile_store(va, da, t129, tid_c);
            const int it2 = it1 + G;
            if (it2 < 2 * CT_ALL) { da = ctile_decode(it2, w_in, w_out, w_mem_kv, winT, woutT, wmemT, norm_g); ctile_load(va, da, tid_c); }
            if (it1 < 2 * CT_ALL) ctile_store(vb, db, t129, tid_c);
            it = it2;
        }
    }
    for (int e = blockIdx.x * 512 + wave * 64 + lane; e < SEQ * 64; e += G * 512) {
        const int t = e >> 6, i = e & 63;
        const double rev = (double)t * ROPE_REV[i];
        const float f = (float)(rev - floor(rev));
        cosT[e] = __builtin_amdgcn_cosf(f); sinT[e] = __builtin_amdgcn_sinf(f);
    }
    for (int rw = gw; rw < 2 * 4 * 128; rw += NGW) {
        const int i = rw & 127; const float* wr_ = sgu_w + (size_t)rw * 128; float s = 0.f;
#pragma unroll
        for (int k = 0; k < 2; ++k) { const int j = lane + 64 * k; const float w = (j <= i) ? wr_[j] : 0.f; s += w; sguw[(size_t)rw * 128 + j] = (hf)w; }
        s = wave_sum(s, lane); if (lane == 0) sgurs[rw] = s;
    }
    for (int m = gw; m < NTOK; m += NGW) xg_row(x + (size_t)m * DM, norm_g, xn + (size_t)m * DM, (float*)(ws + WS_ROWSS) + (size_t)m * 8, lane);
    for (int m = gw; m < 2 * 512; m += NGW) { const int l = m >> 9, r = m & 511; rms_row(mem + (size_t)r * DM, mem_norm_g + l * DM, memn + (size_t)m * DM, nullptr, lane); }
}

__device__ __forceinline__ void phase_proj(LAS unsigned char* lds, int L) {
    {
        KA_BEGIN();
        pg8::Gemm g{(const hf*)(ws + WS_XN), (const hf*)(ws + WS_WINT) + (size_t)L * NCOL * DM, NTOK, PROJ_N1, DM}; pg8::StaticOrder S; S.init(NTOK, PROJ_N1, G, (int)blockIdx.x);
        float* cosT = (float*)(ws + WS_ROPE);
        pg8::EpiProj E{(hf*)(ws + WS_PROJ), cosT, cosT + SEQ * 64, (float*)(ws + WS_KPART), (f32x2*)(ws + WS_VSTAT), (const float*)(ws + WS_ROWSS), (hf*)(ws + WS_HM)};
        pg8::gemm_phase<pg8::EpiProj, pg8::StaticOrder, true, true>(lds, g, S, E);
    }
}

__device__ __forceinline__ void memkv_tile(int tl, LAS unsigned char* lds) {
    KA_BEGIN();
    const hf* memn = (const hf*)(ws + WS_MEMN); const hf* wmemT = (const hf*)(ws + WS_WMEMT); hf* kvmem = (hf*)(ws + WS_KVMEM);
    const int l = tl >> 7, r = tl & 127, mt = r >> 4, nt = r & 15, m0 = mt * 64, n0 = nt * 64;
    const hf* ap = memn + ((size_t)l * 512 + m0 + fr) * DM + wave * 256 + 8 * quad;
    const hf* bp = wmemT + ((size_t)l * 1024 + n0 + fr) * DM + wave * 256 + 8 * quad;
    f32x4 c[4][4];
#pragma unroll
    for (int ni = 0; ni < 4; ++ni)
#pragma unroll
        for (int mi = 0; mi < 4; ++mi) c[ni][mi] = (f32x4){0.f, 0.f, 0.f, 0.f};
#pragma unroll 2
    for (int kk = 0; kk < 8; ++kk) {
        h8 av[4], bv[4];
#pragma unroll
        for (int i = 0; i < 4; ++i) { av[i] = *(const h8*)(ap + (size_t)(16 * i) * DM + 32 * kk); bv[i] = *(const h8*)(bp + (size_t)(16 * i) * DM + 32 * kk); }
#pragma unroll
        for (int ni = 0; ni < 4; ++ni)
#pragma unroll
            for (int mi = 0; mi < 4; ++mi) c[ni][mi] = __builtin_amdgcn_mfma_f32_16x16x32_f16(bv[ni], av[mi], c[ni][mi], 0, 0, 0);
    }
    LAS float* red = (LAS float*)lds + wave * 4096;
#pragma unroll
    for (int ni = 0; ni < 4; ++ni)
#pragma unroll
        for (int mi = 0; mi < 4; ++mi) *(LAS f32x4*)(red + (16 * mi + fr) * 64 + 16 * ni + 4 * quad) = c[ni][mi];
    __syncthreads();
    { const int t = wave * 64 + lane, m = t >> 3, n8 = (t & 7) * 8;
      f32x4 s0 = (f32x4){0.f, 0.f, 0.f, 0.f}, s1 = s0;
#pragma unroll
      for (int w = 0; w < 8; ++w) { const LAS float* p = (const LAS float*)lds + w * 4096 + m * 64 + n8; s0 += *(const LAS f32x4*)p; s1 += *(const LAS f32x4*)(p + 4); }
      const h8 hv = pack8(s0, s1); const unsigned long long* q2 = (const unsigned long long*)&hv; unsigned long long* dst = (unsigned long long*)(kvmem + ((size_t)l * 512 + m0 + m) * 1024 + n0 + n8);
      __hip_atomic_store(dst, q2[0], __ATOMIC_RELAXED, __HIP_MEMORY_SCOPE_AGENT); __hip_atomic_store(dst + 1, q2[1], __ATOMIC_RELAXED, __HIP_MEMORY_SCOPE_AGENT); }
    asm volatile("s_waitcnt vmcnt(0)" ::: "memory");
    __syncthreads();
    if (threadIdx.x == 0) __hip_atomic_fetch_add((unsigned*)(ws + WS_CTL) + CW_BAR + 48, 1u, __ATOMIC_RELAXED, __HIP_MEMORY_SCOPE_AGENT);
}

__device__ __forceinline__ void moba_gate_item(int g, unsigned char* ws, int L, LAS unsigned char* lds) {
    int tid = threadIdx.x; asm volatile("" : "+v"(tid));
    const int wid = __builtin_amdgcn_readfirstlane(tid >> 6), lane = tid & 63, r32 = lane & 31, hi = lane >> 5;
    const int bh = g & 7, qblk = g >> 3, b = bh >> 2, h = bh & 3;
    const int pos = qblk * 256 + wid * 32 + r32;
    float* lsec = (float*)(ws + WS_LSE + MiB) + ((size_t)b * SEQ) * 4 + h;
    {
        if (tid < 256) for (int s = (qblk < 3 ? qblk : 3); s < 3; ++s) __hip_atomic_store(&lsec[((size_t)s * NTOK + qblk * 256 + tid) * 4], -1e30f, __ATOMIC_RELAXED, __HIP_MEMORY_SCOPE_AGENT);
    }
    if (qblk > 0) {
        const hf* Q = (const hf*)(ws + WS_HM) + 3 * (size_t)NTOK * GW + ((size_t)(b * 4 + h) * SEQ + pos) * 128;
        h8 qr[8];
#pragma unroll
        for (int d0 = 0; d0 < 8; ++d0) qr[d0] = *(const h8*)(Q + d0 * 16 + hi * 8);
        const float* ksum = (const float*)(ws + WS_KPART) + (size_t)(b * 16 * 2) * GW + h * 128;
        LAS float* ksl = (LAS float*)(lds + att::LDS_KSUM);
        { const int n = tid >> 5, d4 = (tid & 31) * 4;
          if (n < qblk) { const float* kp = ksum + (size_t)(n * 2) * GW + d4; *(LAS f32x4*)(ksl + n * 128 + d4) = *(const f32x4*)kp + *(const f32x4*)(kp + GW); } }
        __syncthreads();
        float v1 = -3e38f, v2 = -3e38f, v3 = -3e38f; int i1 = -1, i2 = -1, i3 = -1;
        for (int n = 0; n < qblk; ++n) {
            const LAS float* kr = ksl + n * 128 + hi * 8; float dv = 0.f;
#pragma unroll
            for (int d0 = 0; d0 < 8; ++d0) { const f32x4 ka = *(const LAS f32x4*)(kr + d0 * 16), kb = *(const LAS f32x4*)(kr + d0 * 16 + 4);
#pragma unroll
                for (int i = 0; i < 4; ++i) dv += (float)qr[d0][i] * ka[i] + (float)qr[d0][4 + i] * kb[i]; }
            dv += shx_l(dv, lane, 32);
            if (dv > v1) { v3 = v2; i3 = i2; v2 = v1; i2 = i1; v1 = dv; i1 = n; }
            else if (dv > v2) { v3 = v2; i3 = i2; v2 = dv; i2 = n; }
            else if (dv > v3) { v3 = dv; i3 = n; }
        }
        const unsigned sel = (i1 >= 0 ? 1u << i1 : 0u) | (i2 >= 0 ? 1u << i2 : 0u) | (i3 >= 0 ? 1u << i3 : 0u);
        unsigned* cnt = (unsigned*)(ws + WS_CTL) + CW_CNT + L * 128 + bh * 16;
        unsigned* list = (unsigned*)(ws + WS_LIST) + (size_t)bh * 16 * SEQ;
        for (int n = 0; n < qblk; ++n) {
            const bool pred = (hi == 0) && (((sel >> n) & 1u) != 0u);
            const unsigned long long m = __ballot(pred);
            if (m != 0ull) {
                const int leader = __ffsll((unsigned long long)m) - 1;
                unsigned base = 0u;
                if (lane == leader) base = __hip_atomic_fetch_add(cnt + n, (unsigned)__popcll(m), __ATOMIC_RELAXED, __HIP_MEMORY_SCOPE_AGENT);
                base = (unsigned)__builtin_amdgcn_readlane((int)base, leader);
                if (pred) { const unsigned off = (unsigned)__popcll(m & ((1ull << lane) - 1ull)); const unsigned slot = (unsigned)__popc(sel & ((1u << n) - 1u));
                    __hip_atomic_store(&list[(size_t)n * SEQ + base + off], (unsigned)pos | (slot << 16), __ATOMIC_RELAXED, __HIP_MEMORY_SCOPE_AGENT); }
            }
        }
    }
    asm volatile("s_waitcnt vmcnt(0)" ::: "memory");
    __syncthreads();
    if (tid == 0) __hip_atomic_fetch_add((unsigned*)(ws + WS_CTL) + CW_BAR + 32 + 64 * L, 1u, __ATOMIC_RELAXED, __HIP_MEMORY_SCOPE_AGENT);
}

constexpr int NI_G = 64, NI_K = 256, NI_M = 128, NI_C = 128, NI_A = 3 * 8 * 16, NI_X = 8 * 16, NI_B = N_B / 8;
constexpr int LDS_Q_OFF = 131072 + 64;
constexpr int LDS_GTAB = att::LDS_KSUM;
__device__ __forceinline__ att::BlkRef mix_decode(int Li, unsigned char* ws, int L) {
    const hf* hm = (const hf*)(ws + WS_HM); constexpr long HMS = (long)NTOK * GW;
    att::BlkRef r;
    r.list = nullptr; r.cnt = 0;
    if (Li < NI_C) {
        const int bh = Li & 7, qblk = 15 - (Li >> 3), b = bh >> 2, h = bh & 3;
        const long row0 = (long)b * SEQ + qblk * 256, hrow = (long)(b * 4 + h) * SEQ;
        r.Q = hm + 3 * HMS + (hrow + qblk * 256) * 128; r.qs = 128;
        r.K = hm + 4 * HMS + hrow * 128; r.V = hm + 5 * HMS + hrow * 128; r.ks = 128;
        r.O = (hf*)(ws + WS_OCP) + ((long)3 * NTOK + row0) * GW + h * 128; r.os = GW;
        r.LSE = (float*)(ws + WS_LSE + MiB) + ((long)3 * NTOK + row0) * 4 + h; r.ls = 4;
        r.P0 = qblk * 256; r.W = 1 << 30; r.j_lo = qblk * 4; r.j_hi = qblk * 4 + 4;
    } else if (Li < NI_C + NI_A) {
        const int i = Li - NI_C, p = i >> 7, rr = i & 127, b = rr >> 6, h = (rr >> 4) & 3, slot = rr & 15;
        const int dsh = 2 * p, d = 1 << dsh, bpr = 16 >> dsh, res = slot / bpr, blk = slot % bpr, l0 = 256 * blk, Lsub = SEQ >> dsh;
        const long rowb = (long)b * SEQ + res, q0 = rowb + (long)l0 * d, hrow = (long)(b * 4 + h) * SEQ + res;
        r.Q = hm + 0 * HMS + (hrow + (long)l0 * d) * 128; r.qs = d * 128;
        r.K = hm + 1 * HMS + hrow * 128; r.V = hm + 2 * HMS + hrow * 128; r.ks = d * 128;
        r.O = (hf*)(ws + WS_OA) + ((long)p * NTOK + q0) * GW + h * 128; r.os = d * GW;
        r.LSE = (float*)(ws + WS_LSE) + ((long)p * NTOK + q0) * 4 + h; r.ls = d * 4;
        r.P0 = l0; r.W = 129; r.j_lo = (l0 >= 128) ? (l0 - 128) / 64 : 0; r.j_hi = (l0 + 255) / 64 + 1; if (r.j_hi > Lsub / 64) r.j_hi = Lsub / 64;
    } else {
        const int i = Li - NI_C - NI_A, b = i >> 6, h = (i >> 4) & 3, blk = i & 15;
        const long row0 = (long)b * SEQ + 256 * blk;
        const hf* kv = (const hf*)(ws + WS_KVMEM) + (size_t)L * 512 * 1024 + (long)b * NMEM * 1024 + h * 128;
        r.Q = hm + 6 * HMS + ((long)(b * 4 + h) * SEQ + 256 * blk) * 128; r.qs = 128;
        r.K = kv; r.V = kv + GW; r.ks = 1024;
        r.O = (hf*)(ws + WS_OX) + row0 * GW + h * 128; r.os = GW; r.LSE = nullptr; r.ls = 0;
        r.P0 = 1 << 20; r.W = 1 << 30; r.j_lo = 0; r.j_hi = 4;
    }
    return r;
}
__device__ __forceinline__ att::BlkRef gather_decode(int gi, unsigned char* ws, int L, const LAS int* tab) {
    int k = 0;
#pragma unroll 1
    for (int s = 64; s > 0; s >>= 1) if (tab[k + s] <= gi) k += s;
    const int chunk = gi - tab[k], bh = k >> 4, n = k & 15, b = bh >> 2, h = bh & 3;
    const hf* hm = (const hf*)(ws + WS_HM); constexpr long HMS = (long)NTOK * GW;
    const long hrow = (long)(b * 4 + h) * SEQ;
    const unsigned total = __hip_atomic_load((unsigned*)(ws + WS_CTL) + CW_CNT + L * 128 + k, __ATOMIC_RELAXED, __HIP_MEMORY_SCOPE_AGENT);
    att::BlkRef r;
    r.list = (const unsigned*)(ws + WS_LIST) + (size_t)k * SEQ + chunk * 256; r.cnt = (int)total - chunk * 256; if (r.cnt > 256) r.cnt = 256;
    r.Q = hm + 3 * HMS + hrow * 128; r.qs = 128;
    r.K = hm + 4 * HMS + hrow * 128; r.V = hm + 5 * HMS + hrow * 128; r.ks = 128;
    r.O = (hf*)(ws + WS_OCP) + ((long)b * SEQ) * GW + h * 128; r.os = GW;
    r.LSE = (float*)(ws + WS_LSE + MiB) + ((long)b * SEQ) * 4 + h; r.ls = 4;
    r.P0 = 1 << 20; r.W = 1 << 30; r.j_lo = n * 4; r.j_hi = n * 4 + 4;
    return r;
}
__device__ __forceinline__ att::NxtRef nxt_of(const att::BlkRef& n2) { att::NxtRef nx; nx.Q = n2.Q; nx.K = n2.K; nx.V = n2.V; nx.list = n2.list; nx.qs = n2.qs; nx.ks = n2.ks; nx.j_lo = n2.j_lo; nx.cnt = n2.cnt; return nx; }
__device__ __forceinline__ int wg_dequeue(unsigned* ctr, LAS unsigned char* lds, int base) {
    volatile LAS int* qw = (volatile LAS int*)(lds + LDS_Q_OFF);
    if (threadIdx.x == 0) qw[0] = base + (int)__hip_atomic_fetch_add(ctr, 1u, __ATOMIC_RELAXED, __HIP_MEMORY_SCOPE_AGENT);
    __syncthreads();
    const int v = qw[0];
    __syncthreads();
    return __builtin_amdgcn_readfirstlane(v);
}
__device__ __forceinline__ void phase_mix(LAS unsigned char* lds, int L) {
    const CAS Args* ka0 = (const CAS Args*)__builtin_amdgcn_kernarg_segment_ptr(); asm volatile("" : "+s"(ka0));
    const int Gq = gridDim.x;
    unsigned* qctr = (unsigned*)(ka0->ws + WS_CTL) + CW_BAR + 64 * L;
    unsigned* gdone = (unsigned*)(ka0->ws + WS_CTL) + CW_BAR + 32 + 64 * L;
    unsigned* kdone = (unsigned*)(ka0->ws + WS_CTL) + CW_BAR + 48;
    const int Q_M0 = NI_G, Q_C0 = Q_M0 + NI_M, Q_K0 = Q_C0 + NI_C, Q_A0 = Q_K0 + (L == 0 ? NI_K : 0), Q_DYN = Q_A0 + NI_A;
    const int QBASE = 2 * Gq - NI_G;
    LAS int* tab = (LAS int*)(lds + LDS_GTAB);
    bool tabok = false; int GT = 0;
    int L0 = blockIdx.x, L1 = ((int)blockIdx.x >= NI_G) ? (int)blockIdx.x + Gq - NI_G : -1;
    unsigned char* ws = ka0->ws;
#define IS_ATT(i) (((i) >= Q_C0 && (i) < Q_K0) || ((i) >= Q_A0 && (i) < Q_DYN) || (tabok && (i) >= Q_DYN && (i) < Q_DYN + GT + NI_X))
#define ATT_DECODE(i) ((i) < Q_K0 ? mix_decode((i) - Q_C0, ws, L) : ((i) < Q_DYN ? mix_decode(NI_C + (i) - Q_A0, ws, L) : \
                       ((i) < Q_DYN + GT ? gather_decode((i) - Q_DYN, ws, L, tab) : mix_decode(NI_C + NI_A + (i) - Q_DYN - GT, ws, L))))
    for (;;) {
        if (L0 >= Q_DYN && !tabok) {
            __syncthreads();
            if (threadIdx.x == 0) { unsigned sp = 0u;
                while (__hip_atomic_load(gdone, __ATOMIC_RELAXED, __HIP_MEMORY_SCOPE_AGENT) < (unsigned)NI_M || __hip_atomic_load(kdone, __ATOMIC_RELAXED, __HIP_MEMORY_SCOPE_AGENT) < (unsigned)NI_K) { __builtin_amdgcn_s_sleep(2); if (++sp > (1u << 22)) break; }
                __builtin_amdgcn_fence(__ATOMIC_ACQUIRE, "agent"); asm volatile("s_waitcnt vmcnt(0)" ::: "memory"); }
            __syncthreads();
            {
                int tid_s = threadIdx.x; asm volatile("" : "+v"(tid_s));
                LAS int* cl = tab + 160;
                if (tid_s < 128) cl[tid_s] = ((int)__hip_atomic_load((unsigned*)(ws + WS_CTL) + CW_CNT + L * 128 + tid_s, __ATOMIC_RELAXED, __HIP_MEMORY_SCOPE_AGENT) + 255) >> 8;
                __syncthreads();
                if (tid_s <= 128) { int s = 0; for (int k = 0; k < tid_s; ++k) s += cl[k]; tab[tid_s] = s; }
            }
            __syncthreads();
            GT = tab[128]; tabok = true;
        }
        if (tabok && L0 >= Q_DYN + GT + NI_X + NI_B) break;
        if (L0 < Q_M0) {
            {
                KA_BEGIN();
                pg8::Gemm g{(const hf*)(ws + WS_XN), (const hf*)(ws + WS_WINT) + (size_t)L * NCOL * DM, NTOK, NCOL, DM};
                pg8::OneUnit S{L0 & 31, (PROJ_N1 / 256) + (L0 >> 5)};
                float* cosT = (float*)(ws + WS_ROPE);
                pg8::EpiProj E{(hf*)(ws + WS_PROJ), cosT, cosT + SEQ * 64, (float*)(ws + WS_KPART), (f32x2*)(ws + WS_VSTAT), (const float*)(ws + WS_ROWSS), (hf*)(ws + WS_HM)};
                pg8::gemm_phase<pg8::EpiProj, pg8::OneUnit, true, true>(lds, g, S, E);
            }
            L0 = wg_dequeue(qctr, lds, QBASE); L1 = wg_dequeue(qctr, lds, QBASE);
        } else if (L0 < Q_C0) {
            moba_gate_item(L0 - Q_M0, ws, L, lds);
            L0 = L1; L1 = wg_dequeue(qctr, lds, QBASE);
        } else if (L0 >= Q_K0 && L0 < Q_A0) {
            memkv_tile(L0 - Q_K0, lds);
            L0 = L1; L1 = wg_dequeue(qctr, lds, QBASE);
        } else if (tabok && L0 >= Q_DYN + GT + NI_X) {
            KA_BEGIN();
            MixP P{(const hf*)(ws + WS_PROJ), (const hf*)(ws + WS_KVMEM) + (size_t)L * 512 * 1024, (hf*)(ws + WS_OA), (float*)(ws + WS_LSE), (hf*)(ws + WS_OB), (hf*)(ws + WS_OCP),
                   (float*)(ws + WS_LSE + MiB), (hf*)(ws + WS_OX), (const float*)(ws + WS_KPART), (const f32x2*)(ws + WS_VSTAT), (const hf*)(ws + WS_SGUW) + (size_t)L * 4 * 128 * 128,
                   (const float*)(ws + WS_SGUW + 512 * 1024) + L * 512, ka->in[5] + L * 512, ka->in[6] + L * GW, ka->in[7] + L * GW};
            const int it = (L0 - (Q_DYN + GT + NI_X)) * 8 + wave;
            const int itx = ((it & 7) << 8) | (it >> 3);
            item_B(P, itx, lds + wave * WAVE_LDS, lane, fr, quad);
            L0 = L1; L1 = wg_dequeue(qctr, lds, QBASE);
        } else {
            att::Seam S;
            { const att::BlkRef c0 = ATT_DECODE(L0); att::blk_prime(c0, (LAS char*)lds, S); }
            for (;;) {
                const bool more = IS_ATT(L1);
                unsigned tk = 0u;
                if (threadIdx.x == 0) tk = __hip_atomic_fetch_add(qctr, 1u, __ATOMIC_RELAXED, __HIP_MEMORY_SCOPE_AGENT);
                const att::BlkRef cur = ATT_DECODE(L0);
                const int Ln = more ? L1 : L0;
                const att::NxtRef nx = nxt_of(ATT_DECODE(Ln));
                volatile LAS int* qw = (volatile LAS int*)(lds + LDS_Q_OFF);
                att::blk_run(cur, nx, (LAS char*)lds, S, tk, qw, QBASE);
                const int L2 = __builtin_amdgcn_readfirstlane(qw[0]);
                L0 = L1; L1 = L2;
                if (!more) break;
            }
            asm volatile("s_waitcnt vmcnt(0)" ::: "memory");
            __syncthreads();
        }
    }
#undef IS_ATT
#undef ATT_DECODE
}

__device__ __forceinline__ void phase_finalize(int L) {
    KA_BEGIN();
    const hf* proj = (const hf*)(ws + WS_PROJ); const hf* oa = (const hf*)(ws + WS_OA); const hf* ob = (const hf*)(ws + WS_OB); const hf* ocp = (const hf*)(ws + WS_OCP); const hf* ox = (const hf*)(ws + WS_OX);
    const float* lsea = (const float*)(ws + WS_LSE); const float* lsec = (const float*)(ws + WS_LSE + MiB); hf* yb = (hf*)(ws + WS_Y);
    const float* cw = ka->in[8] + (size_t)L * 3 * GW; const float* ong = ka->in[11] + (size_t)L * MIXW;
    f32x4 ogv[5][2];
#pragma unroll
    for (int gq = 0; gq < 5; ++gq) { ogv[gq][0] = *(const f32x4*)(ong + gq * GW + 8 * lane); ogv[gq][1] = *(const f32x4*)(ong + gq * GW + 8 * lane + 4); }
    for (int t = gw; t < NTOK; t += NGW) {
        const int pos = t & (SEQ - 1), hd = lane >> 4, c8 = 8 * lane;
        const hf* prow = proj + (size_t)t * NCOL;
        float u[5][8];
        {
            float ls[3], mx = -3e38f;
#pragma unroll
            for (int p = 0; p < 3; ++p) { ls[p] = lsea[((size_t)p * NTOK + t) * 4 + hd]; mx = fmaxf(mx, ls[p]); }
            float wsum = 0.f, acc[8] = {0, 0, 0, 0, 0, 0, 0, 0};
#pragma unroll
            for (int p = 0; p < 3; ++p) { const float w = __builtin_amdgcn_exp2f(ls[p] - mx); wsum += w; const h8 o = __builtin_nontemporal_load((const h8*)(oa + ((size_t)p * NTOK + t) * GW + c8));
#pragma unroll
                for (int i = 0; i < 8; ++i) acc[i] += w * (float)o[i]; }
            const float inv = 1.0f / wsum; const h8 gt = __builtin_nontemporal_load((const h8*)(prow + SL_AG * GW + c8));
#pragma unroll
            for (int i = 0; i < 8; ++i) u[0][i] = acc[i] * inv * (float)gt[i];
        }
        {
            const h8 o = __builtin_nontemporal_load((const h8*)(ob + (size_t)t * GW + c8));
#pragma unroll
            for (int i = 0; i < 8; ++i) u[1][i] = (float)o[i];
        }
        {
            float ls[4], mx = -3e38f;
#pragma unroll
            for (int p = 0; p < 4; ++p) { ls[p] = lsec[((size_t)p * NTOK + t) * 4 + hd]; mx = fmaxf(mx, ls[p]); }
            float wsum = 0.f, acc[8] = {0, 0, 0, 0, 0, 0, 0, 0};
#pragma unroll
            for (int p = 0; p < 4; ++p) if (ls[p] > -1e29f) { const float w = __builtin_amdgcn_exp2f(ls[p] - mx); wsum += w; const h8 o = __builtin_nontemporal_load((const h8*)(ocp + ((size_t)p * NTOK + t) * GW + c8));
#pragma unroll
                for (int i = 0; i < 8; ++i) acc[i] += w * (float)o[i]; }
            const float inv = 1.0f / wsum; const h8 gt = __builtin_nontemporal_load((const h8*)(prow + SL_CG * GW + c8));
#pragma unroll
            for (int i = 0; i < 8; ++i) u[2][i] = acc[i] * inv * (float)gt[i];
        }
        {
            float y[8] = {0, 0, 0, 0, 0, 0, 0, 0};
#pragma unroll
            for (int k = 0; k < 3; ++k) { const int back = 2 - k;
                if (pos - back >= 0) { const hf* pr = prow - (size_t)back * NCOL; const h8 z = *(const h8*)(pr + SL_DC * GW + c8);
                    const f32x4 w0 = *(const f32x4*)(cw + k * GW + c8), w1 = *(const f32x4*)(cw + k * GW + c8 + 4);
#pragma unroll
                    for (int i = 0; i < 4; ++i) { y[i] += w0[i] * (float)z[i]; y[4 + i] += w1[i] * (float)z[4 + i]; } } }
            const h8 dbg = __builtin_nontemporal_load((const h8*)(prow + SL_DB * GW + c8));
#pragma unroll
            for (int i = 0; i < 8; ++i) u[3][i] = (float)dbg[i] * y[i];
        }
        {
            const h8 o = __builtin_nontemporal_load((const h8*)(ox + (size_t)t * GW + c8)), gt = __builtin_nontemporal_load((const h8*)(prow + SL_XG * GW + c8));
#pragma unroll
            for (int i = 0; i < 8; ++i) u[4][i] = (float)o[i] * (float)gt[i];
        }
        float ssv[5];
#pragma unroll
        for (int gq = 0; gq < 5; ++gq) { float ss = 0.f;
#pragma unroll
            for (int i = 0; i < 8; ++i) ss += u[gq][i] * u[gq][i];
            ssv[gq] = ss; }
#pragma unroll
        for (int o_ = 1; o_ < 64; o_ <<= 1) {
            float tv[5];
#pragma unroll
            for (int gq = 0; gq < 5; ++gq) tv[gq] = shx_l(ssv[gq], lane, o_);
#pragma unroll
            for (int gq = 0; gq < 5; ++gq) ssv[gq] += tv[gq];
        }
#pragma unroll
        for (int gq = 0; gq < 5; ++gq) {
            const float r = __builtin_amdgcn_rsqf(ssv[gq] * (1.0f / GW) + NORM_EPS);
            const f32x4 g0 = ogv[gq][0], g1 = ogv[gq][1];
            f32x4 o0, o1;
#pragma unroll
            for (int i = 0; i < 4; ++i) { o0[i] = u[gq][i] * r * g0[i]; o1[i] = u[gq][4 + i] * r * g1[i]; }
            if (F8_OUT) *(u32x2*)((unsigned char*)yb + (size_t)t * MIXW + gq * GW + c8) = pk8_f8(o0 * A8_SCALE, o1 * A8_SCALE);
            else *(h8*)(yb + (size_t)t * MIXW + gq * GW + c8) = pack8(o0, o1);
        }
    }
}

__device__ __forceinline__ void phase_out(LAS unsigned char* lds, int L) {
    KA_BEGIN();
    float* x1 = (float*)(ws + WS_X1);
    pg8::Gemm g{ws + WS_Y, ws + WS_WOUTT + (size_t)L * DM * MIXW * (F8_OUT ? 1 : 2), NTOK, DM, MIXW}; pg8::StaticOrder S; S.init(NTOK, DM, G, (int)blockIdx.x);
    pg8::EpiRes E{L == 0 ? ka->in[0] : (const float*)nullptr, (const hf*)(ws + WS_XN), L == 0 ? (hf*)(ws + WS_XN) : (hf*)x1, (float*)(ws + WS_ROWSS),
                  L == 0 ? (float*)nullptr : ka->out, ka->in[13], (unsigned*)(ws + WS_CTL) + CW_CNT + 256};
    pg8::gemm_phase<pg8::EpiRes, pg8::StaticOrder, true, true, F8_OUT != 0>(lds, g, S, E);
}
__device__ __forceinline__ void phase_norm_mid() {
    KA_BEGIN();
    const float* x1 = (const float*)(ws + WS_X1); hf* xn = (hf*)(ws + WS_XN); const float* g1 = ka->in[2] + DM;
    for (int m = gw; m < NTOK; m += NGW) rms_row(x1 + (size_t)m * DM, g1, xn + (size_t)m * DM, nullptr, lane);
}
__device__ __forceinline__ void phase_norm_final() {
    KA_BEGIN();
    float* out = ka->out; const float* gf = ka->in[13]; const hf* x2 = (const hf*)(ws + WS_X1); const float* rowss = (const float*)(ws + WS_ROWSS);
    for (int m = gw; m < NTOK; m += NGW) {
        const f32x4 pa = *(const f32x4*)(rowss + (size_t)m * 8), pb = *(const f32x4*)(rowss + (size_t)m * 8 + 4);
        const float r = __builtin_amdgcn_rsqf(((pa[0] + pa[1]) + (pa[2] + pa[3]) + (pb[0] + pb[1]) + (pb[2] + pb[3])) * (1.0f / DM) + NORM_EPS);
#pragma unroll
        for (int j = 0; j < 4; ++j) { const int c = 8 * (lane + 64 * j); const h8 v = *(const h8*)(x2 + (size_t)m * DM + c);
            const f32x4 g0 = *(const f32x4*)(gf + c), g1 = *(const f32x4*)(gf + c + 4); f32x4 o0, o1;
#pragma unroll
            for (int i = 0; i < 4; ++i) { o0[i] = (float)v[i] * r * g0[i]; o1[i] = (float)v[4 + i] * r * g1[i]; }
            *(f32x4*)(out + (size_t)m * DM + c) = o0; *(f32x4*)(out + (size_t)m * DM + c + 4) = o1; }
    }
}


#define XB_TMO      128
#define XB_XCNT(j)  (256  + 64 * (j))
#define XB_XSUB(j)  (1280 + 64 * (j))
#define XB_XGEN(j)  (2304 + 64 * (j))
#define XB_TOP      3328
#define XB_TOPGEN   3392
#define XCD_BAR_WORDS 3456
#define XB_SPIN_CAP (1u << 18)
__device__ __forceinline__ unsigned xb_ld(unsigned* p)              { return __hip_atomic_load(p, __ATOMIC_RELAXED, __HIP_MEMORY_SCOPE_AGENT); }
__device__ __forceinline__ unsigned xb_add(unsigned* p, unsigned v) { return __hip_atomic_fetch_add(p, v, __ATOMIC_RELAXED, __HIP_MEMORY_SCOPE_AGENT); }
__device__ __forceinline__ unsigned xb_xcc_id() { return (unsigned)__builtin_amdgcn_s_getreg((3 << 11) | 20) & 0xFu; }
#define XB_SPIN(cond, bar) do { unsigned _sp = 0; while (cond) { __builtin_amdgcn_s_sleep(1); \
    if ((++_sp & 255u) == 0u) { if (xb_ld(&(bar)[XB_TMO])) break; if (_sp > XB_SPIN_CAP) { atomicAdd(&(bar)[XB_TMO], 1u); break; } } } } while (0)
struct XcdBarrier { unsigned* bar; unsigned x; volatile LAS unsigned* st; };
__device__ __forceinline__ XcdBarrier xcd_barrier_post(unsigned* bar, volatile LAS unsigned* st) {
    XcdBarrier b; b.bar = bar; b.x = xb_xcc_id(); b.st = st;
    if (threadIdx.x == 0) (void)xb_add(&bar[XB_XCNT(b.x)], 1u);
    return b;
}
__device__ __forceinline__ void xcd_barrier_complete(unsigned* bar, unsigned x, unsigned& nloc, unsigned& nx) {
    const unsigned G = gridDim.x * gridDim.y * gridDim.z;
    unsigned sum, cnt, mine, sp = 0u;
    for (;;) {
        sum = 0u; cnt = 0u; mine = 0u;
#pragma unroll
        for (unsigned j = 0; j < 16; ++j) { const unsigned c = xb_ld(&bar[XB_XCNT(j)]); sum += c; cnt += (c > 0u) ? 1u : 0u; mine = (j == x) ? c : mine; }
        if (sum == G) break;
        __builtin_amdgcn_s_sleep(1);
        if ((++sp & 255u) == 0u) { if (xb_ld(&bar[XB_TMO])) break; if (sp > XB_SPIN_CAP) { atomicAdd(&bar[XB_TMO], 1u); break; } }
    }
    nloc = mine > 0u ? mine : 1u; nx = cnt > 0u ? cnt : 1u;
}
__device__ __forceinline__ void xcd_barrier(const XcdBarrier& b) {
    asm volatile("s_waitcnt vmcnt(0)" ::: "memory");
    __syncthreads();
    if (threadIdx.x == 0) {
        unsigned* bar = b.bar;
        __builtin_amdgcn_s_waitcnt(0);
        unsigned nloc = b.st[0], nx = b.st[1];
        if (nloc == 0u) { xcd_barrier_complete(bar, b.x, nloc, nx); b.st[0] = nloc; b.st[1] = nx; }
        const unsigned old = xb_add(&bar[XB_XSUB(b.x)], 1u);
        const unsigned gen = old / nloc;
        if (old + 1u == (gen + 1u) * nloc) {
            __builtin_amdgcn_fence(__ATOMIC_RELEASE, "agent");
            asm volatile("s_waitcnt vmcnt(0)" ::: "memory");
            const unsigned og = xb_add(&bar[XB_TOP], 1u);
            const unsigned tg = og / nx;
            if (og + 1u == (tg + 1u) * nx) xb_add(&bar[XB_TOPGEN], 1u);
            else XB_SPIN(xb_ld(&bar[XB_TOPGEN]) == tg, bar);
            __builtin_amdgcn_fence(__ATOMIC_ACQUIRE, "agent");
            xb_add(&bar[XB_XGEN(b.x)], 1u);
            asm volatile("s_waitcnt vmcnt(0)" ::: "memory");
        } else {
            XB_SPIN(xb_ld(&bar[XB_XGEN(b.x)]) == gen, bar);
            __builtin_amdgcn_fence(__ATOMIC_ACQUIRE, "agent");
            asm volatile("s_waitcnt vmcnt(0)" ::: "memory");
        }
    }
    __syncthreads();
}
constexpr int LDS_BAR_OFF = 131072;

__global__ void __launch_bounds__(NWAVES * 64, 2) mk_fwd(Args args) {
    extern __shared__ __attribute__((aligned(16))) unsigned char lds_raw[];
    LAS unsigned char* lds = (LAS unsigned char*)lds_raw;
    const int ph_lo = args.ph_lo, ph_hi = args.ph_hi;
    if (threadIdx.x < 4) ((LAS unsigned*)(lds + LDS_BAR_OFF))[threadIdx.x] = 0u;
    if (COOP && blockIdx.x == 0) { unsigned* bw = (unsigned*)(args.ws + WS_CTL) + 4096; for (int i = threadIdx.x; i < XCD_BAR_WORDS; i += NWAVES * 64) __hip_atomic_store(bw + i, 0u, __ATOMIC_RELAXED, __HIP_MEMORY_SCOPE_AGENT); }
    __syncthreads();
    XcdBarrier xbar; xbar.bar = (unsigned*)(args.ws + WS_CTL) + 4096; xbar.x = 0; xbar.st = (volatile LAS unsigned*)(lds + LDS_BAR_OFF);
    if (!COOP) xbar = xcd_barrier_post(xbar.bar, xbar.st);
    for (int ph = ph_lo; ph < ph_hi; ++ph) {
        if (ph == 10 || ph == 5 || ph == 11) continue;
        int kind = 6;
        if (ph == 0) kind = 0; else if (ph < 11) kind = 1 + (ph - 1) % 5;
        const int nrep = 1 + ((REP_MASK >> kind) & 1);
        for (int rep = 0; rep < nrep; ++rep) {
        if (ph == 0) { if (PH_EN(0)) phase_prologue(lds); }
        else if (ph == 11) { if (PH_EN(6)) phase_norm_final(); }
        else {
            const int L = (ph - 1) / 5, sp = (ph - 1) % 5;
            if (sp == 0) { if (PH_EN(1)) phase_proj(lds, L); }
            else if (sp == 1) { if (PH_EN(2)) phase_mix(lds, L); }
            else if (sp == 2) { if (PH_EN(3)) phase_finalize(L); }
            else if (sp == 3) { if (PH_EN(4)) phase_out(lds, L); }
            else if (L == 0) { if (PH_EN(5)) phase_norm_mid(); }
        }
        __syncthreads();
        }
        if (ph + 1 < ph_hi) { for (int r = 0; r < SYNC_REP; ++r) { if (COOP && (ph == 0 || !XB_USE)) { __syncthreads(); cg::this_grid().sync(); if (ph == 0 && r == 0) xbar = xcd_barrier_post(xbar.bar, xbar.st); } else xcd_barrier(xbar); } }
    }
}

extern "C" void kernel_launch(void* const* d_in, const int* in_sizes, int n_in, void* d_out, int out_size, void* d_ws, size_t ws_size, hipStream_t stream) {
    static int grid = 0;
    if (grid == 0) {
        if (n_in != 14 || out_size != NTOK * DM || ws_size < WS_END) { fprintf(stderr, "kernel_launch: unexpected shapes (n_in %d, out %d, ws %zu)\n", n_in, out_size, ws_size); grid = -1; return; }
        int dev = 0, cus = 0, per_cu = 0;
        hipGetDevice(&dev); hipDeviceGetAttribute(&cus, hipDeviceAttributeMultiprocessorCount, dev);
        if (hipFuncSetAttribute((const void*)mk_fwd, hipFuncAttributeMaxDynamicSharedMemorySize, LDS_BYTES) != hipSuccess) { fprintf(stderr, "kernel_launch: hipFuncSetAttribute failed\n"); grid = -1; return; }
        if (hipOccupancyMaxActiveBlocksPerMultiprocessor(&per_cu, (const void*)mk_fwd, NWAVES * 64, LDS_BYTES) != hipSuccess || per_cu < 1) { fprintf(stderr, "kernel_launch: occupancy query says %d\n", per_cu); per_cu = 1; }
        (void)hipGetLastError();
        grid = cus;
    }
    if (grid < 0) return;
    Args a{};
    for (int i = 0; i < 14; ++i) a.in[i] = (const float*)d_in[i];
    a.out = (float*)d_out; a.ws = (unsigned char*)d_ws;
#if MK_FUSED
    a.ph_lo = 0; a.ph_hi = 10;
#if COOP
    void* kargs[] = {&a};
    hipError_t e = hipLaunchCooperativeKernel((const void*)mk_fwd, dim3(grid), dim3(NWAVES * 64), kargs, LDS_BYTES, stream);
    if (e != hipSuccess) fprintf(stderr, "cooperative launch failed: %s (grid %d)\n", hipGetErrorString(e), grid);
#else
    if (hipMemsetAsync((char*)d_ws + WS_CTL, 0, 65536, stream) != hipSuccess) { fprintf(stderr, "kernel_launch: memset of the control words failed\n"); return; }
    hipLaunchKernelGGL(mk_fwd, dim3(grid), dim3(NWAVES * 64), LDS_BYTES, stream, a);
#endif
#else
    for (int ph = 0; ph < 12; ++ph) {
        if (ph == 10) continue;
        a.ph_lo = ph; a.ph_hi = ph + 1;
        hipLaunchKernelGGL(mk_fwd, dim3(grid), dim3(NWAVES * 64), LDS_BYTES, stream, a);
    }
#endif
}
```

```cpp
#include <hip/hip_runtime.h>
#include <hip/hip_cooperative_groups.h>
#include <cstdio>
#include <cstdint>
namespace cg = cooperative_groups;

#ifndef REP_MASK
#define REP_MASK 0
#endif
#ifndef SYNC_REP
#define SYNC_REP 1
#endif
#define REPS(k) (1 + ((REP_MASK >> (k)) & 1))
#ifndef PH_MASK
#define PH_MASK 0x7f
#endif
#define PH_EN(k) ((PH_MASK >> (k)) & 1)
#ifndef XB_USE
#define XB_USE 1
#endif
#ifndef COOP
#define COOP 0
#endif
#ifndef MK_FUSED
#define MK_FUSED 1
#endif
#ifndef F8_OUT
#define F8_OUT 3
#endif
#define F8_OUT_L(L) (((F8_OUT) >> (L)) & 1)
#ifndef F8_PROJ
#define F8_PROJ 0
#endif
#define F8_PROJ_L(L) (((F8_PROJ) >> (L)) & 1)
#ifndef I8_PROJ
#define I8_PROJ 3
#endif
#define I8_PROJ_L(L) (((I8_PROJ) >> (L)) & 1)
#ifndef I8_OUT
#define I8_OUT 0
#endif
#define I8_OUT_L(L) (((I8_OUT) >> (L)) & 1)

#define LAS __attribute__((address_space(3)))
typedef _Float16 hf;
typedef _Float16 h8 __attribute__((ext_vector_type(8)));
typedef _Float16 h4 __attribute__((ext_vector_type(4)));
typedef short s16x4 __attribute__((ext_vector_type(4)));
typedef float f32x4 __attribute__((ext_vector_type(4)));
typedef float f32x2 __attribute__((ext_vector_type(2)));
typedef unsigned u32x4 __attribute__((ext_vector_type(4)));

constexpr int SEQ = 4096, NTOK = 8192, DM = 2048, NCOL = 8704, GW = 512, MIXW = 2560, NMEM = 256;
constexpr float NORM_EPS = 1e-6f;
constexpr float QSCALE = 0.08838834764831845f * 1.4426950408889634f;
enum { SL_AQ = 0, SL_AK, SL_AV, SL_AG, SL_BU, SL_BV, SL_BG, SL_CQ, SL_CK, SL_CV, SL_CG, SL_DB, SL_DC, SL_DH, SL_DG, SL_XQ, SL_XG };

constexpr size_t MiB = 1u << 20;
constexpr size_t WS_CTL = 0;
constexpr size_t WS_ROPE = 1 * MiB;
constexpr size_t WS_SGUW = 3 * MiB;
constexpr size_t WS_KPART = 4 * MiB;
constexpr size_t WS_SA = 4 * MiB + 512 * 1024;
constexpr size_t WS_SW = 4 * MiB + 640 * 1024;
constexpr size_t WS_ROWMX = 4 * MiB + 192 * 1024;
constexpr size_t WS_SY = 4 * MiB + 768 * 1024;
constexpr size_t WS_SWO = 4 * MiB + 832 * 1024;
constexpr size_t WS_VSTAT = 5 * MiB;
constexpr size_t WS_LSE = 6 * MiB;
constexpr size_t WS_ROWSS = 7 * MiB + 512 * 1024;
constexpr size_t WS_KVMEM = 8 * MiB;
constexpr size_t WS_MEMN = 10 * MiB;
constexpr size_t WS_WMEMT = 16 * MiB;
constexpr size_t WS_WOUTT = 24 * MiB;
constexpr size_t WS_WINT = 48 * MiB;
constexpr size_t WS_XN = 116 * MiB;
constexpr size_t WS_PROJ = 148 * MiB;
constexpr size_t WS_OA = 284 * MiB;
constexpr size_t WS_OB = 308 * MiB;
constexpr size_t WS_OCP = 316 * MiB;
constexpr size_t WS_OX = 348 * MiB;
constexpr size_t WS_Y = 356 * MiB;
constexpr size_t WS_X1 = 396 * MiB;
constexpr size_t WS_XN8 = 428 * MiB;
constexpr size_t WS_HM = 460 * MiB;
constexpr size_t WS_LIST = 520 * MiB;
constexpr size_t WS_END = 524 * MiB;
constexpr int CW_BAR = 4096;
constexpr int CW_CNT = 8192;

constexpr int PROJ_N1 = 8192;
constexpr int LDS_BYTES = 147456;
constexpr int LDS_RSC_OFF = 145408 + 1024;
constexpr int NWAVES = 8;

__device__ __forceinline__ float shx_l(float v, int lane, int mask) { return __builtin_bit_cast(float, __builtin_amdgcn_ds_bpermute((lane ^ mask) << 2, __builtin_bit_cast(int, v))); }
__device__ __forceinline__ float wave_sum(float v, int lane) {
#pragma unroll
    for (int o = 1; o < 64; o <<= 1) v += shx_l(v, lane, o);
    return v;
}
__device__ __forceinline__ h8 pack8(f32x4 a, f32x4 b) {
    h4 x = __builtin_convertvector(a, h4), y = __builtin_convertvector(b, h4);
    return __builtin_shufflevector(x, y, 0, 1, 2, 3, 4, 5, 6, 7);
}
__device__ __forceinline__ float silu_f(float x) { return x * __builtin_amdgcn_rcpf(1.0f + __builtin_amdgcn_exp2f(-1.4426950408889634f * x)); }
__device__ __forceinline__ float gelu_f(float x) {
    const float z2 = 1.5957691216057308f * (x + 0.044715f * x * x * x);
    return x * __builtin_amdgcn_rcpf(1.0f + __builtin_amdgcn_exp2f(-1.4426950408889634f * z2));
}

typedef int i32x8 __attribute__((ext_vector_type(8)));
typedef int i32x4 __attribute__((ext_vector_type(4)));
typedef unsigned u32x2 __attribute__((ext_vector_type(2)));
__device__ __forceinline__ i32x8 cat8(h8 a, h8 b) { return __builtin_shufflevector(__builtin_bit_cast(i32x4, a), __builtin_bit_cast(i32x4, b), 0, 1, 2, 3, 4, 5, 6, 7); }
__device__ __forceinline__ unsigned pk4_f8(f32x4 a) { int w = __builtin_amdgcn_cvt_pk_fp8_f32(a[0], a[1], 0, false); return (unsigned)__builtin_amdgcn_cvt_pk_fp8_f32(a[2], a[3], w, true); }
__device__ __forceinline__ u32x2 pk8_f8(f32x4 a, f32x4 b) { return (u32x2){pk4_f8(a), pk4_f8(b)}; }
constexpr float W8_SCALE = 8.0f, A8_SCALE = 0.125f;

namespace pg8 {
constexpr int BM = 256, BK = 64, HALF = 128, HTB = HALF * BK * 2, STAGE_BYTES = 8 * HTB, NXCD = 8, WGM = 8;
__host__ __device__ __forceinline__ int lds_byte(int r, int c) { const int st = (r >> 4) * 2 + (c >> 5), rr = r & 15, cc = c & 31, ob = rr * 64 + cc * 2; return st * 1024 + (ob ^ (((ob >> 9) & 1) << 5)); }
__host__ __device__ __forceinline__ void stage_rc(int b, int& R, int& C) { const int st = b / 1024, sb = b % 1024, swz = sb ^ (((sb >> 9) & 1) << 5); R = (st >> 1) * 16 + swz / 64; C = (st & 1) * 32 + (swz % 64) / 2; }
__host__ __device__ __forceinline__ int perm32(int rho) { const int n = rho >> 4, i = rho & 15; return 8 * (i >> 2) + 4 * n + (i & 3); }
struct Unit { int pm, pn; };
struct Gemm { const void* A; const void* Bt; int M, N, K; };
struct StaticOrder {
    int nM, nN, nwg, G, c;
    __host__ __device__ void init(int M, int N, int G_, int c_) { nM = M / BM; nN = N / BM; nwg = nM * nN; G = G_; c = c_; }
    __host__ __device__ bool next(int i, Unit& u) const {
        const long L = (long)i * G + c; if (L >= nwg) return false;
        int wgid = (int)L; { const int q = nwg / NXCD, r = nwg % NXCD, xcd = wgid % NXCD, off = wgid / NXCD; wgid = (xcd < r ? xcd * (q + 1) : r * (q + 1) + (xcd - r) * q) + off; }
        const int nig = WGM * nN, gid = wgid / nig, fm = gid * WGM, gsz = (nM - fm) < WGM ? (nM - fm) : WGM;
        u.pm = fm + ((wgid % nig) % gsz); u.pn = (wgid % nig) / gsz; return true;
    }
    __device__ __forceinline__ void a_ready(const Unit&) const {}
    __device__ __forceinline__ void done(const Unit&) const {}
};

struct OneUnit {
    int pm, pn;
    __device__ __forceinline__ bool next(int i, Unit& u) const { if (i != 0) return false; u.pm = pm; u.pn = pn; return true; }
    __device__ __forceinline__ void a_ready(const Unit&) const {}
    __device__ __forceinline__ void done(const Unit&) const {}
};
template <class Epi, class Sched, bool ALIGN_EPI, bool SP2, int MODE = 0>
__device__ __forceinline__ void gemm_phase(LAS unsigned char* lds, const Gemm g, const Sched& S, const Epi& E) {
    static_assert(SP2, "only the SP2 loop is kept");
    int tid = threadIdx.x; asm volatile("" : "+v"(tid));
    const int wid = __builtin_amdgcn_readfirstlane(tid >> 6), lane = tid & 63, wr = wid >> 2, wc = wid & 3, fr = lane & 15, fq = lane >> 4;
    constexpr bool F8 = MODE == 1; constexpr int EB = MODE ? 1 : 2;
    const int K = g.K, nt = K * EB / (BK * 2);
    unsigned voffA[2], voffB[2];
#pragma unroll
    for (int i = 0; i < 2; ++i) { int R, C; stage_rc(tid * 16 + i * 8192, R, C); const int Rb = Epi::PERM ? ((R & ~31) + perm32(R & 31)) : R;
        voffA[i] = (unsigned)(R * K * EB + C * 2); voffB[i] = (unsigned)(Rb * K * EB + C * 2); }
    const size_t kstep = (size_t)(BK * 2);
    const size_t hstep = (size_t)HALF * K * EB;
    const size_t tstep = 2 * hstep;
    const unsigned ldsw = (unsigned)wid * 1024u;
    const int aoff = lds_byte(wr * 64 + fr, fq * 8), boff = lds_byte(wc * 32 + fr, fq * 8);
#define PG8_SA(b, h) (((b) * 2 + (h)) * HTB)
#define PG8_SB(b, h) ((4 + (b) * 2 + (h)) * HTB)
#define PG8_STAGE(bufoff, gbase, voff) do { _Pragma("unroll") for (int _i = 0; _i < 2; ++_i) \
        __builtin_amdgcn_global_load_lds((const unsigned*)((const char*)(gbase) + (voff)[_i]), (LAS unsigned*)(lds + (bufoff) + ldsw + _i * 8192), 16, 0, 0); } while (0)
#define PG8_LDA(dst, b, h) do { _Pragma("unroll") for (int m = 0; m < 4; ++m) _Pragma("unroll") for (int k = 0; k < 2; ++k) dst[m][k] = *(const LAS h8*)(lds + PG8_SA(b, h) + aoff + m * 2048 + k * 1024); } while (0)
#define PG8_LDB(dst, b, h) do { _Pragma("unroll") for (int n = 0; n < 2; ++n) _Pragma("unroll") for (int k = 0; k < 2; ++k) dst[n][k] = *(const LAS h8*)(lds + PG8_SB(b, h) + boff + n * 2048 + k * 1024); } while (0)
#define PG8_MMA(ai, bj, At, Bt) do { __builtin_amdgcn_s_setprio(1); _Pragma("unroll") for (int m = 0; m < 4; ++m) _Pragma("unroll") for (int n = 0; n < 2; ++n) { \
        if constexpr (F8) asm volatile("v_mfma_f32_16x16x128_f8f6f4 %0, %1, %2, %0" : "+v"(acc[ai][bj][m][n]) : "v"(cat8(Bt[n][0], Bt[n][1])), "v"(cat8(At[m][0], At[m][1]))); \
        else if constexpr (MODE == 2) { _Pragma("unroll") for (int k = 0; k < 2; ++k) acc[ai][bj][m][n] = __builtin_bit_cast(f32x4, __builtin_amdgcn_mfma_i32_16x16x64_i8(__builtin_bit_cast(i32x4, Bt[n][k]), __builtin_bit_cast(i32x4, At[m][k]), __builtin_bit_cast(i32x4, acc[ai][bj][m][n]), 0, 0, 0)); } \
        else { _Pragma("unroll") for (int k = 0; k < 2; ++k) acc[ai][bj][m][n] = __builtin_amdgcn_mfma_f32_16x16x32_f16(Bt[n][k], At[m][k], acc[ai][bj][m][n], 0, 0, 0); } } \
        __builtin_amdgcn_s_setprio(0); } while (0)
#define PG8_WAIT_V(n) asm volatile("s_waitcnt vmcnt(" #n ")" ::: "memory")
#define PG8_WAIT_L(n) asm volatile("s_waitcnt lgkmcnt(" #n ")" ::: "memory")
#define PG8_BAR __builtin_amdgcn_s_barrier()
#define PG8_SCHED __builtin_amdgcn_sched_barrier(0)
    Unit cur, nxt; int ui = 0;
    if (!S.next(0, cur)) return;
    f32x4 acc[2][2][4][2];
    E.init(acc, cur, wr, wc, fr, fq);
    h8 At[4][2], B0[2][2], B1[2][2];
    const char* cA = (const char*)g.A + (size_t)cur.pm * tstep; const char* cB = (const char*)g.Bt + (size_t)cur.pn * tstep;
    S.a_ready(cur);
    {
        PG8_STAGE(PG8_SB(0, 0), cB, voffB); PG8_STAGE(PG8_SB(0, 1), cB + hstep, voffB); PG8_STAGE(PG8_SA(0, 0), cA, voffA); PG8_STAGE(PG8_SA(0, 1), cA + hstep, voffA);
        if (wr == 1) PG8_BAR;
        PG8_WAIT_V(2); PG8_BAR;
        PG8_STAGE(PG8_SB(1, 0), cB + kstep, voffB); PG8_STAGE(PG8_SA(1, 0), cA + kstep, voffA); PG8_STAGE(PG8_SB(1, 1), cB + hstep + kstep, voffB);
        PG8_WAIT_V(6); PG8_BAR;
    }
    for (;;) {
        const bool has_next = S.next(ui + 1, nxt);
        const char* nA = has_next ? (const char*)g.A + (size_t)nxt.pm * tstep : cA; const char* nB = has_next ? (const char*)g.Bt + (size_t)nxt.pn * tstep : cB;
        for (int t = 0; t < nt; t += 2) {
            const bool last = (t == nt - 2);
            const char* a1 = cA + (size_t)(t + 1) * kstep;
            const char* a2 = last ? nA : cA + (size_t)(t + 2) * kstep; const char* b2 = last ? nB : cB + (size_t)(t + 2) * kstep;
            const char* a3 = a2 + kstep; const char* b3 = b2 + kstep;
            if (last && has_next) S.a_ready(nxt);
            PG8_LDB(B0, 0, 0); PG8_LDB(B1, 0, 1); PG8_SCHED; PG8_LDA(At, 0, 0); PG8_STAGE(PG8_SA(1, 1), a1 + hstep, voffA);
            PG8_WAIT_V(8); PG8_WAIT_L(0); PG8_BAR; PG8_MMA(0, 0, At, B0); PG8_MMA(0, 1, At, B1); PG8_BAR; PG8_SCHED;
            PG8_LDA(At, 0, 1); PG8_STAGE(PG8_SB(0, 0), b2, voffB); PG8_STAGE(PG8_SB(0, 1), b2 + hstep, voffB); PG8_STAGE(PG8_SA(0, 0), a2, voffA);
            PG8_WAIT_V(8); PG8_WAIT_L(0); PG8_BAR; PG8_MMA(1, 0, At, B0); PG8_MMA(1, 1, At, B1); PG8_BAR; PG8_SCHED;
            PG8_LDB(B0, 1, 0); PG8_LDB(B1, 1, 1); PG8_SCHED; PG8_LDA(At, 1, 0); PG8_STAGE(PG8_SA(0, 1), a2 + hstep, voffA);
            PG8_WAIT_V(8); PG8_WAIT_L(0); PG8_BAR; PG8_MMA(0, 0, At, B0); PG8_MMA(0, 1, At, B1); PG8_BAR; PG8_SCHED;
            PG8_LDA(At, 1, 1); PG8_STAGE(PG8_SB(1, 0), b3, voffB); PG8_STAGE(PG8_SB(1, 1), b3 + hstep, voffB); PG8_STAGE(PG8_SA(1, 0), a3, voffA);
            PG8_WAIT_V(8); PG8_WAIT_L(0); PG8_BAR; PG8_MMA(1, 0, At, B0); PG8_MMA(1, 1, At, B1); PG8_BAR; PG8_SCHED;
        }
        if constexpr (F8) asm volatile("s_nop 15\n\ts_nop 15" ::: "memory");
        if constexpr (ALIGN_EPI) { if (wr == 0) PG8_BAR; }
        if constexpr (!Epi::AFTER_DRAIN) { E(acc, cur, wr, wc, fr, fq); S.done(cur); }
        if (!has_next) break;
        E.init(acc, nxt, wr, wc, fr, fq);
        cur = nxt; cA = nA; cB = nB; ++ui;
        if constexpr (ALIGN_EPI) { if (wr == 1) PG8_BAR; }
    }
    PG8_WAIT_V(0);
    if constexpr (!ALIGN_EPI) { if (wr == 0) PG8_BAR; }
    PG8_BAR;
    if constexpr (Epi::AFTER_DRAIN) { E.fused(acc, cur, wr, wc, fr, fq, lds); S.done(cur); }
#undef PG8_SA
#undef PG8_SB
#undef PG8_STAGE
#undef PG8_LDA
#undef PG8_LDB
#undef PG8_MMA
#undef PG8_WAIT_V
#undef PG8_WAIT_L
#undef PG8_BAR
#undef PG8_SCHED
}

struct EpiProj {
    static constexpr bool PERM = true, AFTER_DRAIN = false;
    hf* O; const float* cosT; const float* sinT; float* kpart; f32x2* vstat; const float* rowss; hf* HM;
    const float* sa;
    const float* sw;
    const LAS float* rtab; int tab_pm;
    __device__ __forceinline__ void init(f32x4 (&acc)[2][2][4][2], const Unit&, int, int, int, int) const {
#pragma unroll
        for (int a = 0; a < 2; ++a)
#pragma unroll
            for (int b = 0; b < 2; ++b)
#pragma unroll
                for (int m = 0; m < 4; ++m)
#pragma unroll
                    for (int n = 0; n < 2; ++n) acc[a][b][m][n] = (f32x4){0.f, 0.f, 0.f, 0.f};
    }
    template <int TYPE>
    __device__ __forceinline__ void run(const f32x4 (&acc)[2][2][4][2], const Unit& u, int wr, int wc, int fr, int fq, int hmi, int colbase) const {
        asm volatile("" : "+v"(fr), "+v"(fq));
        const int row0 = u.pm * BM + wr * 64 + fr, col0 = colbase + wc * 32 + 8 * fq;
        const int jj = 4 * wc + fq;
        float rscv[8];
        if (u.pm == tab_pm) {
#pragma unroll
            for (int i = 0; i < 8; ++i) rscv[i] = rtab[wr * 64 + fr + (i >> 2) * HALF + (i & 3) * 16];
        } else {
            f32x4 pa[8], pb[8];
#pragma unroll
            for (int i = 0; i < 8; ++i) { const int row = row0 + (i >> 2) * HALF + (i & 3) * 16; pa[i] = *(const f32x4*)(rowss + (size_t)row * 8); pb[i] = *(const f32x4*)(rowss + (size_t)row * 8 + 4); }
#pragma unroll
            for (int i = 0; i < 8; ++i) { rscv[i] = __builtin_amdgcn_rsqf(((pa[i][0] + pa[i][1]) + (pa[i][2] + pa[i][3]) + (pb[i][0] + pb[i][1]) + (pb[i][2] + pb[i][3])) * (1.0f / DM) + NORM_EPS);
                if (sa != nullptr) rscv[i] *= sa[row0 + (i >> 2) * HALF + (i & 3) * 16]; }
        }
        f32x4 swv[2][2];
        if (sw != nullptr) {
#pragma unroll
            for (int bj = 0; bj < 2; ++bj)
#pragma unroll
                for (int n = 0; n < 2; ++n) swv[bj][n] = *(const f32x4*)(sw + u.pn * BM + bj * HALF + wc * 32 + 8 * fq + 4 * n);
        }
#define EPI_AV(ai, bj, m, n) (sw != nullptr ? __builtin_convertvector(__builtin_bit_cast(i32x4, acc[ai][bj][m][n]), f32x4) * swv[bj][n] : acc[ai][bj][m][n])
        if (TYPE >= 8) {
#pragma unroll
            for (int ai = 0; ai < 2; ++ai)
#pragma unroll
                for (int m = 0; m < 4; ++m) {
                    const int row = row0 + ai * HALF + m * 16;
                    const float rsc = rscv[ai * 4 + m];
#pragma unroll
                    for (int bj = 0; bj < 2; ++bj) {
                        const f32x4 v0 = EPI_AV(ai, bj, m, 0) * rsc, v1 = EPI_AV(ai, bj, m, 1) * rsc; f32x4 pr;
#pragma unroll
                        for (int i = 0; i < 4; ++i) pr[i] = (TYPE == 8 ? gelu_f(v0[i]) : v0[i]) * (TYPE == 10 ? v1[i] : silu_f(v1[i]));
                        *(h4*)(O + (size_t)row * NCOL + colbase + bj * 64 + wc * 16 + 4 * fq) = __builtin_convertvector(pr, h4);
                    }
                    asm volatile("" ::: "memory");
                }
            return;
        }
        f32x4 cs[2][2];
        if (TYPE == 3) {
#pragma unroll
            for (int bj = 0; bj < 2; ++bj)
#pragma unroll
                for (int n = 0; n < 2; ++n) cs[bj][n] = (f32x4){0.f, 0.f, 0.f, 0.f};
        }
        f32x4 cv_n = (f32x4){1.f, 1.f, 1.f, 1.f}, sv_n = (f32x4){0.f, 0.f, 0.f, 0.f};
        if (TYPE >= 1 && TYPE <= 3) { const int t = row0 & (SEQ - 1); cv_n = *(const f32x4*)(cosT + t * 64 + 4 * jj); sv_n = *(const f32x4*)(sinT + t * 64 + 4 * jj); }
#pragma unroll
        for (int ai = 0; ai < 2; ++ai)
#pragma unroll
            for (int m = 0; m < 4; ++m) {
                const int row = row0 + ai * HALF + m * 16;
                hf* rowp = O + (size_t)row * NCOL + col0;
                const f32x4 cv = cv_n, sv = sv_n;
                if (TYPE >= 1 && TYPE <= 3 && (ai * 4 + m) < 7) {
                    const int in_ = ai * 4 + m + 1, t = (row0 + (in_ >> 2) * HALF + (in_ & 3) * 16) & (SEQ - 1);
                    cv_n = *(const f32x4*)(cosT + t * 64 + 4 * jj); sv_n = *(const f32x4*)(sinT + t * 64 + 4 * jj); }
                float s1 = 0.f, s2 = 0.f;
                const float rsc = rscv[ai * 4 + m];
#pragma unroll
                for (int bj = 0; bj < 2; ++bj) {
                    f32x4 v0 = EPI_AV(ai, bj, m, 0) * rsc, v1 = EPI_AV(ai, bj, m, 1) * rsc;
                    if (TYPE >= 1 && TYPE <= 3) {
                        const f32x4 r0 = v0 * cv - v1 * sv, r1 = v1 * cv + v0 * sv; v0 = r0; v1 = r1;
                        if (TYPE == 1) { v0 = v0 * QSCALE; v1 = v1 * QSCALE; }
                        if (TYPE == 3) { cs[bj][0] += v0; cs[bj][1] += v1; asm volatile("" : "+v"(cs[bj][0]), "+v"(cs[bj][1])); }
                    } else if (TYPE == 4 || TYPE == 5) {
#pragma unroll
                        for (int i = 0; i < 4; ++i) { v0[i] = gelu_f(v0[i]); v1[i] = gelu_f(v1[i]); }
                    } else if (TYPE == 6) {
#pragma unroll
                        for (int i = 0; i < 4; ++i) { v0[i] = silu_f(v0[i]); v1[i] = silu_f(v1[i]); }
                    } else if (TYPE == 7) { v0 = v0 * QSCALE; v1 = v1 * QSCALE; }
                    const h8 hv = pack8(v0, v1);
                    if (TYPE == 5) {
#pragma unroll
                        for (int i = 0; i < 8; ++i) { const float x = (float)hv[i]; s1 += x; s2 += x * x; }
                    }
                    if ((TYPE <= 3 || TYPE == 7) && hmi >= 0) {
                        const int hh = (u.pn & 1) * 2 + bj;
                        *(h8*)(HM + (size_t)hmi * NTOK * GW + ((size_t)((row >> 12) * 4 + hh) * SEQ + (row & (SEQ - 1))) * 128 + wc * 32 + 8 * fq) = hv;
                    } else *(h8*)(rowp + bj * HALF) = hv;
                }
                if (TYPE == 5) {
                    { const int ln_ = fq * 16 + fr; s1 += shx_l(s1, ln_, 16); s1 += shx_l(s1, ln_, 32); s2 += shx_l(s2, ln_, 16); s2 += shx_l(s2, ln_, 32); }
                    if (fq == 0) vstat[(size_t)row * 8 + (u.pn & 1) * 4 + wc] = (f32x2){s1, s2};
                }
                asm volatile("" ::: "memory");
            }
        if (TYPE == 3) {
#pragma unroll
            for (int bj = 0; bj < 2; ++bj)
#pragma unroll
                for (int n = 0; n < 2; ++n) {
                    f32x4 c = cs[bj][n];
#pragma unroll
                    for (int o = 1; o < 16; o <<= 1) { const int ln_ = fq * 16 + fr; c[0] += shx_l(c[0], ln_, o); c[1] += shx_l(c[1], ln_, o); c[2] += shx_l(c[2], ln_, o); c[3] += shx_l(c[3], ln_, o); }
                    if (fr == 0) *(f32x4*)(kpart + (size_t)(u.pm * 2 + wr) * GW + (u.pn & 1) * BM + bj * HALF + wc * 32 + 8 * fq + 4 * n) = c;
                }
        }
    }
#undef EPI_AV
    __device__ __forceinline__ void operator()(const f32x4 (&acc)[2][2][4][2], const Unit& u, int wr, int wc, int fr, int fq) const {
        const int pn = u.pn, slice = pn >> 1, cb = pn * BM;
        if (pn >= 8 && pn < 12) run<8>(acc, u, wr, wc, fr, fq, -1, SL_BU * GW + (pn - 8) * 128);
        else if (pn == 12 || pn == 13) run<5>(acc, u, wr, wc, fr, fq, -1, SL_BV * GW + (pn - 12) * BM);
        else if (pn >= 22 && pn < 26) run<9>(acc, u, wr, wc, fr, fq, -1, SL_DB * GW + (pn - 22) * 128);
        else if (pn >= 26 && pn < 30) run<10>(acc, u, wr, wc, fr, fq, -1, SL_DC * GW + (pn - 26) * 128);
        else if (slice == SL_AQ || slice == SL_CQ) run<1>(acc, u, wr, wc, fr, fq, slice == SL_AQ ? 0 : 3, cb);
        else if (slice == SL_AK) run<2>(acc, u, wr, wc, fr, fq, 1, cb);
        else if (slice == SL_CK) run<3>(acc, u, wr, wc, fr, fq, 4, cb);
        else if (slice == SL_AG || slice == SL_CG || slice == SL_XG) run<6>(acc, u, wr, wc, fr, fq, -1, cb);
        else if (slice == SL_XQ) run<7>(acc, u, wr, wc, fr, fq, 6, cb);
        else run<0>(acc, u, wr, wc, fr, fq, slice == SL_AV ? 2 : (slice == SL_CV ? 5 : -1), cb);
    }
};
struct EpiRes {
    static constexpr bool PERM = false, AFTER_DRAIN = true;
    const float* res32; const hf* res16; hf* out16; float* rowss; float* out32; const float* gfin; unsigned* pcnt; unsigned char* out8;
    unsigned char* q8x; float* sa_out; float* rowmx;
    const unsigned char* res8; const float* res_sa;
    const float* sy; const float* swo;
    __device__ __forceinline__ void init(f32x4 (&acc)[2][2][4][2], const Unit& u, int wr, int wc, int fr, int fq) const {
        if (sy != nullptr) {
#pragma unroll
            for (int a = 0; a < 2; ++a)
#pragma unroll
                for (int b = 0; b < 2; ++b)
#pragma unroll
                    for (int m = 0; m < 4; ++m)
#pragma unroll
                        for (int n = 0; n < 2; ++n) acc[a][b][m][n] = (f32x4){0.f, 0.f, 0.f, 0.f};
            return;
        }
        asm volatile("" : "+v"(fr), "+v"(fq));
        const int row0 = u.pm * BM + wr * 64 + fr, col0 = u.pn * BM + wc * 32 + 4 * fq;
#pragma unroll
        for (int ai = 0; ai < 2; ++ai)
#pragma unroll
            for (int m = 0; m < 4; ++m) { const size_t off = (size_t)(row0 + ai * HALF + m * 16) * DM + col0;
#pragma unroll
                for (int bj = 0; bj < 2; ++bj)
#pragma unroll
                    for (int n = 0; n < 2; ++n) {
                        if (res8 != nullptr) { const int w = (int)__builtin_nontemporal_load((const unsigned*)(res8 + off + bj * HALF + n * 16));
                            const float s_ = res_sa[row0 + ai * HALF + m * 16];
                            acc[ai][bj][m][n] = (f32x4){(float)((w << 24) >> 24), (float)((w << 16) >> 24), (float)((w << 8) >> 24), (float)(w >> 24)} * s_; }
                        else if (res32 != nullptr) acc[ai][bj][m][n] = __builtin_nontemporal_load((const f32x4*)(res32 + off + bj * HALF + n * 16));
                        else acc[ai][bj][m][n] = __builtin_convertvector(__builtin_nontemporal_load((const h4*)(res16 + off + bj * HALF + n * 16)), f32x4); } }
    }
    __device__ __forceinline__ void fused(f32x4 (&acc)[2][2][4][2], const Unit& u, int wr, int wc, int fr, int fq, LAS unsigned char* lds) const {
        asm volatile("" : "+v"(fr), "+v"(fq));
        const int row0 = u.pm * BM + wr * 64 + fr, col0 = u.pn * BM + wc * 32 + 4 * fq;
        LAS float* red = (LAS float*)lds;
        f32x4 swv[2][2]; h4 rv_n[2][2]; float sy_n = 0.f;
        if (sy != nullptr) {
#pragma unroll
            for (int bj = 0; bj < 2; ++bj)
#pragma unroll
                for (int n = 0; n < 2; ++n) { swv[bj][n] = *(const f32x4*)(swo + col0 + bj * HALF + n * 16); rv_n[bj][n] = __builtin_nontemporal_load((const h4*)(res16 + (size_t)row0 * DM + col0 + bj * HALF + n * 16)); }
            sy_n = sy[row0];
        }
#pragma unroll
        for (int ai = 0; ai < 2; ++ai)
#pragma unroll
            for (int m = 0; m < 4; ++m) { const size_t off = (size_t)(row0 + ai * HALF + m * 16) * DM + col0; float ss = 0.f, mxr = 0.f;
                if (sy != nullptr) {
                    h4 rv[2][2]; const float sy_c = sy_n;
#pragma unroll
                    for (int bj = 0; bj < 2; ++bj)
#pragma unroll
                        for (int n = 0; n < 2; ++n) rv[bj][n] = rv_n[bj][n];
                    if (ai * 4 + m < 7) { const int in_ = ai * 4 + m + 1, rown = row0 + (in_ >> 2) * HALF + (in_ & 3) * 16; sy_n = sy[rown];
#pragma unroll
                        for (int bj = 0; bj < 2; ++bj)
#pragma unroll
                            for (int n = 0; n < 2; ++n) rv_n[bj][n] = __builtin_nontemporal_load((const h4*)(res16 + (size_t)rown * DM + col0 + bj * HALF + n * 16)); }
#pragma unroll
                    for (int bj = 0; bj < 2; ++bj)
#pragma unroll
                        for (int n = 0; n < 2; ++n)
                            acc[ai][bj][m][n] = __builtin_convertvector(__builtin_bit_cast(i32x4, acc[ai][bj][m][n]), f32x4) * (swv[bj][n] * sy_c) + __builtin_convertvector(rv[bj][n], f32x4);
                }
#pragma unroll
                for (int bj = 0; bj < 2; ++bj)
#pragma unroll
                    for (int n = 0; n < 2; ++n) { const f32x4 o = acc[ai][bj][m][n];
                        if (out32 == nullptr && q8x == nullptr) { *(h4*)(out16 + off + bj * HALF + n * 16) = __builtin_convertvector(o, h4); if (out8 != nullptr) *(unsigned*)(out8 + off + bj * HALF + n * 16) = pk4_f8(o * A8_SCALE); }
                        if (q8x != nullptr) mxr = fmaxf(fmaxf(mxr, fmaxf(fabsf(o[0]), fabsf(o[1]))), fmaxf(fabsf(o[2]), fabsf(o[3])));
                        ss += (o[0] * o[0] + o[1] * o[1]) + (o[2] * o[2] + o[3] * o[3]); }
                { const int ln_ = fq * 16 + fr; ss += shx_l(ss, ln_, 16); ss += shx_l(ss, ln_, 32); } if (fq == 0) red[(wr * 64 + ai * HALF + m * 16 + fr) * 4 + wc] = ss;
                if (q8x != nullptr) { const int ln_ = fq * 16 + fr; mxr = fmaxf(mxr, shx_l(mxr, ln_, 16)); mxr = fmaxf(mxr, shx_l(mxr, ln_, 32)); if (fq == 0) red[1024 + (wr * 64 + ai * HALF + m * 16 + fr) * 4 + wc] = mxr; }
                asm volatile("" ::: "memory"); }
        __syncthreads();
        int t = threadIdx.x; asm volatile("" : "+v"(t));
        if (t < 256) { const f32x4 p = *(const LAS f32x4*)(red + t * 4); __hip_atomic_store(&rowss[(size_t)(u.pm * BM + t) * 8 + u.pn], (p[0] + p[1]) + (p[2] + p[3]), __ATOMIC_RELAXED, __HIP_MEMORY_SCOPE_AGENT);
            if (q8x != nullptr) { const f32x4 q = *(const LAS f32x4*)(red + 1024 + t * 4); __hip_atomic_store(&rowmx[(size_t)(u.pm * BM + t) * 8 + u.pn], fmaxf(fmaxf(q[0], q[1]), fmaxf(q[2], q[3])), __ATOMIC_RELAXED, __HIP_MEMORY_SCOPE_AGENT); } }
        if (q8x != nullptr) {
            asm volatile("s_waitcnt vmcnt(0)" ::: "memory");
            __syncthreads();
            if (t == 0) {
                __hip_atomic_fetch_add(pcnt + 32 + u.pm, 1u, __ATOMIC_RELAXED, __HIP_MEMORY_SCOPE_AGENT);
                unsigned sp = 0u;
                while (__hip_atomic_load(pcnt + 32 + u.pm, __ATOMIC_RELAXED, __HIP_MEMORY_SCOPE_AGENT) < 8u) { __builtin_amdgcn_s_sleep(1); if (++sp > (1u << 22)) break; }
                __builtin_amdgcn_fence(__ATOMIC_ACQUIRE, "agent"); asm volatile("s_waitcnt vmcnt(0)" ::: "memory");
            }
            __syncthreads();
#pragma unroll
            for (int ai = 0; ai < 2; ++ai)
#pragma unroll
                for (int m = 0; m < 4; ++m) { const int row = row0 + ai * HALF + m * 16; const size_t off = (size_t)row * DM + col0;
                    const f32x4 pa = *(const f32x4*)(rowmx + (size_t)row * 8), pb = *(const f32x4*)(rowmx + (size_t)row * 8 + 4);
                    const float mx = fmaxf(fmaxf(fmaxf(fmaxf(pa[0], pa[1]), fmaxf(pa[2], pa[3])), fmaxf(fmaxf(pb[0], pb[1]), fmaxf(pb[2], pb[3]))), 1e-30f), inv = 127.0f / mx;
#pragma unroll
                    for (int bj = 0; bj < 2; ++bj)
#pragma unroll
                        for (int n = 0; n < 2; ++n) { const f32x4 q = acc[ai][bj][m][n] * inv; unsigned w = 0u;
#pragma unroll
                            for (int i = 0; i < 4; ++i) w |= ((unsigned)(int)__builtin_rintf(q[i]) & 255u) << (8 * i);
                            *(unsigned*)(q8x + off + bj * HALF + n * 16) = w; }
                    if (u.pn == 0 && wc == 0 && fq == 0) sa_out[row] = mx * (1.0f / 127.0f);
                    asm volatile("" ::: "memory"); }
        }
        if (out32 != nullptr) {
            asm volatile("s_waitcnt vmcnt(0)" ::: "memory");
            __syncthreads();
            if (t == 0) {
                __hip_atomic_fetch_add(pcnt + u.pm, 1u, __ATOMIC_RELAXED, __HIP_MEMORY_SCOPE_AGENT);
                unsigned sp = 0u;
                while (__hip_atomic_load(pcnt + u.pm, __ATOMIC_RELAXED, __HIP_MEMORY_SCOPE_AGENT) < 8u) { __builtin_amdgcn_s_sleep(1); if (++sp > (1u << 22)) break; }
                __builtin_amdgcn_fence(__ATOMIC_ACQUIRE, "agent"); asm volatile("s_waitcnt vmcnt(0)" ::: "memory");
            }
            __syncthreads();
#pragma unroll
            for (int ai = 0; ai < 2; ++ai)
#pragma unroll
                for (int m = 0; m < 4; ++m) { const int row = row0 + ai * HALF + m * 16; const size_t off = (size_t)row * DM + col0;
                    const f32x4 pa = *(const f32x4*)(rowss + (size_t)row * 8), pb = *(const f32x4*)(rowss + (size_t)row * 8 + 4);
                    const float r = __builtin_amdgcn_rsqf(((pa[0] + pa[1]) + (pa[2] + pa[3]) + (pb[0] + pb[1]) + (pb[2] + pb[3])) * (1.0f / DM) + NORM_EPS);
#pragma unroll
                    for (int bj = 0; bj < 2; ++bj)
#pragma unroll
                        for (int n = 0; n < 2; ++n) { const f32x4 gg = *(const f32x4*)(gfin + col0 + bj * HALF + n * 16);
                            __builtin_nontemporal_store(acc[ai][bj][m][n] * r * gg, (f32x4*)(out32 + off + bj * HALF + n * 16)); }
                    asm volatile("" ::: "memory"); }
        }
    }
};
}

namespace att {
constexpr int NWV = 8, QBLK = 32, KVBLK = 64, QB = NWV * QBLK, D = 128;
constexpr int SHM_V = KVBLK * D * 2, SHM_K = KVBLK * D * 2;
constexpr int LDS_WS = 2 * SHM_V + 2 * SHM_K;
constexpr int LDS_KSUM = LDS_WS + NWV * 96 * 4;
constexpr int LDS_BYTES_ATT = LDS_KSUM + 16 * 128 * 4;
constexpr float THR2 = 11.5f;
typedef float f32x16 __attribute__((ext_vector_type(16)));
typedef short s16x8 __attribute__((ext_vector_type(8)));
typedef _Float16 h2 __attribute__((ext_vector_type(2)));
#define KSWZ(row, colB) ((row) * 256 + ((colB) ^ (((row) & 7) << 4)))
#define SBAR() __builtin_amdgcn_sched_barrier(0)
__device__ __forceinline__ int v_st(int k, int c) { const int kk = (k & ~0xC) | ((k & 4) << 1) | ((k & 8) >> 1); return ((kk >> 3) * 4 + (c >> 5)) * 512 + ((kk & 7) * 32 + (c & 31)) * 2; }
__device__ __forceinline__ int v_rd_base(int lane) { return ((lane & 3) << 3) | (((lane >> 2) & 3) << 6) | (((lane >> 4) & 1) << 5) | (((lane >> 5) & 1) << 8); }
constexpr int v_rd_off(int d0, int ks, int half) { return d0 * 512 + ks * 4096 + half * 2048; }
__device__ __forceinline__ int crow(int r, int hi) { return (r & 3) + 8 * (r >> 2) + 4 * hi; }
__device__ __forceinline__ unsigned cvtpk(float lo, float hi) { const f32x2 v = {lo, hi}; const h2 b = __builtin_convertvector(v, h2); return __builtin_bit_cast(unsigned, b); }
__device__ __forceinline__ void mask_tile(f32x16& p0, f32x16& p1, int dq, unsigned W) {
    float NEG = -__builtin_inff(); asm volatile("" : "+v"(NEG));
#pragma unroll
    for (int r = 0; r < 16; ++r) {
        const int c = (r & 3) + 8 * (r >> 2);
        if ((unsigned)(dq - c) >= W) p0[r] = NEG;
        if ((unsigned)(dq - c - 32) >= W) p1[r] = NEG;
    }
}
__device__ __forceinline__ void partialSM(f32x16& p0, f32x16& p1, float& m_reg, float& mn, float& alpha) {
    float pmax = p0[0];
#pragma unroll
    for (int r = 1; r < 16; ++r) pmax = fmaxf(pmax, p0[r]);
#pragma unroll
    for (int r = 0; r < 16; ++r) pmax = fmaxf(pmax, p1[r]);
    { auto rr = __builtin_amdgcn_permlane32_swap(__float_as_uint(pmax), __float_as_uint(pmax), false, false);
      pmax = fmaxf(__uint_as_float(rr[0]), __uint_as_float(rr[1])); }
    mn = ((pmax - m_reg) <= THR2) ? m_reg : fmaxf(m_reg, pmax); alpha = __builtin_amdgcn_exp2f(m_reg - mn); m_reg = mn;
#pragma unroll
    for (int r = 0; r < 16; ++r) p0[r] = p0[r] - mn;
#pragma unroll
    for (int r = 0; r < 16; ++r) p1[r] = p1[r] - mn;
#pragma unroll
    for (int r = 0; r < 16; ++r) p0[r] = __builtin_amdgcn_exp2f(p0[r]);
}
__device__ __forceinline__ void finishSM(f32x16& p0, f32x16& p1, float alpha, float& l_reg, h8& pa0, h8& pa1, h8& pa2, h8& pa3) {
#pragma unroll
    for (int r = 0; r < 16; ++r) p1[r] = __builtin_amdgcn_exp2f(p1[r]);
    float ps = 0;
#pragma unroll
    for (int r = 0; r < 16; ++r) ps += p0[r];
#pragma unroll
    for (int r = 0; r < 16; ++r) ps += p1[r];
    { auto rr = __builtin_amdgcn_permlane32_swap(__float_as_uint(ps), __float_as_uint(ps), false, false);
      ps = __uint_as_float(rr[0]) + __uint_as_float(rr[1]); }
    l_reg = l_reg * alpha + ps;
#define PK4(P, B_, OUT) do { unsigned a0 = cvtpk(P[B_+0], P[B_+1]), a1 = cvtpk(P[B_+2], P[B_+3]);                          \
        unsigned b0 = cvtpk(P[B_+4], P[B_+5]), b1 = cvtpk(P[B_+6], P[B_+7]);                                             \
        auto r0 = __builtin_amdgcn_permlane32_swap(a0, b0, false, false); auto r1 = __builtin_amdgcn_permlane32_swap(a1, b1, false, false); \
        u32x4 w = {r0[0], r1[0], r0[1], r1[1]}; OUT = __builtin_bit_cast(h8, w); } while (0)
    PK4(p0, 0, pa0); PK4(p0, 8, pa1); PK4(p1, 0, pa2); PK4(p1, 8, pa3);
#undef PK4
}
template <int KB>
__device__ __forceinline__ void qkt(f32x16& p0, f32x16& p1, const LAS char* K_lds, int r32, int hi, const h8* qr, bool act) {
    if (!act) { float NEG = -__builtin_inff(); asm volatile("" : "+v"(NEG));
#pragma unroll
        for (int r = 0; r < 16; ++r) { p0[r] = NEG; p1[r] = NEG; } return; }
    p0 = f32x16{}; p1 = f32x16{};
    const LAS char* kb[4];
#pragma unroll
    for (int dd = 0; dd < 4; ++dd) kb[dd] = K_lds + KB * SHM_K + KSWZ(r32, (dd * 16 + hi * 8) * 2);
#pragma unroll
    for (int d0 = 0; d0 < 8; ++d0) { const LAS char* a = kb[d0 & 3] + (d0 >> 2) * 128;
        const h8 b0 = *reinterpret_cast<const LAS h8*>(a);
        const h8 b1 = *reinterpret_cast<const LAS h8*>(a + 32 * 256);
        p0 = __builtin_amdgcn_mfma_f32_32x32x16_f16(b0, qr[d0], p0, 0, 0, 0);
        p1 = __builtin_amdgcn_mfma_f32_32x32x16_f16(b1, qr[d0], p1, 0, 0, 0); }
}
template <int VB>
__device__ __forceinline__ void pv_tile(f32x16* o, int vb0, h8 pa0, h8 pa1, h8 pa2, h8 pa3, bool act) {
    if (!act) return;
#define TRRD(dst, off) asm volatile("ds_read_b64_tr_b16 %0, %1 offset:%2" : "=&v"(dst) : "v"(vb0), "i"(off) : "memory")
#define MKH8(l, h) __builtin_bit_cast(h8, (s16x8){l[0], l[1], l[2], l[3], h[0], h[1], h[2], h[3]})
#define PV_D0(d0) do { s16x4 l0, l1, l2, l3, h0, h1, h2, h3; constexpr int b_ = VB * SHM_V + v_rd_off(d0, 0, 0); \
        TRRD(l0, b_); TRRD(h0, b_ + 2048); TRRD(l1, b_ + 4096); TRRD(h1, b_ + 6144); TRRD(l2, b_ + 8192); TRRD(h2, b_ + 10240); TRRD(l3, b_ + 12288); TRRD(h3, b_ + 14336); \
        asm volatile("s_waitcnt lgkmcnt(0)" ::: "memory"); SBAR();   \
        o[d0] = __builtin_amdgcn_mfma_f32_32x32x16_f16(pa0, MKH8(l0, h0), o[d0], 0, 0, 0);   \
        o[d0] = __builtin_amdgcn_mfma_f32_32x32x16_f16(pa1, MKH8(l1, h1), o[d0], 0, 0, 0);   \
        o[d0] = __builtin_amdgcn_mfma_f32_32x32x16_f16(pa2, MKH8(l2, h2), o[d0], 0, 0, 0);   \
        o[d0] = __builtin_amdgcn_mfma_f32_32x32x16_f16(pa3, MKH8(l3, h3), o[d0], 0, 0, 0); } while (0)
    PV_D0(0); PV_D0(1); PV_D0(2); PV_D0(3);
#undef PV_D0
#undef MKH8
#undef TRRD
}
struct BlkRef { const hf* Q; const hf* K; const hf* V; hf* O; float* LSE; const unsigned* list; int qs, ks, os, ls; int P0, W, j_lo, j_hi, cnt; };
struct NxtRef { const hf* Q; const hf* K; const hf* V; const unsigned* list; int qs, ks, j_lo, cnt; };
struct Seam { h8 qr[8]; h8 st_v0, st_v1, st_k0, st_k1; unsigned ent; };
__device__ __forceinline__ long q_row_of(const unsigned* list, int cnt, int idx, unsigned& ent) {
    ent = 0xFFFFFFFFu; if (list == nullptr) return idx;
    if (idx < cnt) ent = list[idx];
    return ent == 0xFFFFFFFFu ? 0 : (long)(ent & 0xFFFFu);
}
#define ROWP(p, st, k0, rr) ((p) + (long)((k0) + (rr)) * (st) + sc)
#define VMW() asm volatile("s_waitcnt vmcnt(0)" ::: "memory")
#define VMWN(n) asm volatile("s_waitcnt vmcnt(%0)" :: "i"(n) : "memory")
#define SLOAD_H(Kp, Vp, st, k0) do { S.st_v0 = *(const h8*)ROWP(Vp, st, k0, sr); S.st_v1 = *(const h8*)ROWP(Vp, st, k0, 32 + sr);              \
                         S.st_k0 = *(const h8*)ROWP(Kp, st, k0, sr); S.st_k1 = *(const h8*)ROWP(Kp, st, k0, 32 + sr); } while (0)
#define SWRITE_HK(bf) do { *(LAS h8*)(K_lds + (bf) * SHM_K + kws) = S.st_k0; *(LAS h8*)(K_lds + (bf) * SHM_K + kws + 32 * 256) = S.st_k1; } while (0)
#define SWRITE_HV(bf) do { *(LAS h8*)(V_lds + (bf) * SHM_V + vst0) = S.st_v0; *(LAS h8*)(V_lds + (bf) * SHM_V + vst1) = S.st_v1; } while (0)
#define SWRITE_H(bf) do { SWRITE_HV(bf); SWRITE_HK(bf); } while (0)
__device__ __forceinline__ void blk_prime(const BlkRef& cur, LAS char* lds, Seam& S) {
    int tid = threadIdx.x; asm volatile("" : "+v"(tid));
    const int wid = __builtin_amdgcn_readfirstlane(tid >> 6), lane = tid & 63, r32 = lane & 31, hi = lane >> 5;
    const int sr = tid >> 4, sc = (tid & 15) * 8, kws = KSWZ(sr, sc * 2); LAS char* K_lds = lds + 2 * SHM_V;
    const int kb0 = cur.j_lo * KVBLK;
    { const long qrow = q_row_of(cur.list, cur.cnt, wid * QBLK + r32, S.ent);
#pragma unroll
      for (int d0 = 0; d0 < 8; ++d0) S.qr[d0] = *(const h8*)(cur.Q + qrow * cur.qs + d0 * 16 + hi * 8); }
    SLOAD_H(cur.K, cur.V, cur.ks, kb0); VMW(); SWRITE_HK(0);
    __syncthreads();
}
__device__ __forceinline__ void blk_run(const BlkRef& cur, const NxtRef& nxt, LAS char* lds, Seam& S, unsigned tk, volatile LAS int* qw, int qbase) {
    int tid = threadIdx.x; asm volatile("" : "+v"(tid));
    const int wid = __builtin_amdgcn_readfirstlane(tid >> 6), lane = tid & 63, r32 = lane & 31, hi = lane >> 5;
    const int j_lo = cur.j_lo, NT = cur.j_hi - cur.j_lo, W = cur.W;
    const int kbn = nxt.j_lo * KVBLK;
    const int qlo = cur.P0 + wid * QBLK, qm = qlo + r32 - 4 * hi;
    LAS char* V_lds = lds; LAS char* K_lds = lds + 2 * SHM_V;
    LAS float* ws = (LAS float*)(lds + LDS_WS) + wid * 96; LAS float* li_l = ws; LAS float* al_l = ws + 32;
    float m_reg = -1e30f, l_reg = 0; f32x16 o[4] = {}; int epi_r32;
    const int sr = tid >> 4, sc = (tid & 15) * 8, vst0 = v_st(sr, sc), vst1 = v_st(32 + sr, sc), kws = KSWZ(sr, sc * 2);
    const int vb0 = (int)(unsigned)(uintptr_t)V_lds + v_rd_base(lane);
    const hf* Kh = cur.K; const hf* Vh = cur.V; const int kst = cur.ks;
    const unsigned ent_cur = S.ent;
    LAS unsigned* rt_l = (LAS unsigned*)(ws + 64);
    if (cur.list != nullptr && hi == 0) rt_l[r32] = ent_cur;
#define RESC(a) do { if (__any((a) < 1.f)) { if (hi == 0) al_l[r32] = (a); asm volatile("s_waitcnt lgkmcnt(0)" ::: "memory");              \
                     for (int d_ = 0; d_ < 4; ++d_) for (int r = 0; r < 16; ++r) o[d_][r] *= al_l[crow(r, hi)]; } } while (0)
#define KBASE(t) ((j_lo + (t)) * KVBLK)
#define ACT(t) (KBASE(t) <= qlo + QBLK - 1 && KBASE(t) + KVBLK - 1 >= qlo - W + 1)
#define MASKT(P0_, P1_, t) do { const int kb_ = KBASE(t); if (ACT(t) && (kb_ + KVBLK - 1 > qlo || kb_ <= qlo + QBLK - 1 - W)) mask_tile(P0_, P1_, qm - kb_, (unsigned)W); } while (0)
    constexpr int NQL = 8;
#define SEAM_K0() do { VMWN(NQL); SWRITE_HK(0); SBAR(); } while (0)
    f32x16 pA0, pA1, pB0, pB1; float mnA, mnB, alA, alB; h8 pa0, pa1, pa2, pa3;
    SWRITE_HV(0); SBAR();
    if (NT > 1) { SLOAD_H(Kh, Vh, kst, KBASE(1)); }
    SBAR(); qkt<0>(pA0, pA1, K_lds, r32, hi, S.qr, ACT(0));
    if (ACT(0)) { MASKT(pA0, pA1, 0); partialSM(pA0, pA1, m_reg, mnA, alA); } else { mnA = m_reg; alA = 1.f; }
    if (NT > 1) { VMW(); SWRITE_H(1); SBAR(); }
    if (NT > 2) { SLOAD_H(Kh, Vh, kst, KBASE(2)); SBAR(); }
    __syncthreads();
#define HALF_STEP(PX0, PX1, mnX, alX, PY0, PY1, alY, t, KB, VB, SB) do {                                                      \
        SBAR(); qkt<KB>(PX0, PX1, K_lds, r32, hi, S.qr, ACT(t));                                             \
        if (ACT((t) - 1)) finishSM(PY0, PY1, alY, l_reg, pa0, pa1, pa2, pa3); SBAR();                                         \
        pv_tile<VB>(o, vb0, pa0, pa1, pa2, pa3, ACT((t) - 1));                                                                \
        if (ACT(t)) { MASKT(PX0, PX1, (t)); partialSM(PX0, PX1, m_reg, mnX, alX); } else { mnX = m_reg; alX = 1.f; }          \
        __syncthreads();                                                                                                      \
        if ((t) + 1 < NT) { VMW(); SWRITE_H(SB); SBAR(); }                                                                  \
        if ((t) + 2 < NT) { SLOAD_H(Kh, Vh, kst, KBASE((t) + 2)); SBAR(); }                                               \
        RESC(alX); __syncthreads(); } while (0)
    for (int t = 1; t + 1 < NT; t += 2) {
        HALF_STEP(pB0, pB1, mnB, alB, pA0, pA1, alA, t, 1, 0, 0);
        HALF_STEP(pA0, pA1, mnA, alA, pB0, pB1, alB, t + 1, 0, 1, 1);
    }
    const bool even = (NT & 1) == 0;
    if (even) { SBAR(); qkt<1>(pB0, pB1, K_lds, r32, hi, S.qr, ACT(NT - 1)); SBAR(); }
    { SLOAD_H(nxt.K, nxt.V, nxt.ks, kbn); SBAR();
      const long qrow = q_row_of(nxt.list, nxt.cnt, wid * QBLK + r32, S.ent);
#pragma unroll
      for (int d0 = 0; d0 < 8; ++d0) S.qr[d0] = *(const h8*)(nxt.Q + qrow * nxt.qs + d0 * 16 + hi * 8); }
    SBAR();
    if (ACT(even ? NT - 2 : NT - 1)) finishSM(pA0, pA1, alA, l_reg, pa0, pa1, pa2, pa3); SBAR();
    pv_tile<0>(o, vb0, pa0, pa1, pa2, pa3, ACT(even ? NT - 2 : NT - 1));
    if (even) { if (ACT(NT - 1)) { MASKT(pB0, pB1, NT - 1); partialSM(pB0, pB1, m_reg, mnB, alB); } else { mnB = m_reg; alB = 1.f; } __syncthreads(); RESC(alB);
        if (ACT(NT - 1)) finishSM(pB0, pB1, alB, l_reg, pa0, pa1, pa2, pa3); SBAR(); pv_tile<1>(o, vb0, pa0, pa1, pa2, pa3, ACT(NT - 1)); }
    SBAR(); SEAM_K0();
    if (hi == 0) li_l[r32] = l_reg; asm volatile("s_waitcnt lgkmcnt(0)" ::: "memory");
    { int lane_e = lane; asm volatile("" : "+v"(lane_e)); epi_r32 = lane_e & 31; }
    float rli[16];
#pragma unroll
    for (int r = 0; r < 16; ++r) { const float lv = li_l[crow(r, hi)]; rli[r] = lv > 0.f ? __builtin_amdgcn_rcpf(lv) : 0.f; }
    __syncthreads();
    {
        LAS char* ost = V_lds + wid * 4096;
        const bool odd = (epi_r32 & 1) != 0;
        const bool gat = cur.list != nullptr;
        hf* Ow = cur.O + (long)(wid * QBLK) * cur.os;
#pragma unroll
        for (int ps = 0; ps < 2; ++ps) {
#pragma unroll
            for (int r = 0; r < 16; ++r) {
                const float va = o[2 * ps][r] * rli[r], vb = o[2 * ps + 1][r] * rli[r];
                const float got = shx_l(odd ? va : vb, hi * 32 + epi_r32, 1);
                const unsigned w = odd ? cvtpk(got, vb) : cvtpk(va, got);
                *(LAS unsigned*)(ost + crow(r, hi) * 128 + (odd ? 64 : 0) + (epi_r32 & ~1) * 2) = w;
            }
            asm volatile("s_waitcnt lgkmcnt(0)" ::: "memory");
#pragma unroll
            for (int it = 0; it < 4; ++it) {
                const int idx = it * 64 + (hi * 32 + epi_r32), row = idx >> 3, ch = idx & 7;
                const u32x4 v = *(const LAS u32x4*)(ost + row * 128 + ch * 16);
                if (!gat) *(u32x4*)(Ow + (long)row * cur.os + ps * 64 + ch * 8) = v;
                else { const unsigned e = rt_l[row]; if (e != 0xFFFFFFFFu) *(u32x4*)(cur.O + ((long)(e >> 16) * NTOK + (long)(e & 0xFFFFu)) * GW + ps * 64 + ch * 8) = v; }
            }
            asm volatile("s_waitcnt lgkmcnt(0)" ::: "memory");
        }
        if (!gat) { if (cur.LSE != nullptr && hi == 0) cur.LSE[(long)(wid * QBLK + epi_r32) * cur.ls] = l_reg > 0.f ? m_reg + __builtin_amdgcn_logf(l_reg) : -1e30f; }
        else if (hi == 0 && ent_cur != 0xFFFFFFFFu) cur.LSE[((long)(ent_cur >> 16) * NTOK + (long)(ent_cur & 0xFFFFu)) * 4] = l_reg > 0.f ? m_reg + __builtin_amdgcn_logf(l_reg) : -1e30f;
    }
    if (tid == 0) qw[0] = qbase + (int)tk;
    __syncthreads();
#undef RESC
#undef KBASE
#undef ACT
#undef MASKT
#undef SEAM_K0
#undef HALF_STEP
}
#undef ROWP
#undef VMW
#undef VMWN
#undef SLOAD_H
#undef SWRITE_HK
#undef SWRITE_HV
#undef SWRITE_H
#undef KSWZ
#undef SBAR
}

constexpr int VROW = 288;
constexpr int WAVE_LDS = 10240;
constexpr int NG = 1;
constexpr int QW = 16 * NG;
constexpr int NPH = SEQ / QW;

__device__ __forceinline__ void load_q(h8 (&qf)[NG][4], const hf* qb, long qstride, int fr, int quad) {
#pragma unroll
    for (int g = 0; g < NG; ++g) { const hf* p = qb + (long)(16 * g + fr) * qstride + 8 * quad;
#pragma unroll
        for (int c = 0; c < 4; ++c) qf[g][c] = *(const h8*)(p + 32 * c); }
}
__device__ __forceinline__ void v_stage_load(h8 (&vs)[8], const hf* Vt, long stride, int rlo, int rhi, int fr, int quad) {
#pragma unroll
    for (int it = 0; it < 8; ++it) { int r = 4 * it + quad; r = r < rlo ? rlo : r; r = r > rhi ? rhi : r; vs[it] = *(const h8*)(Vt + (long)r * stride + 8 * fr); }
}
__device__ __forceinline__ void v_stage_store(const h8 (&vs)[8], LAS unsigned char* vl, int fr, int quad) {
#pragma unroll
    for (int it = 0; it < 8; ++it) *(LAS h8*)(vl + (4 * it + quad) * VROW + fr * 16) = vs[it];
}
__device__ __forceinline__ void pv_mma(f32x4 (&o)[NG][8], const h8 (&pf)[NG], LAS unsigned char* vl, int fr, int quad) {
    LAS unsigned char* base = vl + (4 * quad + (fr >> 2)) * VROW + 8 * (fr & 3);
#pragma unroll
    for (int dt = 0; dt < 8; ++dt) {
        const s16x4 a = __builtin_amdgcn_ds_read_tr16_b64_v4i16((LAS s16x4*)(base + 32 * dt));
        const s16x4 b = __builtin_amdgcn_ds_read_tr16_b64_v4i16((LAS s16x4*)(base + 16 * VROW + 32 * dt));
        const h4 x = __builtin_bit_cast(h4, a), y = __builtin_bit_cast(h4, b);
        const h8 vf = __builtin_shufflevector(x, y, 0, 1, 2, 3, 4, 5, 6, 7);
#pragma unroll
        for (int g = 0; g < NG; ++g) o[g][dt] = __builtin_amdgcn_mfma_f32_16x16x32_f16(vf, pf[g], o[g][dt], 0, 0, 0);
    }
}
struct AttnAcc { f32x4 o[NG][8]; float m[NG], l[NG]; };
__device__ __forceinline__ void attn_init(AttnAcc& a) {
#pragma unroll
    for (int g = 0; g < NG; ++g) { a.m[g] = -1e30f; a.l[g] = 0.f;
#pragma unroll
        for (int dt = 0; dt < 8; ++dt) a.o[g][dt] = (f32x4){0.f, 0.f, 0.f, 0.f}; }
}
template <class Mask>
__device__ __forceinline__ void attn_step(AttnAcc& a, const h8 (&qf)[NG][4], const hf* Kt, const hf* Vt, long stride, int rlo, int rhi, LAS unsigned char* vl, int fr, int quad, Mask mask) {
    __builtin_amdgcn_sched_barrier(0);
    f32x4 s[NG][2];
    {
        h8 kf[2][4];
#pragma unroll
        for (int kb = 0; kb < 2; ++kb) { int r = 16 * kb + fr; r = r < rlo ? rlo : r; r = r > rhi ? rhi : r; const hf* p = Kt + (long)r * stride + 8 * quad;
#pragma unroll
            for (int c = 0; c < 4; ++c) kf[kb][c] = *(const h8*)(p + 32 * c); }
#pragma unroll
        for (int g = 0; g < NG; ++g)
#pragma unroll
            for (int kb = 0; kb < 2; ++kb) { s[g][kb] = (f32x4){0.f, 0.f, 0.f, 0.f};
#pragma unroll
                for (int c = 0; c < 4; ++c) s[g][kb] = __builtin_amdgcn_mfma_f32_16x16x32_f16(kf[kb][c], qf[g][c], s[g][kb], 0, 0, 0); }
    }
    h8 vs[8];
    v_stage_load(vs, Vt, stride, rlo, rhi, fr, quad);
    h8 pf[NG];
#pragma unroll
    for (int g = 0; g < NG; ++g) {
        float mx = -3e38f;
#pragma unroll
        for (int kb = 0; kb < 2; ++kb)
#pragma unroll
            for (int r = 0; r < 4; ++r) { const float v = mask(g, kb, r) ? s[g][kb][r] : -3e38f; s[g][kb][r] = v; mx = fmaxf(mx, v); }
        { const int ln_ = quad * 16 + fr; mx = fmaxf(mx, shx_l(mx, ln_, 16)); mx = fmaxf(mx, shx_l(mx, ln_, 32)); }
        const float mn = fmaxf(a.m[g], mx), alpha = __builtin_amdgcn_exp2f(a.m[g] - mn);
        a.m[g] = mn; a.l[g] *= alpha;
#pragma unroll
        for (int dt = 0; dt < 8; ++dt) a.o[g][dt] = a.o[g][dt] * alpha;
        f32x4 p0, p1; float ps = 0.f;
#pragma unroll
        for (int r = 0; r < 4; ++r) { p0[r] = __builtin_amdgcn_exp2f(s[g][0][r] - mn); p1[r] = __builtin_amdgcn_exp2f(s[g][1][r] - mn); ps += p0[r] + p1[r]; }
        a.l[g] += ps;
        pf[g] = pack8(p0, p1);
    }
    v_stage_store(vs, vl, fr, quad);
    pv_mma(a.o, pf, vl, fr, quad);
    __builtin_amdgcn_sched_barrier(0);
}
__device__ __forceinline__ void attn_finish(AttnAcc& a, hf* ob, long ostride, float* lsep, long lstride, int fr, int quad) {
#pragma unroll
    for (int g = 0; g < NG; ++g) {
        float lt = a.l[g]; { const int ln_ = quad * 16 + fr; lt += shx_l(lt, ln_, 16); lt += shx_l(lt, ln_, 32); }
        const float inv = lt > 0.f ? 1.0f / lt : 0.f;
        hf* p = ob + (long)(16 * g + fr) * ostride + 4 * quad;
#pragma unroll
        for (int dt = 0; dt < 8; ++dt) { const f32x4 v = a.o[g][dt] * inv; *(h4*)(p + 16 * dt) = __builtin_convertvector(v, h4); }
        if (lsep != nullptr && quad == 0) lsep[(long)(16 * g + fr) * lstride] = lt > 0.f ? a.m[g] + __builtin_log2f(lt) : -1e30f;
    }
}

struct MixP {
    const hf* proj; const hf* kvmem; hf* oa; float* lsea; hf* ob; hf* ocp; float* lsec; hf* ox;
    const float* kpart; const f32x2* vstat; const hf* sguw; const float* sgurs; const float* sgub; const float* lng; const float* lnb;
};
constexpr int N_A = 3 * 8 * NPH, N_X = 8 * NPH, N_C = 40 * 8 * (256 / QW), N_B = 2 * 32 * 4 * (128 / QW);

__device__ __forceinline__ void item_A(const MixP& P, int idx, LAS unsigned char* vl, int fr, int quad) {
    asm volatile("" : "+v"(fr), "+v"(quad));
    const int p = idx / (8 * NPH), r10 = idx % (8 * NPH), b = r10 / (4 * NPH), h = (r10 / NPH) & 3, slot = r10 % NPH;
    const int dsh = 2 * p, d = 1 << dsh, cpr = NPH >> dsh, Lsub = SEQ >> dsh;
    const int res = slot / cpr, ch = slot % cpr, l0 = QW * ch;
    const long rowbase = (long)b * SEQ + res, stride = (long)d * NCOL;
    h8 qf[NG][4];
    load_q(qf, P.proj + (rowbase + (long)l0 * d) * NCOL + SL_AQ * GW + h * 128, stride, fr, quad);
    const hf* Kb = P.proj + rowbase * NCOL + SL_AK * GW + h * 128;
    const hf* Vb = P.proj + rowbase * NCOL + SL_AV * GW + h * 128;
    AttnAcc a; attn_init(a);
    constexpr int NST = (128 + QW + 31) / 32;
    for (int s = NST - 1; s >= 0; --s) {
        const int lk0 = l0 - 128 + 32 * s;
        if (lk0 + 31 < 0) break;
        const int rlo = lk0 < 0 ? -lk0 : 0, rhi = (Lsub - 1 - lk0) < 31 ? (Lsub - 1 - lk0) : 31;
        attn_step(a, qf, Kb + (long)lk0 * stride, Vb + (long)lk0 * stride, stride, rlo, rhi, vl, fr, quad,
                  [&](int g, int kb, int r) { const int lq = l0 + 16 * g + fr, lk = lk0 + 16 * kb + 4 * quad + r; return lk >= 0 && lk <= lq && lq - lk <= 128; });
    }
    const long orow = (long)p * NTOK + rowbase + (long)l0 * d;
    attn_finish(a, P.oa + orow * GW + h * 128, (long)d * GW, P.lsea + orow * 4 + h, (long)d * 4, fr, quad);
}
__device__ __forceinline__ void item_X(const MixP& P, int idx, LAS unsigned char* vl, int fr, int quad) {
    asm volatile("" : "+v"(fr), "+v"(quad));
    const int b = idx / (4 * NPH), h = (idx / NPH) & 3, ch = idx % NPH;
    const long row0 = (long)b * SEQ + QW * ch;
    h8 qf[NG][4];
    load_q(qf, P.proj + row0 * NCOL + SL_XQ * GW + h * 128, NCOL, fr, quad);
    const hf* Kb = P.kvmem + (long)b * NMEM * 1024 + h * 128;
    AttnAcc a; attn_init(a);
    for (int s = 0; s < 8; ++s)
        attn_step(a, qf, Kb + (long)(32 * s) * 1024, Kb + (long)(32 * s) * 1024 + GW, 1024, 0, 31, vl, fr, quad, [&](int, int, int) { return true; });
    attn_finish(a, P.ox + row0 * GW + h * 128, GW, nullptr, 0, fr, quad);
}
__device__ const unsigned char CTAB[40] = {60,61,62,63,56,57,58,52,53,54,48,49,50,44,45,46,40,41,36,37,32,33,28,29,24,20,16,12,59,42,25,8,55,38,21,4,51,34,17,0};
__device__ __forceinline__ void item_C(const MixP& P, int idx, LAS unsigned char* vl, int fr, int quad) {
    asm volatile("" : "+v"(fr), "+v"(quad));
    constexpr int NSUB = 256 / QW;
    const int e = idx / (8 * NSUB), rest = idx % (8 * NSUB), bh = rest / NSUB, sub = rest % NSUB, b = bh >> 2, h = bh & 3;
    const int code = CTAB[e], qblk = code >> 2, part = code & 3;
    const long row0 = (long)b * SEQ + qblk * 256 + sub * QW;
    h8 qf[NG][4];
    load_q(qf, P.proj + row0 * NCOL + SL_CQ * GW + h * 128, NCOL, fr, quad);
    unsigned sel[NG];
    {
        float v1[NG], v2[NG], v3[NG]; int i1[NG], i2[NG], i3[NG];
#pragma unroll
        for (int g = 0; g < NG; ++g) { v1[g] = v2[g] = v3[g] = -3e38f; i1[g] = i2[g] = i3[g] = -1; }
        for (int n = 0; n < qblk; ++n) {
            const float* k0 = P.kpart + (size_t)((b * 16 + n) * 2) * GW + h * 128 + 8 * quad;
            float dv[NG];
#pragma unroll
            for (int g = 0; g < NG; ++g) dv[g] = 0.f;
#pragma unroll
            for (int c = 0; c < 4; ++c) {
                const f32x4 ka = *(const f32x4*)(k0 + 32 * c) + *(const f32x4*)(k0 + GW + 32 * c);
                const f32x4 kb = *(const f32x4*)(k0 + 32 * c + 4) + *(const f32x4*)(k0 + GW + 32 * c + 4);
#pragma unroll
                for (int g = 0; g < NG; ++g)
#pragma unroll
                    for (int i = 0; i < 4; ++i) dv[g] += (float)qf[g][c][i] * ka[i] + (float)qf[g][c][4 + i] * kb[i];
            }
#pragma unroll
            for (int g = 0; g < NG; ++g) {
                float v = dv[g]; { const int ln_ = quad * 16 + fr; v += shx_l(v, ln_, 16); v += shx_l(v, ln_, 32); }
                if (v > v1[g]) { v3[g] = v2[g]; i3[g] = i2[g]; v2[g] = v1[g]; i2[g] = i1[g]; v1[g] = v; i1[g] = n; }
                else if (v > v2[g]) { v3[g] = v2[g]; i3[g] = i2[g]; v2[g] = v; i2[g] = n; }
                else if (v > v3[g]) { v3[g] = v; i3[g] = n; }
            }
        }
#pragma unroll
        for (int g = 0; g < NG; ++g) sel[g] = (i1[g] >= 0 ? 1u << i1[g] : 0u) | (i2[g] >= 0 ? 1u << i2[g] : 0u) | (i3[g] >= 0 ? 1u << i3[g] : 0u);
    }
    unsigned selany = 0u;
#pragma unroll
    for (int g = 0; g < NG; ++g) selany |= sel[g];
    AttnAcc a; attn_init(a);
    const int nlo = 4 * part, nhi = (4 * part + 3 < qblk) ? 4 * part + 3 : qblk;
    for (int n = nlo; n <= nhi; ++n) {
        const hf* Kb = P.proj + ((long)b * SEQ + n * 256) * NCOL + SL_CK * GW + h * 128;
        if (n == qblk) {
            const int tlmax = (QW * sub + QW - 1) >> 5;
            for (int tl = 0; tl <= tlmax; ++tl)
                attn_step(a, qf, Kb + (long)(32 * tl) * NCOL, Kb + (long)(32 * tl) * NCOL + GW, NCOL, 0, 31, vl, fr, quad,
                          [&](int g, int kb, int r) { return 32 * tl + 16 * kb + 4 * quad + r <= QW * sub + 16 * g + fr; });
        } else {
            const bool any = __any((int)((selany >> n) & 1u));
            if (any) {
                for (int tl = 0; tl < 8; ++tl)
                    attn_step(a, qf, Kb + (long)(32 * tl) * NCOL, Kb + (long)(32 * tl) * NCOL + GW, NCOL, 0, 31, vl, fr, quad,
                              [&](int g, int, int) { return ((sel[g] >> n) & 1u) != 0u; });
            }
        }
    }
    const long orow = (long)part * NTOK + row0;
    attn_finish(a, P.ocp + orow * GW + h * 128, GW, P.lsec + orow * 4 + h, 4, fr, quad);
}
__device__ __forceinline__ void item_B(const MixP& P, int idx, LAS unsigned char* vl, int lane, int fr, int quad) {
    asm volatile("" : "+v"(lane)); fr = lane & 15; quad = lane >> 4;
    constexpr int NIG = 128 / QW;
    const int ig = NIG - 1 - (idx >> 8), rest = idx & 255, b = rest >> 7, chunk = (rest >> 2) & 31, g = rest & 3;
    const int smax = (QW * ig + QW - 1) >> 5;
    const long tok0 = (long)b * SEQ + chunk * 128;
    LAS f32x2* stl = (LAS f32x2*)(vl + 32 * VROW);
#pragma unroll
    for (int k = 0; k < 2; ++k) { const int tt = lane + 64 * k;
        if (tt < 32 * (smax + 1)) { const f32x2* sp = P.vstat + (size_t)(tok0 + tt) * 8; float s1 = 0.f, s2 = 0.f;
#pragma unroll
            for (int q = 0; q < 8; ++q) { const f32x2 v = sp[q]; s1 += v.x; s2 += v.y; }
            const float mu = s1 * (1.0f / 512.0f), var = fmaxf(s2 * (1.0f / 512.0f) - mu * mu, 0.f);
            stl[tt] = (f32x2){mu, __builtin_amdgcn_rsqf(var + NORM_EPS)}; } }
    AttnAcc a; attn_init(a);
    float aacc[NG];
#pragma unroll
    for (int g2 = 0; g2 < NG; ++g2) aacc[g2] = 0.f;
    const hf* Vb = P.proj + tok0 * NCOL + SL_BV * GW + g * 128;
    h8 vsa[4][8];
#pragma unroll
    for (int s = 0; s < 4; ++s) if (s <= smax) v_stage_load(vsa[s], Vb + (long)(32 * s) * NCOL, NCOL, 0, 31, fr, quad);
#pragma unroll
    for (int s = 0; s < 4; ++s) { if (s <= smax) {
        const int j0 = 32 * s;
        h8 (&vs)[8] = vsa[s];
        h8 pf[NG];
#pragma unroll
        for (int g2 = 0; g2 < NG; ++g2) {
            const int i = QW * ig + 16 * g2 + fr;
            f32x4 pv[2];
#pragma unroll
            for (int kb = 0; kb < 2; ++kb) { const int j = j0 + 16 * kb + 4 * quad;
                const h4 w = *(const h4*)(P.sguw + ((size_t)(g * 128 + i)) * 128 + j);
#pragma unroll
                for (int r = 0; r < 4; ++r) { const f32x2 st = stl[j + r]; pv[kb][r] = (float)w[r] * st.y; } }
            pf[g2] = pack8(pv[0], pv[1]);
#pragma unroll
            for (int kb = 0; kb < 2; ++kb)
#pragma unroll
                for (int r = 0; r < 4; ++r) aacc[g2] += (float)pf[g2][4 * kb + r] * stl[j0 + 16 * kb + 4 * quad + r].x;
        }
        v_stage_store(vs, vl, fr, quad);
        pv_mma(a.o, pf, vl, fr, quad);
    } }
#pragma unroll
    for (int g2 = 0; g2 < NG; ++g2) {
        float as = aacc[g2]; as += shx_l(as, lane, 16); as += shx_l(as, lane, 32);
        const int i = QW * ig + 16 * g2 + fr;
        const float rs = P.sgurs[g * 128 + i], bs = P.sgub[g * 128 + i];
        const hf* up = P.proj + (tok0 + i) * NCOL + SL_BU * GW + g * 128 + 4 * quad;
        hf* op = P.ob + (tok0 + i) * GW + g * 128 + 4 * quad;
#pragma unroll
        for (int dt = 0; dt < 8; ++dt) {
            const f32x4 gm = *(const f32x4*)(P.lng + g * 128 + 16 * dt + 4 * quad), bt = *(const f32x4*)(P.lnb + g * 128 + 16 * dt + 4 * quad);
            const h4 u = *(const h4*)(up + 16 * dt);
            f32x4 o;
#pragma unroll
            for (int r = 0; r < 4; ++r) o[r] = (float)u[r] * (gm[r] * (a.o[g2][dt][r] - as) + bt[r] * rs + bs);
            *(h4*)(op + 16 * dt) = __builtin_convertvector(o, h4);
        }
    }
}

struct Args { const float* in[14]; float* out; unsigned char* ws; int ph_lo, ph_hi; };

__device__ __forceinline__ int win_phys_row(int n) {
    const int slice = n >> 9, ch = n & 511;
    if (slice == SL_AQ || slice == SL_AK || slice == SL_CQ || slice == SL_CK) { const int d = n & 127, dd = d & 63; return (n & ~127) + 8 * (dd >> 2) + (d >= 64 ? 4 : 0) + (dd & 3); }
    if (slice == SL_BU) return 4 * 512 + (ch >> 2) * 8 + (ch & 3);
    if (slice == SL_BG) return 4 * 512 + (ch >> 2) * 8 + 4 + (ch & 3);
    if (slice == SL_BV) return 6 * 512 + ch;
    if (slice == SL_DB) return 11 * 512 + (ch >> 2) * 8 + (ch & 3);
    if (slice == SL_DG) return 11 * 512 + (ch >> 2) * 8 + 4 + (ch & 3);
    if (slice == SL_DC) return 13 * 512 + (ch >> 2) * 8 + (ch & 3);
    if (slice == SL_DH) return 13 * 512 + (ch >> 2) * 8 + 4 + (ch & 3);
    return n;
}
__device__ __forceinline__ void rms_row(const float* xrow, const float* g, hf* oh, float* of, int lane) {
    f32x4 v[8]; float ss = 0.f;
#pragma unroll
    for (int j = 0; j < 8; ++j) { v[j] = *(const f32x4*)(xrow + 4 * (lane + 64 * j)); ss += v[j][0] * v[j][0] + v[j][1] * v[j][1] + v[j][2] * v[j][2] + v[j][3] * v[j][3]; }
    const float r = __builtin_amdgcn_rsqf(wave_sum(ss, lane) * (1.0f / DM) + NORM_EPS);
#pragma unroll
    for (int j = 0; j < 8; ++j) { const f32x4 gg = *(const f32x4*)(g + 4 * (lane + 64 * j)); const f32x4 o = v[j] * r * gg;
        if (oh) *(h4*)(oh + 4 * (lane + 64 * j)) = __builtin_convertvector(o, h4); else *(f32x4*)(of + 4 * (lane + 64 * j)) = o; }
}

#define CAS __attribute__((address_space(4)))
#define KA_BEGIN() const CAS Args* ka = (const CAS Args*)__builtin_amdgcn_kernarg_segment_ptr(); asm volatile("" : "+s"(ka)); \
    int tid_ = threadIdx.x; asm volatile("" : "+v"(tid_)); const int lane = tid_ & 63; \
    const int wave = __builtin_amdgcn_readfirstlane(tid_ >> 6), fr = lane & 15, quad = lane >> 4; \
    const int G = gridDim.x, gw = blockIdx.x * NWAVES + wave, NGW = G * NWAVES; unsigned char* ws = ka->ws; \
    (void)fr; (void)quad; (void)gw; (void)NGW; (void)ws

struct ConvDesc { const float* W; hf* WT; const float* kscale; int K, N, k0, n0; bool perm; bool f8; };
constexpr int CT_IN = (DM / 128) * (NCOL / 128), CT_OUT = (MIXW / 128) * (DM / 128), CT_MEM = (DM / 128) * (1024 / 128), CT_ALL = CT_IN + CT_OUT + CT_MEM;
__device__ __forceinline__ ConvDesc ctile_decode(int it, const float* w_in, const float* w_out, const float* w_mem_kv, hf* winT, hf* woutT, hf* wmemT, const float* norm_g, unsigned char* ws = nullptr) {
    const int l = it >= CT_ALL ? 1 : 0; int r = it - l * CT_ALL; ConvDesc d;
    if (r < CT_IN) { d.W = w_in + (size_t)l * DM * NCOL; d.WT = winT + (size_t)l * NCOL * DM; d.K = DM; d.N = NCOL; d.perm = true; d.kscale = norm_g + l * DM; d.f8 = false; }
    else if (r < CT_IN + CT_OUT) { r -= CT_IN; d.W = w_out + (size_t)l * MIXW * DM; d.WT = (hf*)((unsigned char*)woutT + (size_t)l * DM * MIXW * 2); d.K = MIXW; d.N = DM; d.perm = false; d.kscale = nullptr; d.f8 = F8_OUT_L(l); }
    else { r -= CT_IN + CT_OUT; d.W = w_mem_kv + (size_t)l * DM * 1024; d.WT = wmemT + (size_t)l * 1024 * DM; d.K = DM; d.N = 1024; d.perm = false; d.kscale = nullptr; d.f8 = false; }
    const int nblk = d.N / 128; d.k0 = 128 * (r / nblk); d.n0 = 128 * (r % nblk);
    if (d.perm && F8_PROJ_L(l)) d.f8 = true;
    return d;
}
__device__ __forceinline__ void ctile_load(f32x4 (&v)[8], const ConvDesc& d, int tid) {
    const float* p = d.W + (size_t)(d.k0 + (tid >> 5)) * d.N + d.n0 + 4 * (tid & 31);
#pragma unroll
    for (int i = 0; i < 8; ++i) v[i] = __builtin_nontemporal_load((const f32x4*)(p + (size_t)(16 * i) * d.N));
}
__device__ __forceinline__ void ctile_store(const f32x4 (&v)[8], const ConvDesc& d, LAS float* t129, int tid) {
    { LAS float* s = t129 + (tid >> 5) * 129 + 4 * (tid & 31);
#pragma unroll
      for (int i = 0; i < 8; ++i) { s[(16 * i) * 129 + 0] = v[i][0]; s[(16 * i) * 129 + 1] = v[i][1]; s[(16 * i) * 129 + 2] = v[i][2]; s[(16 * i) * 129 + 3] = v[i][3]; } }
    __syncthreads();
    const int c = tid & 15;
    f32x4 ga = (f32x4){1.f, 1.f, 1.f, 1.f}, gb = ga;
    if (d.kscale) { ga = *(const f32x4*)(d.kscale + d.k0 + 8 * c); gb = *(const f32x4*)(d.kscale + d.k0 + 8 * c + 4); }
#pragma unroll
    for (int j = 0; j < 4; ++j) { const int n = (tid >> 4) + 32 * j; const LAS float* s = t129 + (8 * c) * 129 + n;
        const f32x4 a = (f32x4){s[0], s[129], s[258], s[387]} * ga, b = (f32x4){s[516], s[645], s[774], s[903]} * gb;
        const int nr = d.perm ? win_phys_row(d.n0 + n) : (d.n0 + n);
        if (d.f8) *(u32x2*)((unsigned char*)d.WT + (size_t)nr * d.K + d.k0 + 8 * c) = pk8_f8(a * W8_SCALE, b * W8_SCALE);
        else *(h8*)(d.WT + (size_t)nr * d.K + d.k0 + 8 * c) = pack8(a, b); }
    __syncthreads();
}
constexpr int SKP = DM + 2, N_STRIP = NCOL / 32;
struct StripHalf { f32x4 v[16]; float g[16]; };
__device__ __forceinline__ void strip_issue(StripHalf& R, const float* W, const float* g, int cb, int h, int tid) {
    const int col4 = tid & 7, krow = tid >> 3;
    const float* p = W + (size_t)(krow + 1024 * h) * NCOL + 32 * cb + 4 * col4;
#pragma unroll
    for (int i = 0; i < 16; ++i) { R.v[i] = __builtin_nontemporal_load((const f32x4*)(p + (size_t)(64 * i) * NCOL)); R.g[i] = g[krow + 1024 * h + 64 * i]; }
}
__device__ __forceinline__ void strip_put(const StripHalf& R, f32x4& pm, LAS unsigned char* lds, int h, int tid) {
    LAS hf* keep = (LAS hf*)lds; const int col4 = tid & 7, krow = tid >> 3;
#pragma unroll
    for (int i = 0; i < 16; ++i) { const int k = krow + 1024 * h + 64 * i;
#pragma unroll
        for (int c = 0; c < 4; ++c) { const hf hv = (hf)(R.v[i][c] * R.g[i]); keep[(4 * col4 + c) * SKP + k] = hv; pm[c] = fmaxf(pm[c], fabsf((float)hv)); } }
}
__device__ __forceinline__ void strip_finish(const f32x4 pm, unsigned char* WT8, float* sw, int cb, LAS unsigned char* lds, int tid) {
    LAS hf* keep = (LAS hf*)lds;
    LAS float* red = (LAS float*)(lds + 32 * SKP * 2);
    const int col4 = tid & 7, krow = tid >> 3;
    *(LAS f32x4*)(red + krow * 32 + 4 * col4) = pm;
    __syncthreads();
    if (tid < 32) { float m = 0.f;
#pragma unroll 8
        for (int r = 0; r < 64; ++r) m = fmaxf(m, red[r * 32 + tid]);
        red[2048 + tid] = m; }
    __syncthreads();
    const int n = tid >> 4, c = tid & 15;
    const float cm = fmaxf(red[2048 + n], 1e-30f);
    const hf invh = (hf)fminf(127.0f / cm, 60000.0f);
    const att::h2 inv2 = {invh, invh}, mg2 = {(hf)1536.0f, (hf)1536.0f};
    const int nr = win_phys_row(32 * cb + n);
    unsigned char* dst = WT8 + (size_t)nr * DM + 8 * c;
    const LAS unsigned* srcw = (const LAS unsigned*)(keep + n * SKP + 8 * c);
#pragma unroll 4
    for (int j = 0; j < 16; ++j) { unsigned t[4];
#pragma unroll
        for (int q = 0; q < 4; ++q) t[q] = __builtin_bit_cast(unsigned, __builtin_elementwise_fma(__builtin_bit_cast(att::h2, srcw[64 * j + q]), inv2, mg2));
        *(u32x2*)(dst + 128 * j) = (u32x2){__builtin_amdgcn_perm(t[1], t[0], 0x06040200u), __builtin_amdgcn_perm(t[3], t[2], 0x06040200u)}; }
    if (c == 0) sw[nr] = 1.0f / (float)invh;
    __syncthreads();
}
__device__ __forceinline__ void strip_i8(const float* W, const float* g, unsigned char* WT8, float* sw, int cb, LAS unsigned char* lds, int tid) {
    StripHalf A, B; strip_issue(A, W, g, cb, 0, tid); strip_issue(B, W, g, cb, 1, tid);
    f32x4 pm = (f32x4){0.f, 0.f, 0.f, 0.f};
    strip_put(A, pm, lds, 0, tid); strip_put(B, pm, lds, 1, tid);
    strip_finish(pm, WT8, sw, cb, lds, tid);
}
__device__ const double ROPE_REV[64] = {0.15915494309189535,0.13782250260398285,0.11934937021124886,0.10335229661843406,0.08949940160889101,0.07750328875537406,0.06711508300522726,0.058119267441876246,0.050329212104487035,0.04358330210530733,0.03774158471741977,0.032682865872357,0.0283021958306234,0.024508691862069852,0.02122365276477766,0.018378926105679667,0.015915494309189534,0.013782250260398284,0.011934937021124886,0.010335229661843406,0.008949940160889102,0.0077503288755374055,0.006711508300522725,0.005811926744187624,0.005032921210448704,0.004358330210530733,0.003774158471741977,0.0032682865872356993,0.00283021958306234,0.002450869186206985,0.0021223652764777662,0.0018378926105679667,0.0015915494309189536,0.0013782250260398288,0.0011934937021124885,0.0010335229661843405,0.0008949940160889102,0.0007750328875537405,0.0006711508300522726,0.0005811926744187624,0.0005032921210448703,0.0004358330210530733,0.00037741584717419774,0.0003268286587235699,0.00028302195830623395,0.00024508691862069854,0.0002122365276477766,0.00018378926105679666,0.00015915494309189535,0.00013782250260398286,0.00011934937021124886,0.00010335229661843406,8.949940160889102e-05,7.750328875537406e-05,6.711508300522725e-05,5.811926744187624e-05,5.0329212104487035e-05,4.358330210530732e-05,3.774158471741978e-05,3.2682865872357e-05,2.8302195830623396e-05,2.4508691862069852e-05,2.122365276477766e-05,1.8378926105679668e-05};
__device__ __forceinline__ void phase_prologue(LAS unsigned char* lds) {
    KA_BEGIN();
    const float* x = ka->in[0]; const float* mem = ka->in[1]; const float* norm_g = ka->in[2]; const float* w_in = ka->in[3];
    const float* sgu_w = ka->in[4]; const float* mem_norm_g = ka->in[9]; const float* w_mem_kv = ka->in[10]; const float* w_out = ka->in[12];
    float* cosT = (float*)(ws + WS_ROPE); float* sinT = cosT + SEQ * 64;
    hf* sguw = (hf*)(ws + WS_SGUW); float* sgurs = (float*)(ws + WS_SGUW + 512 * 1024);
    hf* memn = (hf*)(ws + WS_MEMN); hf* wmemT = (hf*)(ws + WS_WMEMT); hf* woutT = (hf*)(ws + WS_WOUTT); hf* winT = (hf*)(ws + WS_WINT); hf* xn = (hf*)(ws + WS_XN);
    LAS float* scr = (LAS float*)(lds + wave * 16384);
    {
        int tid_c = wave * 64 + lane;
        LAS float* t129 = (LAS float*)lds;
        f32x4 va[8], vb[8];
#define CT_DEC(i_) ctile_decode((i_), w_in, w_out, w_mem_kv, winT, woutT, wmemT, norm_g, ws)
        for (int s = blockIdx.x; s < N_STRIP; s += G) { const int l = 0, cb = s;
            strip_i8(w_in + (size_t)l * DM * NCOL, norm_g + l * DM, ws + WS_WINT + (size_t)l * NCOL * DM * 2, (float*)(ws + WS_SW) + l * NCOL, cb, lds, tid_c); }
        {
            constexpr int NT0 = CT_OUT + CT_MEM, END_ = NT0 + CT_MEM;
            int XS = N_STRIP - G; if (XS < 0 || XS >= G) XS = 0;
            const int GP = G - XS;
#define IT_OF(j_) ((j_) < NT0 ? CT_IN + (j_) : CT_ALL + CT_IN + CT_OUT + ((j_) - NT0))
            int a = (int)blockIdx.x >= XS ? (int)blockIdx.x - XS : END_;
            ConvDesc da = CT_DEC(IT_OF(a < END_ ? a : 0)), db = da;
            if (a < END_) ctile_load(va, da, tid_c);
            while (a < END_) {
                const int b_ = a + GP;
                if (b_ < END_) { db = CT_DEC(IT_OF(b_)); ctile_load(vb, db, tid_c); }
                ctile_store(va, da, t129, tid_c);
                if (b_ >= END_) break;
                a = b_ + GP;
                if (a < END_) { da = CT_DEC(IT_OF(a)); ctile_load(va, da, tid_c); }
                ctile_store(vb, db, t129, tid_c);
            }
#undef IT_OF
        }
    }
    for (int e = blockIdx.x * 512 + wave * 64 + lane; e < SEQ * 64; e += G * 512) {
        const int t = e >> 6, i = e & 63;
        const double rev = (double)t * ROPE_REV[i];
        const float f = (float)(rev - floor(rev));
        cosT[e] = __builtin_amdgcn_cosf(f); sinT[e] = __builtin_amdgcn_sinf(f);
    }
    for (int rw = gw; rw < 2 * 4 * 128; rw += NGW) {
        const int i = rw & 127; const float* wr_ = sgu_w + (size_t)rw * 128; float s = 0.f;
#pragma unroll
        for (int k = 0; k < 2; ++k) { const int j = lane + 64 * k; const float w = (j <= i) ? wr_[j] : 0.f; s += w; sguw[(size_t)rw * 128 + j] = (hf)w; }
        s = wave_sum(s, lane); if (lane == 0) sgurs[rw] = s;
    }
    for (int m0 = gw; m0 < NTOK; m0 += 4 * NGW) {
        f32x4 xv[4][8];
#pragma unroll
        for (int r = 0; r < 4; ++r) { const int m = m0 + r * NGW;
            if (m < NTOK) {
#pragma unroll
                for (int j = 0; j < 8; ++j) xv[r][j] = __builtin_nontemporal_load((const f32x4*)(x + (size_t)m * DM + 4 * (lane + 64 * j))); } }
#pragma unroll
        for (int r = 0; r < 4; ++r) { const int m = m0 + r * NGW;
            if (m < NTOK) { float ss = 0.f;
#pragma unroll
                for (int j = 0; j < 8; ++j) { const f32x4 v = xv[r][j]; ss += v[0] * v[0] + v[1] * v[1] + v[2] * v[2] + v[3] * v[3];
                    if (F8_PROJ_L(0)) *(unsigned*)(ws + WS_XN8 + (size_t)m * DM + 4 * (lane + 64 * j)) = pk4_f8(v * A8_SCALE);
                    if (!I8_PROJ_L(0)) *(h4*)(xn + (size_t)m * DM + 4 * (lane + 64 * j)) = __builtin_convertvector(v, h4); }
                if (I8_PROJ_L(0)) {
                    float mx = 0.f;
#pragma unroll
                    for (int j = 0; j < 8; ++j) { const f32x4 v = xv[r][j]; mx = fmaxf(fmaxf(mx, fmaxf(fabsf(v[0]), fabsf(v[1]))), fmaxf(fabsf(v[2]), fabsf(v[3]))); }
#pragma unroll
                    for (int o_ = 1; o_ < 64; o_ <<= 1) mx = fmaxf(mx, shx_l(mx, lane, o_));
                    mx = fmaxf(mx, 1e-30f); const float inv = 127.0f / mx;
#pragma unroll
                    for (int j = 0; j < 8; ++j) { const f32x4 v = xv[r][j] * inv; unsigned w = 0u;
#pragma unroll
                        for (int i = 0; i < 4; ++i) w |= ((unsigned)(int)__builtin_rintf(v[i]) & 255u) << (8 * i);
                        *(unsigned*)(ws + WS_XN8 + (size_t)m * DM + 4 * (lane + 64 * j)) = w; }
                    if (lane == 0) ((float*)(ws + WS_SA))[m] = mx * (1.0f / 127.0f);
                }
                ss = wave_sum(ss, lane);
                float* ssp = (float*)(ws + WS_ROWSS) + (size_t)m * 8; if (lane < 8) ssp[lane] = lane == 0 ? ss : 0.f; } }
    }
    for (int m = gw; m < 2 * 512; m += NGW) { const int l = m >> 9, r = m & 511; rms_row(mem + (size_t)r * DM, mem_norm_g + l * DM, memn + (size_t)m * DM, nullptr, lane); }
#undef CT_DEC
}

__device__ __forceinline__ void phase_proj(LAS unsigned char* lds, int L) {
    {
        KA_BEGIN();
        pg8::Gemm g{(F8_PROJ_L(L) || I8_PROJ_L(L)) ? (const void*)(ws + WS_XN8) : (const void*)(ws + WS_XN), ws + WS_WINT + (size_t)L * NCOL * DM * 2, NTOK, PROJ_N1, DM}; pg8::StaticOrder S; S.init(NTOK, PROJ_N1, G, (int)blockIdx.x);
        float* cosT = (float*)(ws + WS_ROPE);
        LAS float* rtab = (LAS float*)(lds + LDS_RSC_OFF); pg8::Unit u0; S.next(0, u0);
        { int t = tid_; if (t < 256) { const float* rp = (const float*)(ws + WS_ROWSS) + (size_t)(u0.pm * pg8::BM + t) * 8; const f32x4 pa = *(const f32x4*)rp, pb = *(const f32x4*)(rp + 4);
            float rs_ = __builtin_amdgcn_rsqf(((pa[0] + pa[1]) + (pa[2] + pa[3]) + (pb[0] + pb[1]) + (pb[2] + pb[3])) * (1.0f / DM) + NORM_EPS);
            if (I8_PROJ_L(L)) rs_ *= ((const float*)(ws + WS_SA))[u0.pm * pg8::BM + t];
            rtab[t] = rs_; } }
        __syncthreads();
        pg8::EpiProj E{(hf*)(ws + WS_PROJ), cosT, cosT + SEQ * 64, (float*)(ws + WS_KPART), (f32x2*)(ws + WS_VSTAT), (const float*)(ws + WS_ROWSS), (hf*)(ws + WS_HM), (const float*)nullptr, I8_PROJ_L(L) ? (const float*)(ws + WS_SW) + L * NCOL : (const float*)nullptr, rtab, u0.pm};
#if I8_PROJ == 3
        pg8::gemm_phase<pg8::EpiProj, pg8::StaticOrder, true, true, 2>(lds, g, S, E);
#else
        if (I8_PROJ_L(L)) pg8::gemm_phase<pg8::EpiProj, pg8::StaticOrder, true, true, 2>(lds, g, S, E);
        else if (F8_PROJ_L(L)) pg8::gemm_phase<pg8::EpiProj, pg8::StaticOrder, true, true, 1>(lds, g, S, E);
        else pg8::gemm_phase<pg8::EpiProj, pg8::StaticOrder, true, true, 0>(lds, g, S, E);
#endif
    }
}

__device__ __forceinline__ void memkv_tile(int tl, LAS unsigned char* lds) {
    KA_BEGIN();
    const hf* memn = (const hf*)(ws + WS_MEMN); const hf* wmemT = (const hf*)(ws + WS_WMEMT); hf* kvmem = (hf*)(ws + WS_KVMEM);
    const int l = tl >> 7, r = tl & 127, mt = r >> 4, nt = r & 15, m0 = mt * 64, n0 = nt * 64;
    const hf* ap = memn + ((size_t)l * 512 + m0 + fr) * DM + wave * 256 + 8 * quad;
    const hf* bp = wmemT + ((size_t)l * 1024 + n0 + fr) * DM + wave * 256 + 8 * quad;
    f32x4 c[4][4];
#pragma unroll
    for (int ni = 0; ni < 4; ++ni)
#pragma unroll
        for (int mi = 0; mi < 4; ++mi) c[ni][mi] = (f32x4){0.f, 0.f, 0.f, 0.f};
#pragma unroll 2
    for (int kk = 0; kk < 8; ++kk) {
        h8 av[4], bv[4];
#pragma unroll
        for (int i = 0; i < 4; ++i) { av[i] = *(const h8*)(ap + (size_t)(16 * i) * DM + 32 * kk); bv[i] = *(const h8*)(bp + (size_t)(16 * i) * DM + 32 * kk); }
#pragma unroll
        for (int ni = 0; ni < 4; ++ni)
#pragma unroll
            for (int mi = 0; mi < 4; ++mi) c[ni][mi] = __builtin_amdgcn_mfma_f32_16x16x32_f16(bv[ni], av[mi], c[ni][mi], 0, 0, 0);
    }
    LAS float* red = (LAS float*)lds + wave * 4096;
#pragma unroll
    for (int ni = 0; ni < 4; ++ni)
#pragma unroll
        for (int mi = 0; mi < 4; ++mi) *(LAS f32x4*)(red + (16 * mi + fr) * 64 + 16 * ni + 4 * quad) = c[ni][mi];
    __syncthreads();
    { const int t = wave * 64 + lane, m = t >> 3, n8 = (t & 7) * 8;
      f32x4 s0 = (f32x4){0.f, 0.f, 0.f, 0.f}, s1 = s0;
#pragma unroll
      for (int w = 0; w < 8; ++w) { const LAS float* p = (const LAS float*)lds + w * 4096 + m * 64 + n8; s0 += *(const LAS f32x4*)p; s1 += *(const LAS f32x4*)(p + 4); }
      const h8 hv = pack8(s0, s1); const unsigned long long* q2 = (const unsigned long long*)&hv; unsigned long long* dst = (unsigned long long*)(kvmem + ((size_t)l * 512 + m0 + m) * 1024 + n0 + n8);
      __hip_atomic_store(dst, q2[0], __ATOMIC_RELAXED, __HIP_MEMORY_SCOPE_AGENT); __hip_atomic_store(dst + 1, q2[1], __ATOMIC_RELAXED, __HIP_MEMORY_SCOPE_AGENT); }
    asm volatile("s_waitcnt vmcnt(0)" ::: "memory");
    __syncthreads();
    if (threadIdx.x == 0) __hip_atomic_fetch_add((unsigned*)(ws + WS_CTL) + CW_BAR + 48, 1u, __ATOMIC_RELAXED, __HIP_MEMORY_SCOPE_AGENT);
}

__device__ __forceinline__ void moba_gate_item(int g, unsigned char* ws, int L, LAS unsigned char* lds) {
    int tid = threadIdx.x; asm volatile("" : "+v"(tid));
    const int wid = __builtin_amdgcn_readfirstlane(tid >> 6), lane = tid & 63, r32 = lane & 31, hi = lane >> 5;
    const int bh = g & 7, qblk = g >> 3, b = bh >> 2, h = bh & 3;
    const int pos = qblk * 256 + wid * 32 + r32;
    float* lsec = (float*)(ws + WS_LSE + MiB) + ((size_t)b * SEQ) * 4 + h;
    {
        if (tid < 256) for (int s = (qblk < 3 ? qblk : 3); s < 3; ++s) __hip_atomic_store(&lsec[((size_t)s * NTOK + qblk * 256 + tid) * 4], -1e30f, __ATOMIC_RELAXED, __HIP_MEMORY_SCOPE_AGENT);
    }
    if (qblk > 0) {
        const hf* Q = (const hf*)(ws + WS_HM) + 3 * (size_t)NTOK * GW + ((size_t)(b * 4 + h) * SEQ + pos) * 128;
        h8 qr[8];
#pragma unroll
        for (int d0 = 0; d0 < 8; ++d0) qr[d0] = *(const h8*)(Q + d0 * 16 + hi * 8);
        const float* ksum = (const float*)(ws + WS_KPART) + (size_t)(b * 16 * 2) * GW + h * 128;
        LAS float* ksl = (LAS float*)(lds + att::LDS_KSUM);
        { const int n = tid >> 5, d4 = (tid & 31) * 4;
          if (n < qblk) { const float* kp = ksum + (size_t)(n * 2) * GW + d4; *(LAS f32x4*)(ksl + n * 128 + d4) = *(const f32x4*)kp + *(const f32x4*)(kp + GW); } }
        __syncthreads();
        float v1 = -3e38f, v2 = -3e38f, v3 = -3e38f; int i1 = -1, i2 = -1, i3 = -1;
        for (int n = 0; n < qblk; ++n) {
            const LAS float* kr = ksl + n * 128 + hi * 8; float dv = 0.f;
#pragma unroll
            for (int d0 = 0; d0 < 8; ++d0) { const f32x4 ka = *(const LAS f32x4*)(kr + d0 * 16), kb = *(const LAS f32x4*)(kr + d0 * 16 + 4);
#pragma unroll
                for (int i = 0; i < 4; ++i) dv += (float)qr[d0][i] * ka[i] + (float)qr[d0][4 + i] * kb[i]; }
            dv += shx_l(dv, lane, 32);
            if (dv > v1) { v3 = v2; i3 = i2; v2 = v1; i2 = i1; v1 = dv; i1 = n; }
            else if (dv > v2) { v3 = v2; i3 = i2; v2 = dv; i2 = n; }
            else if (dv > v3) { v3 = dv; i3 = n; }
        }
        const unsigned sel = (i1 >= 0 ? 1u << i1 : 0u) | (i2 >= 0 ? 1u << i2 : 0u) | (i3 >= 0 ? 1u << i3 : 0u);
        unsigned* cnt = (unsigned*)(ws + WS_CTL) + CW_CNT + L * 128 + bh * 16;
        unsigned* list = (unsigned*)(ws + WS_LIST) + (size_t)bh * 16 * SEQ;
        unsigned basev[16];
#pragma unroll
        for (int n = 0; n < 16; ++n) { basev[n] = 0u;
            if (n < qblk) {
                const bool pred = (hi == 0) && (((sel >> n) & 1u) != 0u);
                const unsigned long long m = __ballot(pred);
                if (m != 0ull && lane == __ffsll((unsigned long long)m) - 1) basev[n] = __hip_atomic_fetch_add(cnt + n, (unsigned)__popcll(m), __ATOMIC_RELAXED, __HIP_MEMORY_SCOPE_AGENT);
            } }
#pragma unroll
        for (int n = 0; n < 16; ++n) {
            if (n < qblk) {
                const bool pred = (hi == 0) && (((sel >> n) & 1u) != 0u);
                const unsigned long long m = __ballot(pred);
                if (m != 0ull) {
                    const int leader = __ffsll((unsigned long long)m) - 1;
                    const unsigned base = (unsigned)__builtin_amdgcn_readlane((int)basev[n], leader);
                    if (pred) { const unsigned off = (unsigned)__popcll(m & ((1ull << lane) - 1ull)); const unsigned slot = (unsigned)__popc(sel & ((1u << n) - 1u));
                        __hip_atomic_store(&list[(size_t)n * SEQ + base + off], (unsigned)pos | (slot << 16), __ATOMIC_RELAXED, __HIP_MEMORY_SCOPE_AGENT); }
                }
            } }
    }
    asm volatile("s_waitcnt vmcnt(0)" ::: "memory");
    __syncthreads();
    if (tid == 0) __hip_atomic_fetch_add((unsigned*)(ws + WS_CTL) + CW_BAR + 32 + 64 * L, 1u, __ATOMIC_RELAXED, __HIP_MEMORY_SCOPE_AGENT);
}

constexpr int NI_G = 64, NI_K = 256, NI_M = 128, NI_C = 128, NI_A = 3 * 8 * 16, NI_X = 8 * 16, NI_B = N_B / 8;
constexpr int NI_F = N_STRIP + CT_OUT / 8;
constexpr int LDS_Q_OFF = 145408 + 64;
constexpr int LDS_GTAB = att::LDS_KSUM;
__device__ __forceinline__ att::BlkRef mix_decode(int Li, unsigned char* ws, int L) {
    const hf* hm = (const hf*)(ws + WS_HM); constexpr long HMS = (long)NTOK * GW;
    att::BlkRef r;
    r.list = nullptr; r.cnt = 0;
    if (Li < NI_C) {
        const int bh = Li & 7, qblk = 15 - (Li >> 3), b = bh >> 2, h = bh & 3;
        const long row0 = (long)b * SEQ + qblk * 256, hrow = (long)(b * 4 + h) * SEQ;
        r.Q = hm + 3 * HMS + (hrow + qblk * 256) * 128; r.qs = 128;
        r.K = hm + 4 * HMS + hrow * 128; r.V = hm + 5 * HMS + hrow * 128; r.ks = 128;
        r.O = (hf*)(ws + WS_OCP) + ((long)3 * NTOK + row0) * GW + h * 128; r.os = GW;
        r.LSE = (float*)(ws + WS_LSE + MiB) + ((long)3 * NTOK + row0) * 4 + h; r.ls = 4;
        r.P0 = qblk * 256; r.W = 1 << 30; r.j_lo = qblk * 4; r.j_hi = qblk * 4 + 4;
    } else if (Li < NI_C + NI_A) {
        const int i = Li - NI_C, p = i >> 7, rr = i & 127, b = rr >> 6, h = (rr >> 4) & 3, slot = rr & 15;
        const int dsh = 2 * p, d = 1 << dsh, bpr = 16 >> dsh, res = slot / bpr, blk = slot % bpr, l0 = 256 * blk, Lsub = SEQ >> dsh;
        const long rowb = (long)b * SEQ + res, q0 = rowb + (long)l0 * d, hrow = (long)(b * 4 + h) * SEQ + res;
        r.Q = hm + 0 * HMS + (hrow + (long)l0 * d) * 128; r.qs = d * 128;
        r.K = hm + 1 * HMS + hrow * 128; r.V = hm + 2 * HMS + hrow * 128; r.ks = d * 128;
        r.O = (hf*)(ws + WS_OA) + ((long)p * NTOK + q0) * GW + h * 128; r.os = d * GW;
        r.LSE = (float*)(ws + WS_LSE) + ((long)p * NTOK + q0) * 4 + h; r.ls = d * 4;
        r.P0 = l0; r.W = 129; r.j_lo = (l0 >= 128) ? (l0 - 128) / 64 : 0; r.j_hi = (l0 + 255) / 64 + 1; if (r.j_hi > Lsub / 64) r.j_hi = Lsub / 64;
    } else {
        const int i = Li - NI_C - NI_A, b = i >> 6, h = (i >> 4) & 3, blk = i & 15;
        const long row0 = (long)b * SEQ + 256 * blk;
        const hf* kv = (const hf*)(ws + WS_KVMEM) + (size_t)L * 512 * 1024 + (long)b * NMEM * 1024 + h * 128;
        r.Q = hm + 6 * HMS + ((long)(b * 4 + h) * SEQ + 256 * blk) * 128; r.qs = 128;
        r.K = kv; r.V = kv + GW; r.ks = 1024;
        r.O = (hf*)(ws + WS_OX) + row0 * GW + h * 128; r.os = GW; r.LSE = nullptr; r.ls = 0;
        r.P0 = 1 << 20; r.W = 1 << 30; r.j_lo = 0; r.j_hi = 4;
    }
    return r;
}
__device__ __forceinline__ att::BlkRef gather_decode(int gi, unsigned char* ws, int L, const LAS int* tab) {
    int k = 0;
#pragma unroll 1
    for (int s = 64; s > 0; s >>= 1) if (tab[k + s] <= gi) k += s;
    const int chunk = gi - tab[k], bh = k >> 4, n = k & 15, b = bh >> 2, h = bh & 3;
    const hf* hm = (const hf*)(ws + WS_HM); constexpr long HMS = (long)NTOK * GW;
    const long hrow = (long)(b * 4 + h) * SEQ;
    const unsigned total = __hip_atomic_load((unsigned*)(ws + WS_CTL) + CW_CNT + L * 128 + k, __ATOMIC_RELAXED, __HIP_MEMORY_SCOPE_AGENT);
    att::BlkRef r;
    r.list = (const unsigned*)(ws + WS_LIST) + (size_t)k * SEQ + chunk * 256; r.cnt = (int)total - chunk * 256; if (r.cnt > 256) r.cnt = 256;
    r.Q = hm + 3 * HMS + hrow * 128; r.qs = 128;
    r.K = hm + 4 * HMS + hrow * 128; r.V = hm + 5 * HMS + hrow * 128; r.ks = 128;
    r.O = (hf*)(ws + WS_OCP) + ((long)b * SEQ) * GW + h * 128; r.os = GW;
    r.LSE = (float*)(ws + WS_LSE + MiB) + ((long)b * SEQ) * 4 + h; r.ls = 4;
    r.P0 = 1 << 20; r.W = 1 << 30; r.j_lo = n * 4; r.j_hi = n * 4 + 4;
    return r;
}
__device__ __forceinline__ att::NxtRef nxt_of(const att::BlkRef& n2) { att::NxtRef nx; nx.Q = n2.Q; nx.K = n2.K; nx.V = n2.V; nx.list = n2.list; nx.qs = n2.qs; nx.ks = n2.ks; nx.j_lo = n2.j_lo; nx.cnt = n2.cnt; return nx; }
__device__ __forceinline__ int wg_dequeue(unsigned* ctr, LAS unsigned char* lds, int base) {
    volatile LAS int* qw = (volatile LAS int*)(lds + LDS_Q_OFF);
    if (threadIdx.x == 0) qw[0] = base + (int)__hip_atomic_fetch_add(ctr, 1u, __ATOMIC_RELAXED, __HIP_MEMORY_SCOPE_AGENT);
    __syncthreads();
    const int v = qw[0];
    __syncthreads();
    return __builtin_amdgcn_readfirstlane(v);
}
__device__ __forceinline__ void conv_fill_item(int f, LAS unsigned char* lds) {
    KA_BEGIN();
    const float* norm_g = ka->in[2]; const float* w_in = ka->in[3]; const float* w_mem_kv = ka->in[10]; const float* w_out = ka->in[12];
    const int tid_c = wave * 64 + lane;
    if (f < N_STRIP) strip_i8(w_in + (size_t)DM * NCOL, norm_g + DM, ws + WS_WINT + (size_t)NCOL * DM * 2, (float*)(ws + WS_SW) + NCOL, f, lds, tid_c);
    else {
        const int t0 = CT_ALL + CT_IN + 8 * (f - N_STRIP);
        f32x4 va[8], vb[8];
        ConvDesc da = ctile_decode(t0, w_in, w_out, w_mem_kv, (hf*)(ws + WS_WINT), (hf*)(ws + WS_WOUTT), (hf*)(ws + WS_WMEMT), norm_g, ws), db = da;
        ctile_load(va, da, tid_c);
#pragma unroll 1
        for (int i = 0; i < 8; i += 2) {
            db = ctile_decode(t0 + i + 1, w_in, w_out, w_mem_kv, (hf*)(ws + WS_WINT), (hf*)(ws + WS_WOUTT), (hf*)(ws + WS_WMEMT), norm_g, ws); ctile_load(vb, db, tid_c);
            ctile_store(va, da, (LAS float*)lds, tid_c);
            if (i + 2 < 8) { da = ctile_decode(t0 + i + 2, w_in, w_out, w_mem_kv, (hf*)(ws + WS_WINT), (hf*)(ws + WS_WOUTT), (hf*)(ws + WS_WMEMT), norm_g, ws); ctile_load(va, da, tid_c); }
            ctile_store(vb, db, (LAS float*)lds, tid_c);
        }
    }
    asm volatile("s_waitcnt vmcnt(0)" ::: "memory");
    __syncthreads();
}
__device__ __forceinline__ int wg_dequeue(unsigned* ctr, LAS unsigned char* lds, int base);
__device__ __forceinline__ void conv_fill_loop(LAS unsigned char* lds) {
    KA_BEGIN();
    unsigned* fctr = (unsigned*)(ws + WS_CTL) + CW_BAR + 16;
    const float* W1 = ka->in[3] + (size_t)DM * NCOL; const float* g1 = ka->in[2] + DM; unsigned char* WT8 = ws + WS_WINT + (size_t)NCOL * DM * 2; float* sw = (float*)(ws + WS_SW) + NCOL;
    const int tid_c = wave * 64 + lane;
    int f = wg_dequeue(fctr, lds, 0);
    if (f < N_STRIP) {
        StripHalf A; strip_issue(A, W1, g1, f, 0, tid_c);
        for (;;) {
            f32x4 pm = (f32x4){0.f, 0.f, 0.f, 0.f};
            { StripHalf B; strip_issue(B, W1, g1, f, 1, tid_c); strip_put(A, pm, lds, 0, tid_c); strip_put(B, pm, lds, 1, tid_c); }
            const int fn = wg_dequeue(fctr, lds, 0);
            if (fn < N_STRIP) strip_issue(A, W1, g1, fn, 0, tid_c);
            strip_finish(pm, WT8, sw, f, lds, tid_c);
            f = fn;
            if (fn >= N_STRIP) break;
        }
    }
    while (f < NI_F) { conv_fill_item(f, lds); f = wg_dequeue(fctr, lds, 0); }
}
__device__ __forceinline__ unsigned wg_ticket(unsigned* ctr) { unsigned tk = 0u; if (threadIdx.x == 0) tk = __hip_atomic_fetch_add(ctr, 1u, __ATOMIC_RELAXED, __HIP_MEMORY_SCOPE_AGENT); return tk; }
__device__ __forceinline__ int wg_publish(unsigned tk, LAS unsigned char* lds, int base) {
    volatile LAS int* qw = (volatile LAS int*)(lds + LDS_Q_OFF);
    if (threadIdx.x == 0) qw[0] = base + (int)tk;
    __syncthreads();
    const int v = qw[0];
    __syncthreads();
    return __builtin_amdgcn_readfirstlane(v);
}
__device__ __forceinline__ void phase_mix(LAS unsigned char* lds, int L) {
    const CAS Args* ka0 = (const CAS Args*)__builtin_amdgcn_kernarg_segment_ptr(); asm volatile("" : "+s"(ka0));
    const int Gq = gridDim.x;
    unsigned* qctr = (unsigned*)(ka0->ws + WS_CTL) + CW_BAR + 64 * L;
    unsigned* gdone = (unsigned*)(ka0->ws + WS_CTL) + CW_BAR + 32 + 64 * L;
    unsigned* kdone = (unsigned*)(ka0->ws + WS_CTL) + CW_BAR + 48;
    const int Q_M0 = NI_G, Q_C0 = Q_M0 + NI_M, Q_K0 = Q_C0 + NI_C, Q_A0 = Q_K0 + (L == 0 ? NI_K : 0), Q_DYN = Q_A0 + NI_A;
    const int QBASE = 2 * Gq - NI_G;
    LAS int* tab = (LAS int*)(lds + LDS_GTAB);
    bool tabok = false; int GT = 0;
    int L0 = blockIdx.x, L1 = ((int)blockIdx.x >= NI_G) ? (int)blockIdx.x + Gq - NI_G : -1;
    unsigned char* ws = ka0->ws;
#define IS_ATT(i) (((i) >= Q_C0 && (i) < Q_K0) || ((i) >= Q_A0 && (i) < Q_DYN) || (tabok && (i) >= Q_DYN && (i) < Q_DYN + GT + NI_X))
#define ATT_DECODE(i) ((i) < Q_K0 ? mix_decode((i) - Q_C0, ws, L) : ((i) < Q_DYN ? mix_decode(NI_C + (i) - Q_A0, ws, L) : \
                       ((i) < Q_DYN + GT ? gather_decode((i) - Q_DYN, ws, L, tab) : mix_decode(NI_C + NI_A + (i) - Q_DYN - GT, ws, L))))
    for (;;) {
        if (L0 >= Q_DYN && !tabok) {
            __syncthreads();
            if (threadIdx.x == 0) { unsigned sp = 0u;
                while (__hip_atomic_load(gdone, __ATOMIC_RELAXED, __HIP_MEMORY_SCOPE_AGENT) < (unsigned)NI_M || __hip_atomic_load(kdone, __ATOMIC_RELAXED, __HIP_MEMORY_SCOPE_AGENT) < (unsigned)NI_K) { __builtin_amdgcn_s_sleep(2); if (++sp > (1u << 22)) break; }
                __builtin_amdgcn_fence(__ATOMIC_ACQUIRE, "agent"); asm volatile("s_waitcnt vmcnt(0)" ::: "memory"); }
            __syncthreads();
            {
                int tid_s = threadIdx.x; asm volatile("" : "+v"(tid_s));
                LAS int* cl = tab + 160;
                if (tid_s < 128) cl[tid_s] = ((int)__hip_atomic_load((unsigned*)(ws + WS_CTL) + CW_CNT + L * 128 + tid_s, __ATOMIC_RELAXED, __HIP_MEMORY_SCOPE_AGENT) + 255) >> 8;
                __syncthreads();
                if (tid_s <= 128) { int s = 0; for (int k = 0; k < tid_s; ++k) s += cl[k]; tab[tid_s] = s; }
            }
            __syncthreads();
            GT = tab[128]; tabok = true;
        }
        if (tabok && L0 >= Q_DYN + GT + NI_X + NI_B) break;
        if (L0 < Q_M0) {
            {
                KA_BEGIN();
                pg8::Gemm g{(F8_PROJ_L(L) || I8_PROJ_L(L)) ? (const void*)(ws + WS_XN8) : (const void*)(ws + WS_XN), ws + WS_WINT + (size_t)L * NCOL * DM * 2, NTOK, NCOL, DM};
                pg8::OneUnit S{L0 & 31, (PROJ_N1 / 256) + (L0 >> 5)};
                float* cosT = (float*)(ws + WS_ROPE);
                pg8::EpiProj E{(hf*)(ws + WS_PROJ), cosT, cosT + SEQ * 64, (float*)(ws + WS_KPART), (f32x2*)(ws + WS_VSTAT), (const float*)(ws + WS_ROWSS), (hf*)(ws + WS_HM), I8_PROJ_L(L) ? (const float*)(ws + WS_SA) : (const float*)nullptr,
                               I8_PROJ_L(L) ? (const float*)(ws + WS_SW) + L * NCOL : (const float*)nullptr, (const LAS float*)nullptr, -1};
#if I8_PROJ == 3
                pg8::gemm_phase<pg8::EpiProj, pg8::OneUnit, true, true, 2>(lds, g, S, E);
#else
                if (I8_PROJ_L(L)) pg8::gemm_phase<pg8::EpiProj, pg8::OneUnit, true, true, 2>(lds, g, S, E);
                else if (F8_PROJ_L(L)) pg8::gemm_phase<pg8::EpiProj, pg8::OneUnit, true, true, 1>(lds, g, S, E);
                else pg8::gemm_phase<pg8::EpiProj, pg8::OneUnit, true, true, 0>(lds, g, S, E);
#endif
            }
            if (L == 0) conv_fill_loop(lds);
            L0 = wg_dequeue(qctr, lds, QBASE); L1 = wg_dequeue(qctr, lds, QBASE);
        } else if (L0 < Q_C0) {
            const unsigned tkn = wg_ticket(qctr);
            moba_gate_item(L0 - Q_M0, ws, L, lds);
            L0 = L1; L1 = wg_publish(tkn, lds, QBASE);
        } else if (L0 >= Q_K0 && L0 < Q_A0) {
            const unsigned tkn = wg_ticket(qctr);
            memkv_tile(L0 - Q_K0, lds);
            L0 = L1; L1 = wg_publish(tkn, lds, QBASE);
        } else if (tabok && L0 >= Q_DYN + GT + NI_X) {
            const unsigned tkn = wg_ticket(qctr);
            KA_BEGIN();
            MixP P{(const hf*)(ws + WS_PROJ), (const hf*)(ws + WS_KVMEM) + (size_t)L * 512 * 1024, (hf*)(ws + WS_OA), (float*)(ws + WS_LSE), (hf*)(ws + WS_OB), (hf*)(ws + WS_OCP),
                   (float*)(ws + WS_LSE + MiB), (hf*)(ws + WS_OX), (const float*)(ws + WS_KPART), (const f32x2*)(ws + WS_VSTAT), (const hf*)(ws + WS_SGUW) + (size_t)L * 4 * 128 * 128,
                   (const float*)(ws + WS_SGUW + 512 * 1024) + L * 512, ka->in[5] + L * 512, ka->in[6] + L * GW, ka->in[7] + L * GW};
            const int it = (L0 - (Q_DYN + GT + NI_X)) * 8 + wave;
            const int itx = ((it & 7) << 8) | (it >> 3);
            item_B(P, itx, lds + wave * WAVE_LDS, lane, fr, quad);
            L0 = L1; L1 = wg_publish(tkn, lds, QBASE);
        } else {
            att::Seam S;
            { const att::BlkRef c0 = ATT_DECODE(L0); att::blk_prime(c0, (LAS char*)lds, S); }
            for (;;) {
                const bool more = IS_ATT(L1);
                unsigned tk = 0u;
                if (threadIdx.x == 0) tk = __hip_atomic_fetch_add(qctr, 1u, __ATOMIC_RELAXED, __HIP_MEMORY_SCOPE_AGENT);
                const att::BlkRef cur = ATT_DECODE(L0);
                const int Ln = more ? L1 : L0;
                const att::NxtRef nx = nxt_of(ATT_DECODE(Ln));
                volatile LAS int* qw = (volatile LAS int*)(lds + LDS_Q_OFF);
                att::blk_run(cur, nx, (LAS char*)lds, S, tk, qw, QBASE);
                const int L2 = __builtin_amdgcn_readfirstlane(qw[0]);
                L0 = L1; L1 = L2;
                if (!more) break;
            }
            asm volatile("s_waitcnt vmcnt(0)" ::: "memory");
            __syncthreads();
        }
    }
#undef IS_ATT
#undef ATT_DECODE
}

__device__ __forceinline__ void phase_finalize(int L) {
    KA_BEGIN();
    const hf* proj = (const hf*)(ws + WS_PROJ); const hf* oa = (const hf*)(ws + WS_OA); const hf* ob = (const hf*)(ws + WS_OB); const hf* ocp = (const hf*)(ws + WS_OCP); const hf* ox = (const hf*)(ws + WS_OX);
    const float* lsea = (const float*)(ws + WS_LSE); const float* lsec = (const float*)(ws + WS_LSE + MiB); hf* yb = (hf*)(ws + WS_Y);
    const float* cw = ka->in[8] + (size_t)L * 3 * GW; const float* ong = ka->in[11] + (size_t)L * MIXW;
    f32x4 ogv[5][2];
#pragma unroll
    for (int gq = 0; gq < 5; ++gq) { ogv[gq][0] = *(const f32x4*)(ong + gq * GW + 8 * lane); ogv[gq][1] = *(const f32x4*)(ong + gq * GW + 8 * lane + 4); }
    for (int t = gw; t < NTOK; t += NGW) {
        const int pos = t & (SEQ - 1), hd = lane >> 4, c8 = 8 * lane;
        const hf* prow = proj + (size_t)t * NCOL;
        float u[5][8];
        {
            float ls[3], mx = -3e38f;
#pragma unroll
            for (int p = 0; p < 3; ++p) { ls[p] = lsea[((size_t)p * NTOK + t) * 4 + hd]; mx = fmaxf(mx, ls[p]); }
            float wsum = 0.f, acc[8] = {0, 0, 0, 0, 0, 0, 0, 0};
#pragma unroll
            for (int p = 0; p < 3; ++p) { const float w = __builtin_amdgcn_exp2f(ls[p] - mx); wsum += w; const h8 o = __builtin_nontemporal_load((const h8*)(oa + ((size_t)p * NTOK + t) * GW + c8));
#pragma unroll
                for (int i = 0; i < 8; ++i) acc[i] += w * (float)o[i]; }
            const float inv = 1.0f / wsum; const h8 gt = __builtin_nontemporal_load((const h8*)(prow + SL_AG * GW + c8));
#pragma unroll
            for (int i = 0; i < 8; ++i) u[0][i] = acc[i] * inv * (float)gt[i];
        }
        {
            const h8 o = __builtin_nontemporal_load((const h8*)(ob + (size_t)t * GW + c8));
#pragma unroll
            for (int i = 0; i < 8; ++i) u[1][i] = (float)o[i];
        }
        {
            float ls[4], mx = -3e38f;
#pragma unroll
            for (int p = 0; p < 4; ++p) { ls[p] = lsec[((size_t)p * NTOK + t) * 4 + hd]; mx = fmaxf(mx, ls[p]); }
            float wsum = 0.f, acc[8] = {0, 0, 0, 0, 0, 0, 0, 0};
#pragma unroll
            for (int p = 0; p < 4; ++p) if (ls[p] > -1e29f) { const float w = __builtin_amdgcn_exp2f(ls[p] - mx); wsum += w; const h8 o = __builtin_nontemporal_load((const h8*)(ocp + ((size_t)p * NTOK + t) * GW + c8));
#pragma unroll
                for (int i = 0; i < 8; ++i) acc[i] += w * (float)o[i]; }
            const float inv = 1.0f / wsum; const h8 gt = __builtin_nontemporal_load((const h8*)(prow + SL_CG * GW + c8));
#pragma unroll
            for (int i = 0; i < 8; ++i) u[2][i] = acc[i] * inv * (float)gt[i];
        }
        {
            float y[8] = {0, 0, 0, 0, 0, 0, 0, 0};
#pragma unroll
            for (int k = 0; k < 3; ++k) { const int back = 2 - k;
                if (pos - back >= 0) { const hf* pr = prow - (size_t)back * NCOL; const h8 z = *(const h8*)(pr + SL_DC * GW + c8);
                    const f32x4 w0 = *(const f32x4*)(cw + k * GW + c8), w1 = *(const f32x4*)(cw + k * GW + c8 + 4);
#pragma unroll
                    for (int i = 0; i < 4; ++i) { y[i] += w0[i] * (float)z[i]; y[4 + i] += w1[i] * (float)z[4 + i]; } } }
            const h8 dbg = __builtin_nontemporal_load((const h8*)(prow + SL_DB * GW + c8));
#pragma unroll
            for (int i = 0; i < 8; ++i) u[3][i] = (float)dbg[i] * y[i];
        }
        {
            const h8 o = __builtin_nontemporal_load((const h8*)(ox + (size_t)t * GW + c8)), gt = __builtin_nontemporal_load((const h8*)(prow + SL_XG * GW + c8));
#pragma unroll
            for (int i = 0; i < 8; ++i) u[4][i] = (float)o[i] * (float)gt[i];
        }
        float ssv[5];
#pragma unroll
        for (int gq = 0; gq < 5; ++gq) { float ss = 0.f;
#pragma unroll
            for (int i = 0; i < 8; ++i) ss += u[gq][i] * u[gq][i];
            ssv[gq] = ss; }
#pragma unroll
        for (int o_ = 1; o_ < 64; o_ <<= 1) {
            float tv[5];
#pragma unroll
            for (int gq = 0; gq < 5; ++gq) tv[gq] = shx_l(ssv[gq], lane, o_);
#pragma unroll
            for (int gq = 0; gq < 5; ++gq) ssv[gq] += tv[gq];
        }
        if (I8_OUT_L(L)) {
            float mx = 0.f;
#pragma unroll
            for (int gq = 0; gq < 5; ++gq) { const float r = __builtin_amdgcn_rsqf(ssv[gq] * (1.0f / GW) + NORM_EPS); const f32x4 g0 = ogv[gq][0], g1 = ogv[gq][1];
#pragma unroll
                for (int i = 0; i < 4; ++i) { u[gq][i] *= r * g0[i]; u[gq][4 + i] *= r * g1[i]; mx = fmaxf(mx, fmaxf(fabsf(u[gq][i]), fabsf(u[gq][4 + i]))); } }
#pragma unroll
            for (int o_ = 1; o_ < 64; o_ <<= 1) mx = fmaxf(mx, shx_l(mx, lane, o_));
            mx = fmaxf(mx, 1e-30f); const float inv = 127.0f / mx;
#pragma unroll
            for (int gq = 0; gq < 5; ++gq) { unsigned w0 = 0u, w1 = 0u;
#pragma unroll
                for (int i = 0; i < 4; ++i) { w0 |= ((unsigned)(int)__builtin_rintf(u[gq][i] * inv) & 255u) << (8 * i); w1 |= ((unsigned)(int)__builtin_rintf(u[gq][4 + i] * inv) & 255u) << (8 * i); }
                *(u32x2*)((unsigned char*)yb + (size_t)t * MIXW + gq * GW + c8) = (u32x2){w0, w1}; }
            if (lane == 0) ((float*)(ws + WS_SY))[t] = mx * (1.0f / 127.0f);
        } else {
#pragma unroll
        for (int gq = 0; gq < 5; ++gq) {
            const float r = __builtin_amdgcn_rsqf(ssv[gq] * (1.0f / GW) + NORM_EPS);
            const f32x4 g0 = ogv[gq][0], g1 = ogv[gq][1];
            f32x4 o0, o1;
#pragma unroll
            for (int i = 0; i < 4; ++i) { o0[i] = u[gq][i] * r * g0[i]; o1[i] = u[gq][4 + i] * r * g1[i]; }
            if (F8_OUT_L(L)) *(u32x2*)((unsigned char*)yb + (size_t)t * MIXW + gq * GW + c8) = pk8_f8(o0 * A8_SCALE, o1 * A8_SCALE);
            else *(h8*)(yb + (size_t)t * MIXW + gq * GW + c8) = pack8(o0, o1);
        }
        }
    }
}

__device__ __forceinline__ void phase_out(LAS unsigned char* lds, int L) {
    KA_BEGIN();
    float* x1 = (float*)(ws + WS_X1);
    pg8::Gemm g{ws + WS_Y, ws + WS_WOUTT + (size_t)L * DM * MIXW * 2, NTOK, DM, MIXW}; pg8::StaticOrder S; S.init(NTOK, DM, G, (int)blockIdx.x);
    pg8::EpiRes E{(const float*)nullptr, (const hf*)(ws + WS_XN), L == 0 ? (hf*)(ws + WS_XN) : (hf*)x1, (float*)(ws + WS_ROWSS),
                  L == 0 ? (float*)nullptr : ka->out, ka->in[13], (unsigned*)(ws + WS_CTL) + CW_CNT + 256, (L == 0 && F8_PROJ_L(1)) ? ws + WS_XN8 : (unsigned char*)nullptr,
                  (L == 0 && I8_PROJ_L(1)) ? ws + WS_XN8 : (unsigned char*)nullptr, (float*)(ws + WS_SA), (float*)(ws + WS_ROWMX),
                  I8_PROJ_L(L) ? (const unsigned char*)(ws + WS_XN8) : (const unsigned char*)nullptr, (const float*)(ws + WS_SA),
                  I8_OUT_L(L) ? (const float*)(ws + WS_SY) : (const float*)nullptr, (const float*)(ws + WS_SWO) + L * DM};
#if I8_OUT == 0 && F8_OUT == 3
    pg8::gemm_phase<pg8::EpiRes, pg8::StaticOrder, true, true, 1>(lds, g, S, E);
#else
    if (I8_OUT_L(L)) pg8::gemm_phase<pg8::EpiRes, pg8::StaticOrder, true, true, 2>(lds, g, S, E);
    else if (F8_OUT_L(L)) pg8::gemm_phase<pg8::EpiRes, pg8::StaticOrder, true, true, 1>(lds, g, S, E);
    else pg8::gemm_phase<pg8::EpiRes, pg8::StaticOrder, true, true, 0>(lds, g, S, E);
#endif
}
__device__ __forceinline__ void phase_norm_mid() {
    KA_BEGIN();
    const float* x1 = (const float*)(ws + WS_X1); hf* xn = (hf*)(ws + WS_XN); const float* g1 = ka->in[2] + DM;
    for (int m = gw; m < NTOK; m += NGW) rms_row(x1 + (size_t)m * DM, g1, xn + (size_t)m * DM, nullptr, lane);
}
__device__ __forceinline__ void phase_norm_final() {
    KA_BEGIN();
    float* out = ka->out; const float* gf = ka->in[13]; const hf* x2 = (const hf*)(ws + WS_X1); const float* rowss = (const float*)(ws + WS_ROWSS);
    for (int m = gw; m < NTOK; m += NGW) {
        const f32x4 pa = *(const f32x4*)(rowss + (size_t)m * 8), pb = *(const f32x4*)(rowss + (size_t)m * 8 + 4);
        const float r = __builtin_amdgcn_rsqf(((pa[0] + pa[1]) + (pa[2] + pa[3]) + (pb[0] + pb[1]) + (pb[2] + pb[3])) * (1.0f / DM) + NORM_EPS);
#pragma unroll
        for (int j = 0; j < 4; ++j) { const int c = 8 * (lane + 64 * j); const h8 v = *(const h8*)(x2 + (size_t)m * DM + c);
            const f32x4 g0 = *(const f32x4*)(gf + c), g1 = *(const f32x4*)(gf + c + 4); f32x4 o0, o1;
#pragma unroll
            for (int i = 0; i < 4; ++i) { o0[i] = (float)v[i] * r * g0[i]; o1[i] = (float)v[4 + i] * r * g1[i]; }
            *(f32x4*)(out + (size_t)m * DM + c) = o0; *(f32x4*)(out + (size_t)m * DM + c + 4) = o1; }
    }
}


#define XB_TMO      128
#define XB_XCNT(j)  (256  + 64 * (j))
#define XB_XSUB(j)  (1280 + 64 * (j))
#define XB_XGEN(j)  (2304 + 64 * (j))
#define XB_TOP      3328
#define XB_TOPGEN   3392
#define XCD_BAR_WORDS 3456
#define XB_SPIN_CAP (1u << 18)
__device__ __forceinline__ unsigned xb_ld(unsigned* p)              { return __hip_atomic_load(p, __ATOMIC_RELAXED, __HIP_MEMORY_SCOPE_AGENT); }
__device__ __forceinline__ unsigned xb_add(unsigned* p, unsigned v) { return __hip_atomic_fetch_add(p, v, __ATOMIC_RELAXED, __HIP_MEMORY_SCOPE_AGENT); }
__device__ __forceinline__ unsigned xb_xcc_id() { return (unsigned)__builtin_amdgcn_s_getreg((3 << 11) | 20) & 0xFu; }
#define XB_SPIN(cond, bar) do { unsigned _sp = 0; while (cond) { __builtin_amdgcn_s_sleep(1); \
    if ((++_sp & 255u) == 0u) { if (xb_ld(&(bar)[XB_TMO])) break; if (_sp > XB_SPIN_CAP) { atomicAdd(&(bar)[XB_TMO], 1u); break; } } } } while (0)
struct XcdBarrier { unsigned* bar; unsigned x; volatile LAS unsigned* st; };
__device__ __forceinline__ XcdBarrier xcd_barrier_post(unsigned* bar, volatile LAS unsigned* st) {
    XcdBarrier b; b.bar = bar; b.x = xb_xcc_id(); b.st = st;
    if (threadIdx.x == 0) (void)xb_add(&bar[XB_XCNT(b.x)], 1u);
    return b;
}
__device__ __forceinline__ void xcd_barrier_complete(unsigned* bar, unsigned x, unsigned& nloc, unsigned& nx) {
    const unsigned G = gridDim.x * gridDim.y * gridDim.z;
    unsigned sum, cnt, mine, sp = 0u;
    for (;;) {
        sum = 0u; cnt = 0u; mine = 0u;
#pragma unroll
        for (unsigned j = 0; j < 16; ++j) { const unsigned c = xb_ld(&bar[XB_XCNT(j)]); sum += c; cnt += (c > 0u) ? 1u : 0u; mine = (j == x) ? c : mine; }
        if (sum == G) break;
        __builtin_amdgcn_s_sleep(1);
        if ((++sp & 255u) == 0u) { if (xb_ld(&bar[XB_TMO])) break; if (sp > XB_SPIN_CAP) { atomicAdd(&bar[XB_TMO], 1u); break; } }
    }
    nloc = mine > 0u ? mine : 1u; nx = cnt > 0u ? cnt : 1u;
}
__device__ __forceinline__ void xcd_barrier(const XcdBarrier& b) {
    asm volatile("s_waitcnt vmcnt(0)" ::: "memory");
    __syncthreads();
    if (threadIdx.x == 0) {
        unsigned* bar = b.bar;
        __builtin_amdgcn_s_waitcnt(0);
        unsigned nloc = b.st[0], nx = b.st[1];
        if (nloc == 0u) { xcd_barrier_complete(bar, b.x, nloc, nx); b.st[0] = nloc; b.st[1] = nx; }
        const unsigned old = xb_add(&bar[XB_XSUB(b.x)], 1u);
        const unsigned gen = old / nloc;
        if (old + 1u == (gen + 1u) * nloc) {
            __builtin_amdgcn_fence(__ATOMIC_RELEASE, "agent");
            asm volatile("s_waitcnt vmcnt(0)" ::: "memory");
            const unsigned og = xb_add(&bar[XB_TOP], 1u);
            const unsigned tg = og / nx;
            if (og + 1u == (tg + 1u) * nx) xb_add(&bar[XB_TOPGEN], 1u);
            else XB_SPIN(xb_ld(&bar[XB_TOPGEN]) == tg, bar);
            __builtin_amdgcn_fence(__ATOMIC_ACQUIRE, "agent");
            xb_add(&bar[XB_XGEN(b.x)], 1u);
            asm volatile("s_waitcnt vmcnt(0)" ::: "memory");
        } else {
            XB_SPIN(xb_ld(&bar[XB_XGEN(b.x)]) == gen, bar);
            __builtin_amdgcn_fence(__ATOMIC_ACQUIRE, "agent");
            asm volatile("s_waitcnt vmcnt(0)" ::: "memory");
        }
    }
    __syncthreads();
}
constexpr int LDS_BAR_OFF = 145408;

__global__ void __launch_bounds__(NWAVES * 64, 2) mk_fwd(Args args) {
    extern __shared__ __attribute__((aligned(16))) unsigned char lds_raw[];
    LAS unsigned char* lds = (LAS unsigned char*)lds_raw;
    const int ph_lo = args.ph_lo, ph_hi = args.ph_hi;
    if (threadIdx.x < 4) ((LAS unsigned*)(lds + LDS_BAR_OFF))[threadIdx.x] = 0u;
    if (COOP && blockIdx.x == 0) { unsigned* bw = (unsigned*)(args.ws + WS_CTL) + 4096; for (int i = threadIdx.x; i < XCD_BAR_WORDS; i += NWAVES * 64) __hip_atomic_store(bw + i, 0u, __ATOMIC_RELAXED, __HIP_MEMORY_SCOPE_AGENT); }
    __syncthreads();
    XcdBarrier xbar; xbar.bar = (unsigned*)(args.ws + WS_CTL) + 4096; xbar.x = 0; xbar.st = (volatile LAS unsigned*)(lds + LDS_BAR_OFF);
    if (!COOP) xbar = xcd_barrier_post(xbar.bar, xbar.st);
    for (int ph = ph_lo; ph < ph_hi; ++ph) {
        if (ph == 10 || ph == 5 || ph == 11) continue;
        int kind = 6;
        if (ph == 0) kind = 0; else if (ph < 11) kind = 1 + (ph - 1) % 5;
        const int nrep = 1 + ((REP_MASK >> kind) & 1);
        for (int rep = 0; rep < nrep; ++rep) {
        if (ph == 0) { if (PH_EN(0)) phase_prologue(lds); }
        else if (ph == 11) { if (PH_EN(6)) phase_norm_final(); }
        else {
            const int L = (ph - 1) / 5, sp = (ph - 1) % 5;
            if (sp == 0) { if (PH_EN(1)) phase_proj(lds, L); }
            else if (sp == 1) { if (PH_EN(2)) phase_mix(lds, L); }
            else if (sp == 2) { if (PH_EN(3)) phase_finalize(L); }
            else if (sp == 3) { if (PH_EN(4)) phase_out(lds, L); }
            else if (L == 0) { if (PH_EN(5)) phase_norm_mid(); }
        }
        __syncthreads();
        }
        if (ph + 1 < ph_hi) { for (int r = 0; r < SYNC_REP; ++r) { if (COOP && (ph == 0 || !XB_USE)) { __syncthreads(); cg::this_grid().sync(); if (ph == 0 && r == 0) xbar = xcd_barrier_post(xbar.bar, xbar.st); } else xcd_barrier(xbar); } }
    }
}

extern "C" void kernel_launch(void* const* d_in, const int* in_sizes, int n_in, void* d_out, int out_size, void* d_ws, size_t ws_size, hipStream_t stream) {
    static int grid = 0;
    if (grid == 0) {
        if (n_in != 14 || out_size != NTOK * DM || ws_size < WS_END) { fprintf(stderr, "kernel_launch: unexpected shapes (n_in %d, out %d, ws %zu)\n", n_in, out_size, ws_size); grid = -1; return; }
        int dev = 0, cus = 0, per_cu = 0;
        hipGetDevice(&dev); hipDeviceGetAttribute(&cus, hipDeviceAttributeMultiprocessorCount, dev);
        if (hipFuncSetAttribute((const void*)mk_fwd, hipFuncAttributeMaxDynamicSharedMemorySize, LDS_BYTES) != hipSuccess) { fprintf(stderr, "kernel_launch: hipFuncSetAttribute failed\n"); grid = -1; return; }
        if (hipOccupancyMaxActiveBlocksPerMultiprocessor(&per_cu, (const void*)mk_fwd, NWAVES * 64, LDS_BYTES) != hipSuccess || per_cu < 1) { fprintf(stderr, "kernel_launch: occupancy query says %d\n", per_cu); per_cu = 1; }
        (void)hipGetLastError();
        grid = cus;
    }
    if (grid < 0) return;
    Args a{};
    for (int i = 0; i < 14; ++i) a.in[i] = (const float*)d_in[i];
    a.out = (float*)d_out; a.ws = (unsigned char*)d_ws;
#if MK_FUSED
    a.ph_lo = 0; a.ph_hi = 10;
#if COOP
    void* kargs[] = {&a};
    hipError_t e = hipLaunchCooperativeKernel((const void*)mk_fwd, dim3(grid), dim3(NWAVES * 64), kargs, LDS_BYTES, stream);
    if (e != hipSuccess) fprintf(stderr, "cooperative launch failed: %s (grid %d)\n", hipGetErrorString(e), grid);
#else
    if (hipMemsetAsync((char*)d_ws + WS_CTL, 0, 65536, stream) != hipSuccess) { fprintf(stderr, "kernel_launch: memset of the control words failed\n"); return; }
    hipLaunchKernelGGL(mk_fwd, dim3(grid), dim3(NWAVES * 64), LDS_BYTES, stream, a);
#endif
#else
    for (int ph = 0; ph < 12; ++ph) {
        if (ph == 10) continue;
        a.ph_lo = ph; a.ph_hi = ph + 1;
        hipLaunchKernelGGL(mk_fwd, dim3(grid), dim3(NWAVES * 64), LDS_BYTES, stream, a);
    }
#endif
}
```
